# Optimizing an MI355X kernel written in HIP

```python
import jax, jax.numpy as jnp
from jax import lax
import numpy as np

D_MODEL = 2048
BATCH = 1
SEQ = 8192
DEPTH = 1

PLE_DIM = 256
RMS_EPS = 1e-6
N_HEADS = 16
QK_NOPE_DIM = 128
QK_ROPE_DIM = 64
V_HEAD_DIM = 128
QK_HEAD_DIM = QK_NOPE_DIM + QK_ROPE_DIM
Q_LORA_RANK = 768
KV_LORA_RANK = 512
ROPE_THETA = 10000.0
Q_BLOCK = 128
D_RNN = D_MODEL
RNN_BLOCKS = 16
RNN_BLOCK_DIM = D_RNN // RNN_BLOCKS
CONV_WIDTH = 4
LRU_C = 8.0
PEER_HEADS = 8
N_KEYS = 128
N_EXPERTS = N_KEYS * N_KEYS
PEER_QUERY_DIM = 256
PEER_HALF = PEER_QUERY_DIM // 2
PEER_TOPK = 16
PEER_CHUNK = 128
IN_SPLITS = (Q_LORA_RANK, KV_LORA_RANK, QK_ROPE_DIM, D_RNN, D_RNN, D_MODEL, D_MODEL)
IN_WIDTH = Q_LORA_RANK + KV_LORA_RANK + QK_ROPE_DIM + 2 * D_RNN + 2 * D_MODEL

kernel_name = 'hybrid_mla_rglru_peer_block'


def rms_norm(x, g):
    xf = x.astype(jnp.float32)
    y = xf * lax.rsqrt(jnp.mean(xf * xf, axis=-1, keepdims=True) + RMS_EPS)
    return (y * g.astype(jnp.float32)).astype(x.dtype)


def rope(x, pos):
    half = QK_ROPE_DIM // 2
    inv_freq = 1.0 / (ROPE_THETA ** (jnp.arange(half, dtype=jnp.float32) / half))
    ang = pos.astype(jnp.float32)[:, None] * inv_freq[None, :]
    cos = jnp.cos(ang)[:, None, :]
    sin = jnp.sin(ang)[:, None, :]
    xf = x.astype(jnp.float32)
    x1, x2 = xf[..., :half], xf[..., half:]
    return jnp.concatenate([x1 * cos - x2 * sin, x2 * cos + x1 * sin], axis=-1).astype(x.dtype)


def split_columns(z):
    offs, acc = [], 0
    for w in IN_SPLITS[:-1]:
        acc += w
        offs.append(acc)
    return jnp.split(z, offs, axis=-1)


def mla_branch(c_q, c_kv, k_r, q_norm, w_uq, kv_norm, w_ukv, w_attn_o):
    B, S, _ = c_q.shape
    pos = jnp.arange(S)
    q = (rms_norm(c_q, q_norm) @ w_uq).reshape(B, S, N_HEADS, QK_HEAD_DIM)
    q_nope = q[..., :QK_NOPE_DIM]
    q_pe = rope(q[..., QK_NOPE_DIM:], pos)
    kv = (rms_norm(c_kv, kv_norm) @ w_ukv).reshape(B, S, N_HEADS, QK_NOPE_DIM + V_HEAD_DIM)
    k_nope, v = kv[..., :QK_NOPE_DIM], kv[..., QK_NOPE_DIM:]
    k_pe = rope(k_r[:, :, None, :], pos)[:, :, 0, :]
    scale = QK_HEAD_DIM ** -0.5
    n_blk = S // Q_BLOCK

    def to_blocks(t):
        return t.reshape(B, n_blk, Q_BLOCK, *t.shape[2:]).swapaxes(0, 1)

    def attend(args):
        qn, qp, blk = args
        s = (jnp.einsum('bqhd,bkhd->bhqk', qn, k_nope, preferred_element_type=jnp.float32)
             + jnp.einsum('bqhd,bkd->bhqk', qp, k_pe, preferred_element_type=jnp.float32))
        q_pos = blk * Q_BLOCK + jnp.arange(Q_BLOCK)
        s = jnp.where(pos[None, :] <= q_pos[:, None], s * scale, -jnp.inf)
        prob = jax.nn.softmax(s, axis=-1)
        return jnp.einsum('bhqk,bkhd->bqhd', prob.astype(v.dtype), v)

    o = lax.map(attend, (to_blocks(q_nope), to_blocks(q_pe), jnp.arange(n_blk)))
    o = o.swapaxes(0, 1).reshape(B, S, N_HEADS * V_HEAD_DIM)
    return o @ w_attn_o


def rglru_branch(x_r, y_r, conv_w, conv_b, w_rg_a, b_rg_a, w_rg_x, b_rg_x, lru_lambda, w_rnn_o):
    B, S, C = x_r.shape
    xc = lax.conv_general_dilated(x_r, conv_w[:, None, :], window_strides=(1,),
                                  padding=[(CONV_WIDTH - 1, 0)],
                                  dimension_numbers=('NWC', 'WIO', 'NWC'),
                                  feature_group_count=C) + conv_b
    xb = xc.reshape(B, S, RNN_BLOCKS, RNN_BLOCK_DIM)
    r = jax.nn.sigmoid(jnp.einsum('bshi,hij->bshj', xb, w_rg_a) + b_rg_a).reshape(B, S, C)
    i = jax.nn.sigmoid(jnp.einsum('bshi,hij->bshj', xb, w_rg_x) + b_rg_x).reshape(B, S, C)
    log_a = -LRU_C * r.astype(jnp.float32) * jax.nn.softplus(-lru_lambda.astype(jnp.float32))
    a = jnp.exp(log_a)
    mult = jnp.sqrt(-jnp.expm1(2.0 * log_a))
    mult = jnp.where((jnp.arange(S) == 0)[None, :, None], 1.0, mult)
    b = mult * (i * xc).astype(jnp.float32)

    def combine(left, right):
        a1, b1 = left
        a2, b2 = right
        return a1 * a2, a2 * b1 + b2

    _, h = lax.associative_scan(combine, (a, b), axis=1)
    y = h.astype(x_r.dtype) * jax.nn.gelu(y_r)
    return y @ w_rnn_o


def peer_ffn(x, w_peer_q, peer_subkeys, peer_u, peer_v):
    B, S, D = x.shape
    q = (x @ w_peer_q).reshape(B, S, PEER_HEADS, 2, PEER_HALF)
    s = jnp.einsum('bshcd,hcnd->bshcn', q, peer_subkeys, preferred_element_type=jnp.float32)
    top_s, top_i = lax.top_k(s, PEER_TOPK)
    cand = top_s[..., 0, :, None] + top_s[..., 1, None, :]
    cand = cand.reshape(B, S, PEER_HEADS, PEER_TOPK * PEER_TOPK)
    best_s, best_c = lax.top_k(cand, PEER_TOPK)
    i1 = jnp.take_along_axis(top_i[..., 0, :], best_c // PEER_TOPK, axis=-1)
    i2 = jnp.take_along_axis(top_i[..., 1, :], best_c % PEER_TOPK, axis=-1)
    experts = i1 * N_KEYS + i2
    gates = jax.nn.softmax(best_s, axis=-1).astype(x.dtype)
    T = B * S
    HK = PEER_HEADS * PEER_TOPK
    xs = x.reshape(T // PEER_CHUNK, PEER_CHUNK, D)
    es = experts.reshape(T // PEER_CHUNK, PEER_CHUNK, HK)
    gs = gates.reshape(T // PEER_CHUNK, PEER_CHUNK, HK)

    def chunk(args):
        xc, ec, gc = args
        u = peer_u[ec]
        act = jax.nn.gelu(jnp.einsum('tkd,td->tk', u, xc))
        return jnp.einsum('tk,tkd->td', gc * act, peer_v[ec])

    return lax.map(chunk, (xs, es, gs)).reshape(B, S, D)


def setup_inputs(seed: int = 0) -> dict:
    key = jax.random.key(seed)
    ks = iter(jax.random.split(key, 40))
    f32 = jnp.float32

    def nrm(shape, scale):
        return jax.random.normal(next(ks), shape, f32) * scale

    def gain(shape):
        return 1.0 + nrm(shape, 0.05)

    L = DEPTH
    u = jax.random.uniform(next(ks), (L, D_RNN), f32, 0.9, 0.999)
    s_root = u ** (1.0 / LRU_C)
    lru_lambda = jnp.log(s_root) - jnp.log1p(-s_root)
    return {
        'x': nrm((BATCH, SEQ, D_MODEL), 1.0),
        'p': nrm((DEPTH, BATCH, SEQ, PLE_DIM), 1.0),
        'attn_norm': gain((L, D_MODEL)),
        'w_in': nrm((L, D_MODEL, IN_WIDTH), D_MODEL ** -0.5),
        'b_gate': nrm((L, 2 * D_MODEL), 0.01),
        'q_norm': gain((L, Q_LORA_RANK)),
        'w_uq': nrm((L, Q_LORA_RANK, N_HEADS * QK_HEAD_DIM), Q_LORA_RANK ** -0.5),
        'kv_norm': gain((L, KV_LORA_RANK)),
        'w_ukv': nrm((L, KV_LORA_RANK, N_HEADS * (QK_NOPE_DIM + V_HEAD_DIM)), KV_LORA_RANK ** -0.5),
        'w_attn_o': nrm((L, N_HEADS * V_HEAD_DIM, D_MODEL), (N_HEADS * V_HEAD_DIM) ** -0.5),
        'conv_w': nrm((L, CONV_WIDTH, D_RNN), CONV_WIDTH ** -0.5),
        'conv_b': nrm((L, D_RNN), 0.01),
        'w_rg_a': nrm((L, RNN_BLOCKS, RNN_BLOCK_DIM, RNN_BLOCK_DIM), RNN_BLOCK_DIM ** -0.5),
        'b_rg_a': nrm((L, RNN_BLOCKS, RNN_BLOCK_DIM), 0.01),
        'w_rg_x': nrm((L, RNN_BLOCKS, RNN_BLOCK_DIM, RNN_BLOCK_DIM), RNN_BLOCK_DIM ** -0.5),
        'b_rg_x': nrm((L, RNN_BLOCKS, RNN_BLOCK_DIM), 0.01),
        'lru_lambda': lru_lambda,
        'w_rnn_o': nrm((L, D_RNN, D_MODEL), D_RNN ** -0.5),
        'w_out': nrm((L, D_MODEL, D_MODEL), D_MODEL ** -0.5),
        'ffn_norm': gain((L, D_MODEL)),
        'w_peer_q': nrm((L, D_MODEL, PEER_HEADS * PEER_QUERY_DIM), D_MODEL ** -0.5),
        'peer_subkeys': nrm((L, PEER_HEADS, 2, N_KEYS, PEER_HALF), PEER_HALF ** -0.5),
        'peer_u': nrm((L, N_EXPERTS, D_MODEL), D_MODEL ** -0.5),
        'peer_v': nrm((L, N_EXPERTS, D_MODEL), PEER_HEADS ** -0.5),
        'ple_norm': gain((L, D_MODEL)),
        'w_ple_gate': nrm((L, D_MODEL, D_MODEL), D_MODEL ** -0.5),
        'w_ple_proj': nrm((L, PLE_DIM, D_MODEL), PLE_DIM ** -0.5),
        'final_norm': gain((D_MODEL,)),
    }


def reference(x, p, attn_norm, w_in, b_gate, q_norm, w_uq, kv_norm, w_ukv, w_attn_o,
              conv_w, conv_b, w_rg_a, b_rg_a, w_rg_x, b_rg_x, lru_lambda, w_rnn_o, w_out,
              ffn_norm, w_peer_q, peer_subkeys, peer_u, peer_v, ple_norm, w_ple_gate,
              w_ple_proj, final_norm):
    h = x
    for l in range(DEPTH):
        n = rms_norm(h, attn_norm[l])
        c_q, c_kv, k_r, x_r, y_r, ga, gr = split_columns(n @ w_in[l])
        g_attn = jax.nn.sigmoid(ga + b_gate[l, :D_MODEL])
        g_rnn = jax.nn.sigmoid(gr + b_gate[l, D_MODEL:])
        y_attn = mla_branch(c_q, c_kv, k_r, q_norm[l], w_uq[l], kv_norm[l], w_ukv[l], w_attn_o[l])
        y_rnn = rglru_branch(x_r, y_r, conv_w[l], conv_b[l], w_rg_a[l], b_rg_a[l],
                             w_rg_x[l], b_rg_x[l], lru_lambda[l], w_rnn_o[l])
        h = h + (g_attn * y_attn + g_rnn * y_rnn) @ w_out[l]
        h = h + peer_ffn(rms_norm(h, ffn_norm[l]), w_peer_q[l], peer_subkeys[l], peer_u[l], peer_v[l])
        gate = jax.nn.sigmoid(rms_norm(h, ple_norm[l]) @ w_ple_gate[l])
        h = h + gate * (p[l] @ w_ple_proj[l])
    return rms_norm(h, final_norm)
```

```cpp
#include <hip/hip_runtime.h>
#include <hip/hip_cooperative_groups.h>
#include <cstdio>
#include <cstdint>
namespace cg = cooperative_groups;

#define DEV __device__ __forceinline__
typedef unsigned short bf16_t;
typedef float f32x4 __attribute__((ext_vector_type(4)));
typedef float f32x2 __attribute__((ext_vector_type(2)));
typedef unsigned u32x2 __attribute__((ext_vector_type(2)));
typedef unsigned u32x4 __attribute__((ext_vector_type(4)));

constexpr int S = 8192, DM = 2048, PLE = 256;
constexpr int NH = 16, DN = 128, DR = 64, DV = 128;
constexpr int QL = 768, KVL = 512;
constexpr int NBLK = 16, BD = 128;
constexpr int PH = 8, NK = 128, TOPK = 16;
constexpr int NIN_PAD = 9728;
constexpr float EPS = 1e-6f;
constexpr float QSCALE = 0.07216878364870322f * 1.4426950408889634f;
constexpr int NTHREADS = 512;
#ifndef DBG_PEER
#define DBG_PEER 1
#endif
constexpr int LDS_BYTES = 147456;

constexpr size_t MiB = 1u << 20;
constexpr size_t WS_WIN = 0, WS_WUQ = 38 * MiB, WS_WUKV = WS_WUQ + 9 * MiB / 2, WS_WAO = WS_WUKV + 4 * MiB, WS_WRO = WS_WAO + 8 * MiB,
                 WS_WOUT = WS_WRO + 8 * MiB, WS_WPQ = WS_WOUT + 8 * MiB, WS_WPG = WS_WPQ + 8 * MiB, WS_WPP = WS_WPG + 8 * MiB,
                 WS_WG = WS_WPP + 1 * MiB, WS_WSK = WS_WG + 1 * MiB, WS_ROPE = WS_WSK + 1 * MiB, WS_PB = WS_ROPE + 2 * MiB, WS_SMALL = WS_PB + 4 * MiB;
static_assert(WS_SMALL == 95 * MiB + MiB / 2, "ws map");
constexpr size_t WS_A0 = 96 * MiB;
constexpr size_t WS_A2 = 128 * MiB;
constexpr size_t WS_A3 = 160 * MiB;
constexpr size_t WS_A4 = 192 * MiB;
constexpr size_t WS_A5 = 224 * MiB;
constexpr size_t WS_A6 = 256 * MiB;
constexpr size_t WS_A7 = 288 * MiB;
constexpr size_t WS_A8 = 320 * MiB;
constexpr size_t WS_A9 = 352 * MiB;
constexpr size_t WS_KPE = 368 * MiB;
constexpr size_t WS_TU = 384 * MiB, WS_TV = 448 * MiB, WS_END = 512 * MiB;
constexpr int SM_SSQ0 = 0, SM_SSQQ = 8192, SM_SSQKV = 24576, SM_SSQ1 = 40960, SM_SSQ3 = 57344, SM_N8SP = 73728;
typedef unsigned long long u64;

DEV unsigned f2bf(float f) { unsigned u = __float_as_uint(f); return (u + 0x7fffu + ((u >> 16) & 1u)) >> 16; }
DEV unsigned pk2(float lo, float hi) { return f2bf(lo) | (f2bf(hi) << 16); }
DEV float bflo(unsigned w) { return __uint_as_float(w << 16); }
DEV float bfhi(unsigned w) { return __uint_as_float(w & 0xffff0000u); }
DEV u32x2 pk4(f32x4 v) { u32x2 r; r.x = pk2(v[0], v[1]); r.y = pk2(v[2], v[3]); return r; }
DEV f32x4 unpk4(u32x2 w) { return (f32x4){bflo(w.x), bfhi(w.x), bflo(w.y), bfhi(w.y)}; }
DEV float sigmoidf_(float x) { return 1.f / (1.f + __expf(-x)); }
DEV float gelu_tanh(float x) { const float y = 0.7978845608028654f * (x + 0.044715f * x * x * x); const float t = 1.f - 2.f / (1.f + __expf(2.f * y)); return 0.5f * x * (1.f + t); }
DEV float wave_sum(float v) {
#pragma unroll
    for (int o = 1; o < 64; o <<= 1) v += __shfl_xor(v, o);
    return v;
}

struct Params { const float* in[28]; float* out; unsigned char* ws; int ph_lo, ph_hi; };
enum { I_X = 0, I_P, I_ATTN_NORM, I_W_IN, I_B_GATE, I_Q_NORM, I_W_UQ, I_KV_NORM, I_W_UKV, I_W_ATTN_O, I_CONV_W, I_CONV_B, I_W_RG_A, I_B_RG_A, I_W_RG_X,
       I_B_RG_X, I_LAMBDA, I_W_RNN_O, I_W_OUT, I_FFN_NORM, I_W_PEER_Q, I_SUBKEYS, I_PEER_U, I_PEER_V, I_PLE_NORM, I_W_PLE_GATE, I_W_PLE_PROJ, I_FINAL_NORM };

struct MapIdent { DEV int operator()(int n) const { return n; } };
struct MapWin { DEV int operator()(int n) const {
    if (n < 1280) return n;
    if (n < 1344) { const int j = n - 1280, g = j >> 5, w = j & 31; return 1280 + ((w < 16) ? (16 * g + w) : (32 + 16 * g + (w - 16))); }
    if (n < 1536) return -1;
    return n - 192; } };
struct MapWuq { DEV int operator()(int n) const {
    if (n < 2048) { const int h = n >> 7, d = n & 127; return h * 192 + d; }
    const int r = n - 2048, h = r >> 6, j = r & 63, g = j >> 5, w = j & 31;
    return h * 192 + 128 + ((w < 16) ? (16 * g + w) : (32 + 16 * g + (w - 16))); } };

template <class MAP>
DEV void transpose_items(float* lds, const float* W, int K, int N, int Nd, bf16_t* WT, const float* gain, float scale, MAP map, int& item_base, int gw, int ngw) {
    const int tid = threadIdx.x;
    const int nkt = K / 64, nnt = Nd / 64, nitems = nkt * nnt;
    float* T = lds;
    for (int it = 0; it < nitems; ++it) {
        if (((item_base + it) % ngw) != gw) continue;
        const int kt = it % nkt, nt = it / nkt, k0 = kt * 64, n0 = nt * 64;
        __syncthreads();
        {
            const int c4 = (tid & 15) * 4, src = map(n0 + c4);
#pragma unroll
            for (int h = 0; h < 2; ++h) { const int kk = (tid >> 4) + 32 * h;
                f32x4 v = (f32x4){0.f, 0.f, 0.f, 0.f};
                if (src >= 0) v = *(const f32x4*)(W + (size_t)(k0 + kk) * N + src);
                const float g = (gain ? gain[k0 + kk] : 1.f) * scale;
                T[kk * 65 + c4 + 0] = v[0] * g; T[kk * 65 + c4 + 1] = v[1] * g; T[kk * 65 + c4 + 2] = v[2] * g; T[kk * 65 + c4 + 3] = v[3] * g; }
        }
        __syncthreads();
        {
            const int n = tid >> 3, kc = (tid & 7) * 8;
            u32x4 o;
            o.x = pk2(T[(kc + 0) * 65 + n], T[(kc + 1) * 65 + n]); o.y = pk2(T[(kc + 2) * 65 + n], T[(kc + 3) * 65 + n]);
            o.z = pk2(T[(kc + 4) * 65 + n], T[(kc + 5) * 65 + n]); o.w = pk2(T[(kc + 6) * 65 + n], T[(kc + 7) * 65 + n]);
            *(u32x4*)(WT + (size_t)(n0 + n) * K + k0 + kc) = o;
        }
    }
    item_base += nitems;
}

struct Unit { int pm, pn, b; };
struct GemmDesc { const bf16_t* A; int lda; long a_bs; const bf16_t* Bt; int ldb; long b_bs; int nM, nN, nB, K; };
template <class Epi>
DEV void gemm_simple(float* lds, const GemmDesc g, const Epi& E) {
    const int tid = threadIdx.x, lane = tid & 63, wid = tid >> 6, wr = wid >> 2, wc = wid & 3, fr = lane & 15, fq = lane >> 4;
    float* As = lds; float* Bs = lds + 256 * 20;
    const int total = g.nM * g.nN * g.nB;
    for (int u = blockIdx.x; u < total; u += gridDim.x) {
        Unit un; un.pm = u % g.nM; un.pn = (u / g.nM) % g.nN; un.b = u / (g.nM * g.nN);
        const bf16_t* Ab = g.A + (size_t)un.b * g.a_bs + (size_t)un.pm * 256 * g.lda;
        const bf16_t* Bb = g.Bt + (size_t)un.b * g.b_bs + (size_t)un.pn * 256 * g.ldb;
        f32x4 acc[2][2][4][2];
#pragma unroll
        for (int a = 0; a < 2; ++a)
#pragma unroll
            for (int b = 0; b < 2; ++b)
#pragma unroll
                for (int m = 0; m < 4; ++m)
#pragma unroll
                    for (int n = 0; n < 2; ++n) acc[a][b][m][n] = (f32x4){0.f, 0.f, 0.f, 0.f};
        for (int k0 = 0; k0 < g.K; k0 += 16) {
            __syncthreads();
            { const int r = tid >> 1, kk = (tid & 1) * 8;
              const u32x4 a = *(const u32x4*)(Ab + (size_t)r * g.lda + k0 + kk);
              const u32x4 b = *(const u32x4*)(Bb + (size_t)r * g.ldb + k0 + kk);
              float* ap = As + r * 20 + kk; float* bp = Bs + r * 20 + kk;
              *(f32x4*)ap = (f32x4){bflo(a.x), bfhi(a.x), bflo(a.y), bfhi(a.y)}; *(f32x4*)(ap + 4) = (f32x4){bflo(a.z), bfhi(a.z), bflo(a.w), bfhi(a.w)};
              *(f32x4*)bp = (f32x4){bflo(b.x), bfhi(b.x), bflo(b.y), bfhi(b.y)}; *(f32x4*)(bp + 4) = (f32x4){bflo(b.z), bfhi(b.z), bflo(b.w), bfhi(b.w)}; }
            __syncthreads();
#pragma unroll 1
            for (int k4 = 0; k4 < 16; k4 += 4) {
#pragma unroll
                for (int ai = 0; ai < 2; ++ai) {
                    f32x4 av[4];
#pragma unroll
                    for (int m = 0; m < 4; ++m) av[m] = *(const f32x4*)(As + (ai * 128 + wr * 64 + m * 16 + fr) * 20 + k4);
#pragma unroll
                    for (int bj = 0; bj < 2; ++bj)
#pragma unroll
                        for (int n = 0; n < 2; ++n)
#pragma unroll
                            for (int i = 0; i < 4; ++i) {
                                const f32x4 b = *(const f32x4*)(Bs + (bj * 128 + wc * 32 + n * 16 + fq * 4 + i) * 20 + k4);
#pragma unroll
                                for (int m = 0; m < 4; ++m) { const f32x4 a = av[m]; float c = acc[ai][bj][m][n][i];
                                    c = fmaf(a[0], b[0], c); c = fmaf(a[1], b[1], c); c = fmaf(a[2], b[2], c); c = fmaf(a[3], b[3], c); acc[ai][bj][m][n][i] = c; }
                                asm volatile("" ::: "memory");
                            }
                }
            }
        }
        { int fr2 = fr, fq2 = fq, wr2 = wr, wc2 = wc; asm volatile("" : "+v"(fr2), "+v"(fq2), "+v"(wr2), "+v"(wc2));
          E(acc, un, wr2, wc2, fr2, fq2); }
    }
}

#define EPI_ARGS const f32x4 (&acc)[2][2][4][2], const Unit& u, int wr, int wc, int fr, int fq
#define ROW_OF(ai, m) (u.pm * 256 + (ai) * 128 + wr * 64 + (m) * 16 + fr)
#define COL_OF(bj, n) (u.pn * 256 + (bj) * 128 + wc * 32 + (n) * 16 + fq * 4)
#define FOR_AI_M _Pragma("unroll") for (int ai = 0; ai < 2; ++ai) _Pragma("unroll") for (int m = 0; m < 4; ++m)
#define FOR_BJ_N _Pragma("unroll") for (int bj = 0; bj < 2; ++bj) _Pragma("unroll") for (int n = 0; n < 2; ++n)

DEV float sumsq4(f32x4 v) { return (v[0] * v[0] + v[1] * v[1]) + (v[2] * v[2] + v[3] * v[3]); }
DEV void row_atomic(u64* dst, int row, float s, int fq) { s += __shfl_xor(s, 16); s += __shfl_xor(s, 32); if (fq == 0) atomicAdd(dst + row, (u64)(s * 4294967296.f)); }
DEV float ssq_get(const u64* p, int row) { return (float)p[row] * 2.3283064365386963e-10f; }

struct EpiIn {
    const float* ssq0; const float* rope; const float* b_gate;
    bf16_t *cq, *kpe, *xr, *gy; u64 *ssqq;
    DEV void operator()(EPI_ARGS) const {
        const int pn = u.pn;
#define FENCE __builtin_amdgcn_sched_barrier(0)
        if (pn < 5) {
            FOR_AI_M { const int row = ROW_OF(ai, m); const float rs = rsqrtf(ssq0[row] * (1.f / DM) + EPS);
                float s = 0.f;
                const size_t ro = pn < 3 ? (size_t)row * QL : (size_t)6 * 1024 * 1024 + (size_t)row * KVL - 768;
                FOR_BJ_N { const f32x4 v = acc[ai][bj][m][n] * rs; s += sumsq4(v); *(u32x2*)(cq + ro + COL_OF(bj, n)) = pk4(v); }
                row_atomic(ssqq + (pn < 3 ? 0 : 8192), row, s, fq); FENCE; }
        } else if (pn == 5) {
            if (wc < 2) { FOR_AI_M { const int row = ROW_OF(ai, m); const float rs = rsqrtf(ssq0[row] * (1.f / DM) + EPS);
                const f32x4 x1 = acc[ai][0][m][0] * rs, x2 = acc[ai][0][m][1] * rs; f32x4 o1, o2;
#pragma unroll
                for (int i = 0; i < 4; ++i) { const f32x2 cs = *(const f32x2*)(rope + ((size_t)row * 32 + 16 * wc + 4 * fq + i) * 2);
                    o1[i] = x1[i] * cs.x - x2[i] * cs.y; o2[i] = x2[i] * cs.x + x1[i] * cs.y; }
                *(u32x2*)(kpe + (size_t)row * 64 + 32 * wc + 4 * fq) = pk4(o1); *(u32x2*)(kpe + (size_t)row * 64 + 32 * wc + 16 + 4 * fq) = pk4(o2); FENCE; } }
        } else {
            const int seg = (pn - 6) >> 3;
            bf16_t* dst = seg == 0 ? xr : gy + (size_t)(seg - 1) * (16 * 1024 * 1024);
            const int colb = (pn - 6 - 8 * seg) * 256 + wc * 32 + fq * 4;
            FOR_AI_M { const int row = ROW_OF(ai, m); const float rs = rsqrtf(ssq0[row] * (1.f / DM) + EPS);
                FOR_BJ_N { f32x4 v = acc[ai][bj][m][n] * rs; const int col = colb + bj * 128 + n * 16;
                    if (seg == 1) { v[0] = gelu_tanh(v[0]); v[1] = gelu_tanh(v[1]); v[2] = gelu_tanh(v[2]); v[3] = gelu_tanh(v[3]); }
                    if (seg >= 2) { const f32x4 bb = *(const f32x4*)(b_gate + (seg - 2) * DM + col);
                        v[0] = sigmoidf_(v[0] + bb[0]); v[1] = sigmoidf_(v[1] + bb[1]); v[2] = sigmoidf_(v[2] + bb[2]); v[3] = sigmoidf_(v[3] + bb[3]); }
                    *(u32x2*)(dst + (size_t)row * DM + col) = pk4(v); }
                FENCE; }
        }
    }
};
struct EpiQ {
    const u64* ssqq; const float* rope; bf16_t *qn, *qp;
    DEV void operator()(EPI_ARGS) const {
        if (u.pn < 8) {
            FOR_AI_M { const int row = ROW_OF(ai, m); const float rs = rsqrtf(ssq_get(ssqq, row) * (1.f / QL) + EPS);
                FOR_BJ_N { *(u32x2*)(qn + (size_t)row * DM + COL_OF(bj, n)) = pk4(acc[ai][bj][m][n] * rs); } FENCE; }
        } else {
            const int g = wc & 1;
            FOR_AI_M { const int row = ROW_OF(ai, m); const float rs = rsqrtf(ssq_get(ssqq, row) * (1.f / QL) + EPS);
                f32x2 cs[4];
#pragma unroll
                for (int i = 0; i < 4; ++i) cs[i] = *(const f32x2*)(rope + ((size_t)row * 32 + 16 * g + 4 * fq + i) * 2);
#pragma unroll
                for (int bj = 0; bj < 2; ++bj) { const f32x4 x1 = acc[ai][bj][m][0] * rs, x2 = acc[ai][bj][m][1] * rs; f32x4 o1, o2;
#pragma unroll
                    for (int i = 0; i < 4; ++i) { o1[i] = x1[i] * cs[i].x - x2[i] * cs[i].y; o2[i] = x2[i] * cs[i].x + x1[i] * cs[i].y; }
                    const int col = (u.pn - 8) * 256 + bj * 128 + wc * 32 + fq * 4;
                    *(u32x2*)(qp + (size_t)row * 1024 + col) = pk4(o1); *(u32x2*)(qp + (size_t)row * 1024 + col + 16) = pk4(o2); }
                FENCE; }
        }
    }
};
struct EpiKV {
    const u64* ssqkv; bf16_t *kn, *vv;
    DEV void operator()(EPI_ARGS) const {
        FOR_AI_M {
            const int row = ROW_OF(ai, m);
            const float rs = rsqrtf(ssq_get(ssqkv, row) * (1.f / KVL) + EPS);
            FOR_BJ_N { bf16_t* dst = bj == 0 ? kn : vv; *(u32x2*)(dst + (size_t)row * DM + u.pn * 128 + wc * 32 + n * 16 + fq * 4) = pk4(acc[ai][bj][m][n] * rs); }
        }
    }
};
struct EpiGates {
    const float *b_a, *b_x, *n8sp; const bf16_t* xc; bf16_t *la, *gx;
    DEV void operator()(EPI_ARGS) const {
        FOR_AI_M {
            const int row = ROW_OF(ai, m);
#pragma unroll
            for (int n = 0; n < 2; ++n) { const int c = u.b * 128 + wc * 32 + n * 16 + fq * 4;
                const f32x4 ba = *(const f32x4*)(b_a + c), bx = *(const f32x4*)(b_x + c), sp = *(const f32x4*)(n8sp + c);
                const f32x4 xv = unpk4(*(const u32x2*)(xc + (size_t)row * DM + c));
                f32x4 l, g;
#pragma unroll
                for (int i = 0; i < 4; ++i) { const float r = sigmoidf_(acc[ai][0][m][n][i] + ba[i]), ig = sigmoidf_(acc[ai][1][m][n][i] + bx[i]); l[i] = sp[i] * r; g[i] = ig * xv[i]; }
                *(u32x2*)(la + (size_t)row * DM + c) = pk4(l); *(u32x2*)(gx + (size_t)row * DM + c) = pk4(g); }
        }
    }
};
struct EpiMixA { const bf16_t* ga; bf16_t* mixa;
    DEV void operator()(EPI_ARGS) const { FOR_AI_M { const int row = ROW_OF(ai, m); FOR_BJ_N { const size_t o = (size_t)row * DM + COL_OF(bj, n);
        *(u32x2*)(mixa + o) = pk4(acc[ai][bj][m][n] * unpk4(*(const u32x2*)(ga + o))); } } } };
struct EpiMix { const bf16_t* gr; const bf16_t* mixa; bf16_t* mix;
    DEV void operator()(EPI_ARGS) const { FOR_AI_M { const int row = ROW_OF(ai, m); FOR_BJ_N { const size_t o = (size_t)row * DM + COL_OF(bj, n);
        const u32x2 ma = __builtin_nontemporal_load((const u32x2*)(mixa + o));
        *(u32x2*)(mix + o) = pk4(unpk4(ma) + acc[ai][bj][m][n] * unpk4(*(const u32x2*)(gr + o))); } } } };
struct EpiOut { const float* x; float* h1; bf16_t* h1b; u64* ssq1;
    DEV void operator()(EPI_ARGS) const { FOR_AI_M { const int row = ROW_OF(ai, m); float s = 0.f;
        FOR_BJ_N { const size_t o = (size_t)row * DM + COL_OF(bj, n); const f32x4 v = *(const f32x4*)(x + o) + acc[ai][bj][m][n]; s += sumsq4(v);
            *(f32x4*)(h1 + o) = v; *(u32x2*)(h1b + o) = pk4(v); }
        row_atomic(ssq1, row, s, fq); } } };
struct EpiPeerQ { const u64* ssq1; bf16_t* q;
    DEV void operator()(EPI_ARGS) const { FOR_AI_M { const int row = ROW_OF(ai, m); const float rs = rsqrtf(ssq_get(ssq1, row) * (1.f / DM) + EPS);
        FOR_BJ_N { *(u32x2*)(q + (size_t)row * DM + COL_OF(bj, n)) = pk4(acc[ai][bj][m][n] * rs); } } } };
struct EpiPlain { bf16_t* o;
    DEV void operator()(EPI_ARGS) const { FOR_AI_M { const int row = ROW_OF(ai, m); FOR_BJ_N { *(u32x2*)(o + (size_t)row * DM + COL_OF(bj, n)) = pk4(acc[ai][bj][m][n]); } } } };
struct EpiScores { float* sc;
    DEV void operator()(EPI_ARGS) const { FOR_AI_M { const int row = ROW_OF(ai, m); FOR_BJ_N { *(f32x4*)(sc + (size_t)row * DM + u.b * 256 + bj * 128 + wc * 32 + n * 16 + fq * 4) = acc[ai][bj][m][n]; } } } };
struct EpiPle { const bf16_t* pp; float* h; u64* ssq3;
    DEV void operator()(EPI_ARGS) const { FOR_AI_M { const int row = ROW_OF(ai, m); float s = 0.f;
        FOR_BJ_N { const size_t o = (size_t)row * DM + COL_OF(bj, n); const f32x4 a = acc[ai][bj][m][n], p4 = unpk4(*(const u32x2*)(pp + o)); f32x4 v = *(const f32x4*)(h + o);
            v[0] += sigmoidf_(a[0]) * p4[0]; v[1] += sigmoidf_(a[1]) * p4[1]; v[2] += sigmoidf_(a[2]) * p4[2]; v[3] += sigmoidf_(a[3]) * p4[3]; s += sumsq4(v);
            *(f32x4*)(h + o) = v; }
        row_atomic(ssq3, row, s, fq); } } };

DEV void attn_simple(float* lds, const bf16_t* qn, const bf16_t* qp, const bf16_t* kn, const bf16_t* kpe, const bf16_t* vv, bf16_t* o_out) {
    const int tid = threadIdx.x, sub = tid & 7, rloc = tid >> 3;
    float* Ks = lds;
    float* Vs = lds + 32 * 196;
    const int nunits = NH * (S / 64);
    for (int ui = blockIdx.x; ui < nunits; ui += gridDim.x) {
        const int h = ui & 15, qb = (S / 64 - 1) - (ui >> 4);
        const int t = qb * 64 + rloc;
        float q[24];
        { const u32x4 a = *(const u32x4*)(qn + (size_t)t * DM + h * 128 + sub * 16), b = *(const u32x4*)(qn + (size_t)t * DM + h * 128 + sub * 16 + 8);
          const u32x4 c = *(const u32x4*)(qp + (size_t)t * 1024 + h * 64 + sub * 8);
          q[0] = bflo(a.x); q[1] = bfhi(a.x); q[2] = bflo(a.y); q[3] = bfhi(a.y); q[4] = bflo(a.z); q[5] = bfhi(a.z); q[6] = bflo(a.w); q[7] = bfhi(a.w);
          q[8] = bflo(b.x); q[9] = bfhi(b.x); q[10] = bflo(b.y); q[11] = bfhi(b.y); q[12] = bflo(b.z); q[13] = bfhi(b.z); q[14] = bflo(b.w); q[15] = bfhi(b.w);
          q[16] = bflo(c.x); q[17] = bfhi(c.x); q[18] = bflo(c.y); q[19] = bfhi(c.y); q[20] = bflo(c.z); q[21] = bfhi(c.z); q[22] = bflo(c.w); q[23] = bfhi(c.w); }
        float o[16];
#pragma unroll
        for (int i = 0; i < 16; ++i) o[i] = 0.f;
        float mrun = -1e30f, l = 0.f;
        const int ntiles = 2 * qb + 2;
        for (int kt = 0; kt < ntiles; ++kt) {
            __syncthreads();
            {
                const int key = tid >> 4, c8 = (tid & 15) * 8; const size_t tk = (size_t)(kt * 32 + key);
                const u32x4 a = *(const u32x4*)(kn + tk * DM + h * 128 + c8), b = *(const u32x4*)(vv + tk * DM + h * 128 + c8);
                float* kd = Ks + key * 196 + c8; float* vd = Vs + key * 132 + c8;
                *(f32x4*)kd = (f32x4){bflo(a.x), bfhi(a.x), bflo(a.y), bfhi(a.y)}; *(f32x4*)(kd + 4) = (f32x4){bflo(a.z), bfhi(a.z), bflo(a.w), bfhi(a.w)};
                *(f32x4*)vd = (f32x4){bflo(b.x), bfhi(b.x), bflo(b.y), bfhi(b.y)}; *(f32x4*)(vd + 4) = (f32x4){bflo(b.z), bfhi(b.z), bflo(b.w), bfhi(b.w)};
                if (tid < 256) { const int key2 = tid >> 3, d8 = (tid & 7) * 8; const u32x4 c = *(const u32x4*)(kpe + (size_t)(kt * 32 + key2) * 64 + d8);
                    float* pd = Ks + key2 * 196 + 128 + d8;
                    *(f32x4*)pd = (f32x4){bflo(c.x), bfhi(c.x), bflo(c.y), bfhi(c.y)}; *(f32x4*)(pd + 4) = (f32x4){bflo(c.z), bfhi(c.z), bflo(c.w), bfhi(c.w)}; }
            }
            __syncthreads();
#pragma unroll 1
            for (int j0 = 0; j0 < 32; j0 += 8) {
                float sc[8]; float tmax = -1e30f;
#pragma unroll
                for (int jj = 0; jj < 8; ++jj) {
                    const float* kr = Ks + (j0 + jj) * 196;
                    float p = 0.f;
#pragma unroll
                    for (int d4 = 0; d4 < 4; ++d4) { const f32x4 kv = *(const f32x4*)(kr + sub * 16 + d4 * 4); p += (q[d4 * 4] * kv[0] + q[d4 * 4 + 1] * kv[1]) + (q[d4 * 4 + 2] * kv[2] + q[d4 * 4 + 3] * kv[3]); }
#pragma unroll
                    for (int d4 = 0; d4 < 2; ++d4) { const f32x4 kv = *(const f32x4*)(kr + 128 + sub * 8 + d4 * 4); p += (q[16 + d4 * 4] * kv[0] + q[17 + d4 * 4] * kv[1]) + (q[18 + d4 * 4] * kv[2] + q[19 + d4 * 4] * kv[3]); }
                    p += __shfl_xor(p, 1); p += __shfl_xor(p, 2); p += __shfl_xor(p, 4);
                    if (kt * 32 + j0 + jj > t) p = -__builtin_inff();
                    sc[jj] = p; tmax = fmaxf(tmax, p);
                }
                const float mn = fmaxf(mrun, tmax), alpha = exp2f(mrun - mn); mrun = mn;
                l *= alpha;
#pragma unroll
                for (int i = 0; i < 16; ++i) o[i] *= alpha;
#pragma unroll
                for (int jj = 0; jj < 8; ++jj) {
                    const float p = exp2f(sc[jj] - mn); l += p;
                    const float* vr = Vs + (j0 + jj) * 132 + sub * 16;
#pragma unroll
                    for (int d4 = 0; d4 < 4; ++d4) { const f32x4 v4 = *(const f32x4*)(vr + d4 * 4); o[d4 * 4] += p * v4[0]; o[d4 * 4 + 1] += p * v4[1]; o[d4 * 4 + 2] += p * v4[2]; o[d4 * 4 + 3] += p * v4[3]; }
                }
            }
        }
        const float il = 1.f / l;
        u32x4 w0, w1;
        w0.x = pk2(o[0] * il, o[1] * il); w0.y = pk2(o[2] * il, o[3] * il); w0.z = pk2(o[4] * il, o[5] * il); w0.w = pk2(o[6] * il, o[7] * il);
        w1.x = pk2(o[8] * il, o[9] * il); w1.y = pk2(o[10] * il, o[11] * il); w1.z = pk2(o[12] * il, o[13] * il); w1.w = pk2(o[14] * il, o[15] * il);
        *(u32x4*)(o_out + (size_t)t * DM + h * 128 + sub * 16) = w0; *(u32x4*)(o_out + (size_t)t * DM + h * 128 + sub * 16 + 8) = w1;
    }
}

DEV void wave_argmax(float& v, int& idx) {
#pragma unroll
    for (int o = 1; o < 64; o <<= 1) { const float ov = __shfl_xor(v, o); const int oi = __shfl_xor(idx, o);
        if (ov > v || (ov == v && oi < idx)) { v = ov; idx = oi; } }
}
DEV void peer_phase(float* lds, const float* sc, const float* h1, const bf16_t* h1b, const u64* ssq1, const bf16_t* tu, const bf16_t* tv, float* h2, bf16_t* xn3) {
    const int tid = threadIdx.x, lane = tid & 63, wid = tid >> 6;
    int* ex = (int*)(lds + wid * 256);
    float* gt = lds + wid * 256 + 128;
    const float NEG = -__builtin_inff();
    for (int t = blockIdx.x * 8 + wid; t < S; t += gridDim.x * 8) {
        for (int h = 0; h < PH; ++h) {
            const float* sp = sc + (size_t)t * DM + h * 256;
            float tvv[2]; int tii[2];
#pragma unroll
            for (int c = 0; c < 2; ++c) {
                float a = sp[c * 128 + lane], b = sp[c * 128 + 64 + lane];
                float keepv = NEG; int keepi = 0;
                for (int r = 0; r < TOPK; ++r) {
                    float v; int idx; if (b > a) { v = b; idx = lane + 64; } else { v = a; idx = lane; }
                    wave_argmax(v, idx);
                    if (idx == lane) a = NEG; if (idx == lane + 64) b = NEG;
                    if (lane == r) { keepv = v; keepi = idx; }
                }
                tvv[c] = keepv; tii[c] = keepi;
            }
            const float a1 = __shfl(tvv[0], lane >> 2);
            float cv[4];
#pragma unroll
            for (int j = 0; j < 4; ++j) cv[j] = a1 + __shfl(tvv[1], (lane & 3) * 4 + j);
            float bs = NEG; int bc = 0;
            for (int r = 0; r < TOPK; ++r) {
                float v = cv[0]; int idx = lane * 4;
#pragma unroll
                for (int j = 1; j < 4; ++j) if (cv[j] > v) { v = cv[j]; idx = lane * 4 + j; }
                wave_argmax(v, idx);
                if ((idx >> 2) == lane) {
#pragma unroll
                    for (int j = 0; j < 4; ++j) if ((idx & 3) == j) cv[j] = NEG;
                }
                if (lane == r) { bs = v; bc = idx; }
            }
            const int i1 = __shfl(tii[0], bc >> 4), i2 = __shfl(tii[1], bc & 15);
            const float mx = __shfl(bs, 0);
            float e = (lane < 16) ? __expf(bs - mx) : 0.f;
            float sum = e;
#pragma unroll
            for (int o = 1; o < 16; o <<= 1) sum += __shfl_xor(sum, o);
            if (lane < 16) { ex[h * 16 + lane] = i1 * NK + i2; gt[h * 16 + lane] = e / sum; }
        }
        asm volatile("s_waitcnt lgkmcnt(0)" ::: "memory");
        const float rs1 = rsqrtf(ssq_get(ssq1, t) * (1.f / DM) + EPS);
        float hv[32];
#pragma unroll
        for (int j = 0; j < 4; ++j) { const u32x4 w = *(const u32x4*)(h1b + (size_t)t * DM + j * 512 + lane * 8);
            hv[j * 8 + 0] = bflo(w.x); hv[j * 8 + 1] = bfhi(w.x); hv[j * 8 + 2] = bflo(w.y); hv[j * 8 + 3] = bfhi(w.y);
            hv[j * 8 + 4] = bflo(w.z); hv[j * 8 + 5] = bfhi(w.z); hv[j * 8 + 6] = bflo(w.w); hv[j * 8 + 7] = bfhi(w.w); }
        float ac[32];
#pragma unroll
        for (int i = 0; i < 32; ++i) ac[i] = 0.f;
        for (int k = 0; k < PH * TOPK * DBG_PEER; ++k) {
            const int e = ex[k]; const float g = gt[k];
            const bf16_t* ur = tu + (size_t)e * DM + lane * 8; const bf16_t* vr = tv + (size_t)e * DM + lane * 8;
            u32x4 uw[4], vw[4];
#pragma unroll
            for (int j = 0; j < 4; ++j) { uw[j] = *(const u32x4*)(ur + j * 512); vw[j] = *(const u32x4*)(vr + j * 512); }
            float d = 0.f;
#pragma unroll
            for (int j = 0; j < 4; ++j) { d += hv[j * 8 + 0] * bflo(uw[j].x) + hv[j * 8 + 1] * bfhi(uw[j].x) + hv[j * 8 + 2] * bflo(uw[j].y) + hv[j * 8 + 3] * bfhi(uw[j].y)
                                             + hv[j * 8 + 4] * bflo(uw[j].z) + hv[j * 8 + 5] * bfhi(uw[j].z) + hv[j * 8 + 6] * bflo(uw[j].w) + hv[j * 8 + 7] * bfhi(uw[j].w); }
            d = wave_sum(d);
            const float w = g * gelu_tanh(d * rs1);
#pragma unroll
            for (int j = 0; j < 4; ++j) { ac[j * 8 + 0] += w * bflo(vw[j].x); ac[j * 8 + 1] += w * bfhi(vw[j].x); ac[j * 8 + 2] += w * bflo(vw[j].y); ac[j * 8 + 3] += w * bfhi(vw[j].y);
                                          ac[j * 8 + 4] += w * bflo(vw[j].z); ac[j * 8 + 5] += w * bfhi(vw[j].z); ac[j * 8 + 6] += w * bflo(vw[j].w); ac[j * 8 + 7] += w * bfhi(vw[j].w); }
        }
        float ss = 0.f;
#pragma unroll
        for (int j = 0; j < 4; ++j) { const size_t o = (size_t)t * DM + j * 512 + lane * 8;
            const f32x4 x0 = *(const f32x4*)(h1 + o), x1 = *(const f32x4*)(h1 + o + 4);
#pragma unroll
            for (int i = 0; i < 4; ++i) { ac[j * 8 + i] += x0[i]; ac[j * 8 + 4 + i] += x1[i]; }
#pragma unroll
            for (int i = 0; i < 8; ++i) ss += ac[j * 8 + i] * ac[j * 8 + i]; }
        ss = wave_sum(ss);
        const float rs2 = rsqrtf(ss * (1.f / DM) + EPS);
#pragma unroll
        for (int j = 0; j < 4; ++j) { const size_t o = (size_t)t * DM + j * 512 + lane * 8;
            *(f32x4*)(h2 + o) = (f32x4){ac[j * 8], ac[j * 8 + 1], ac[j * 8 + 2], ac[j * 8 + 3]}; *(f32x4*)(h2 + o + 4) = (f32x4){ac[j * 8 + 4], ac[j * 8 + 5], ac[j * 8 + 6], ac[j * 8 + 7]};
            u32x4 w; w.x = pk2(ac[j * 8] * rs2, ac[j * 8 + 1] * rs2); w.y = pk2(ac[j * 8 + 2] * rs2, ac[j * 8 + 3] * rs2); w.z = pk2(ac[j * 8 + 4] * rs2, ac[j * 8 + 5] * rs2); w.w = pk2(ac[j * 8 + 6] * rs2, ac[j * 8 + 7] * rs2);
            *(u32x4*)(xn3 + o) = w; }
    }
}

__global__ void __launch_bounds__(NTHREADS, 2) fwd_kernel(Params P) {
    extern __shared__ __attribute__((aligned(16))) unsigned char lds_raw[];
    float* lds = (float*)lds_raw;
    cg::grid_group grid = cg::this_grid();
    const int tid = threadIdx.x, lane = tid & 63, wid = tid >> 6;
    const int G = gridDim.x, bx = blockIdx.x;
    const int gtid = bx * NTHREADS + tid, gthreads = G * NTHREADS;
    const int gwave = bx * 8 + wid, gwaves = G * 8;
    unsigned char* ws = P.ws;
    float* small = (float*)(ws + WS_SMALL);
    float* rope = (float*)(ws + WS_ROPE);
    bf16_t* wt_in = (bf16_t*)(ws + WS_WIN); bf16_t* wt_uq = (bf16_t*)(ws + WS_WUQ); bf16_t* wt_ukv = (bf16_t*)(ws + WS_WUKV);
    bf16_t* wt_ao = (bf16_t*)(ws + WS_WAO); bf16_t* wt_ro = (bf16_t*)(ws + WS_WRO); bf16_t* wt_out = (bf16_t*)(ws + WS_WOUT);
    bf16_t* wt_pq = (bf16_t*)(ws + WS_WPQ); bf16_t* wt_pg = (bf16_t*)(ws + WS_WPG); bf16_t* wt_pp = (bf16_t*)(ws + WS_WPP);
    bf16_t* wt_g = (bf16_t*)(ws + WS_WG); bf16_t* wt_sk = (bf16_t*)(ws + WS_WSK); bf16_t* pb = (bf16_t*)(ws + WS_PB);
    bf16_t* tu = (bf16_t*)(ws + WS_TU); bf16_t* tvt = (bf16_t*)(ws + WS_TV);
    bf16_t* xb = (bf16_t*)(ws + WS_A0); bf16_t* xc = (bf16_t*)(ws + WS_A0); float* agg = (float*)(ws + WS_A0); bf16_t* h1b = (bf16_t*)(ws + WS_A0);
    bf16_t* Yb = (bf16_t*)(ws + WS_A2); bf16_t* qpeer = (bf16_t*)(ws + WS_A2);
    bf16_t* gy = (bf16_t*)(ws + WS_A3); float* scores = (float*)(ws + WS_A3);
    bf16_t* gat = (bf16_t*)(ws + WS_A4); bf16_t* grn = (bf16_t*)(ws + WS_A5); bf16_t* ppb = (bf16_t*)(ws + WS_A5);
    bf16_t* qn = (bf16_t*)(ws + WS_A6); bf16_t* kn = (bf16_t*)(ws + WS_A7); bf16_t* mixa = (bf16_t*)(ws + WS_A7); bf16_t* xn3 = (bf16_t*)(ws + WS_A7);
    bf16_t* vv = (bf16_t*)(ws + WS_A8); bf16_t* mix = (bf16_t*)(ws + WS_A8);
    bf16_t* qp = (bf16_t*)(ws + WS_A9); bf16_t* kpe = (bf16_t*)(ws + WS_KPE);
    bf16_t* cq = (bf16_t*)P.out; bf16_t* ckv = (bf16_t*)((unsigned char*)P.out + 12 * MiB); bf16_t* xr = (bf16_t*)((unsigned char*)P.out + 20 * MiB);
    bf16_t* la = (bf16_t*)P.out; bf16_t* gx = (bf16_t*)((unsigned char*)P.out + 32 * MiB);
    float* hres = P.out;

    const int lo = P.ph_lo, hi = P.ph_hi;
#ifndef PHMASK
#define PHMASK 0xFFFF
#endif
#define IN(k) (((PHMASK >> (k)) & 1) && lo <= (k) && (k) < hi)
#define SYNC_AFTER(k) do { if (IN(k) && IN((k) + 1)) { asm volatile("s_waitcnt vmcnt(0)" ::: "memory"); __syncthreads(); grid.sync(); \
        if (tid == 0) { __builtin_amdgcn_fence(__ATOMIC_ACQUIRE, "agent"); asm volatile("s_waitcnt vmcnt(0)" ::: "memory"); } __syncthreads(); } } while (0)

    if (IN(0)) {
        int ib = 0;
        transpose_items(lds, P.in[I_W_IN], DM, 9536, NIN_PAD, wt_in, P.in[I_ATTN_NORM], 1.f, MapWin(), ib, bx, G);
        transpose_items(lds, P.in[I_W_UQ], QL, 3072, 3072, wt_uq, P.in[I_Q_NORM], QSCALE, MapWuq(), ib, bx, G);
        transpose_items(lds, P.in[I_W_UKV], KVL, 4096, 4096, wt_ukv, P.in[I_KV_NORM], 1.f, MapIdent(), ib, bx, G);
        transpose_items(lds, P.in[I_W_ATTN_O], DM, DM, DM, wt_ao, nullptr, 1.f, MapIdent(), ib, bx, G);
        transpose_items(lds, P.in[I_W_RNN_O], DM, DM, DM, wt_ro, nullptr, 1.f, MapIdent(), ib, bx, G);
        transpose_items(lds, P.in[I_W_OUT], DM, DM, DM, wt_out, nullptr, 1.f, MapIdent(), ib, bx, G);
        transpose_items(lds, P.in[I_W_PEER_Q], DM, DM, DM, wt_pq, P.in[I_FFN_NORM], 1.f, MapIdent(), ib, bx, G);
        transpose_items(lds, P.in[I_W_PLE_GATE], DM, DM, DM, wt_pg, P.in[I_PLE_NORM], 1.f, MapIdent(), ib, bx, G);
        transpose_items(lds, P.in[I_W_PLE_PROJ], PLE, DM, DM, wt_pp, nullptr, 1.f, MapIdent(), ib, bx, G);
        for (int b = 0; b < NBLK; ++b) {
            transpose_items(lds, P.in[I_W_RG_A] + (size_t)b * BD * BD, BD, BD, BD, wt_g + (size_t)b * 256 * BD, nullptr, 1.f, MapIdent(), ib, bx, G);
            transpose_items(lds, P.in[I_W_RG_X] + (size_t)b * BD * BD, BD, BD, BD, wt_g + (size_t)b * 256 * BD + 128 * BD, nullptr, 1.f, MapIdent(), ib, bx, G);
        }
        for (int i = gtid; i < PH * 256 * 256; i += gthreads) { const int h = i >> 16, n = (i >> 8) & 255, k = i & 255, c = n >> 7;
            float v = 0.f; if ((k >> 7) == c) v = P.in[I_SUBKEYS][(((size_t)h * 2 + c) * NK + (n & 127)) * 128 + (k & 127)];
            wt_sk[i] = (bf16_t)f2bf(v); }
        { const float* pu = P.in[I_PEER_U]; const float* pv = P.in[I_PEER_V]; const float* gn = P.in[I_FFN_NORM];
          const size_t n8 = (size_t)NK * NK * DM / 8;
          for (size_t i = gtid; i < n8; i += gthreads) { const size_t o = i * 8; const int d = (int)(o & (DM - 1));
              const f32x4 a0 = *(const f32x4*)(pu + o), a1 = *(const f32x4*)(pu + o + 4), g0 = *(const f32x4*)(gn + d), g1 = *(const f32x4*)(gn + d + 4);
              const f32x4 b0 = *(const f32x4*)(pv + o), b1 = *(const f32x4*)(pv + o + 4);
              u32x4 w; w.x = pk2(a0[0] * g0[0], a0[1] * g0[1]); w.y = pk2(a0[2] * g0[2], a0[3] * g0[3]); w.z = pk2(a1[0] * g1[0], a1[1] * g1[1]); w.w = pk2(a1[2] * g1[2], a1[3] * g1[3]);
              *(u32x4*)(tu + o) = w;
              u32x4 w2; w2.x = pk2(b0[0], b0[1]); w2.y = pk2(b0[2], b0[3]); w2.z = pk2(b1[0], b1[1]); w2.w = pk2(b1[2], b1[3]);
              *(u32x4*)(tvt + o) = w2; } }
        for (int i = gtid; i < S * PLE / 4; i += gthreads) { const f32x4 v = *(const f32x4*)(P.in[I_P] + (size_t)i * 4); *(u32x2*)(pb + (size_t)i * 4) = pk4(v); }
        for (int t = gwave; t < S; t += gwaves) { const float* xrw = P.in[I_X] + (size_t)t * DM; float s = 0.f;
#pragma unroll
            for (int j = 0; j < 8; ++j) { const f32x4 v = *(const f32x4*)(xrw + j * 256 + lane * 4); s += sumsq4(v); *(u32x2*)(xb + (size_t)t * DM + j * 256 + lane * 4) = pk4(v); }
            s = wave_sum(s); if (lane == 0) small[SM_SSQ0 + t] = s; }
        for (int i = gtid; i < S * 32; i += gthreads) { const int t = i >> 5, j = i & 31; const float inv = 1.0f / powf(10000.f, (float)j / 32.f); const float ang = (float)t * inv;
            rope[2 * i] = cosf(ang); rope[2 * i + 1] = sinf(ang); }
        for (int i = gtid; i < 4 * 2 * S; i += gthreads) small[SM_SSQQ + i] = 0.f;
        for (int i = gtid; i < DM; i += gthreads) { const float lam = P.in[I_LAMBDA][i]; small[SM_N8SP + i] = -8.f * log1pf(__expf(-lam)); }
    }
    SYNC_AFTER(0);
    if (IN(1)) {
        GemmDesc g{xb, DM, 0, wt_in, DM, 0, S / 256, NIN_PAD / 256, 1, DM};
        static_assert(WS_A4 - WS_A3 == 32 * MiB && WS_A5 - WS_A4 == 32 * MiB && SM_SSQKV - SM_SSQQ == 16384, "EpiIn layout");
        EpiIn E{small + SM_SSQ0, rope, P.in[I_B_GATE], cq, kpe, xr, gy, (u64*)(small + SM_SSQQ)};
        gemm_simple(lds, g, E);
    }
    SYNC_AFTER(1);
    if (IN(2)) {
        { GemmDesc g{cq, QL, 0, wt_uq, QL, 0, S / 256, 12, 1, QL}; EpiQ E{(const u64*)(small + SM_SSQQ), rope, qn, qp}; gemm_simple(lds, g, E); }
        { GemmDesc g{ckv, KVL, 0, wt_ukv, KVL, 0, S / 256, 16, 1, KVL}; EpiKV E{(const u64*)(small + SM_SSQKV), kn, vv}; gemm_simple(lds, g, E); }
        const float* cw = P.in[I_CONV_W]; const float* cb = P.in[I_CONV_B];
        for (int i = gtid; i < S * DM / 4; i += gthreads) { const int t = i / (DM / 4), c = (i % (DM / 4)) * 4;
            f32x4 a = *(const f32x4*)(cb + c);
#pragma unroll
            for (int w = 0; w < 4; ++w) { const int tt = t - 3 + w; if (tt >= 0) a += *(const f32x4*)(cw + w * DM + c) * unpk4(*(const u32x2*)(xr + (size_t)tt * DM + c)); }
            *(u32x2*)(xc + (size_t)t * DM + c) = pk4(a); }
    }
    SYNC_AFTER(2);
    if (IN(3)) {
        attn_simple(lds, qn, qp, kn, kpe, vv, qn);
        GemmDesc g{xc, DM, BD, wt_g, BD, 256 * BD, S / 256, 1, NBLK, BD};
        EpiGates E{P.in[I_B_RG_A], P.in[I_B_RG_X], small + SM_N8SP, xc, la, gx};
        gemm_simple(lds, g, E);
    }
    SYNC_AFTER(3);
    if (IN(4)) {
        for (int i = gtid; i < 64 * (DM / 2); i += gthreads) { const int ch = i / (DM / 2), c = (i % (DM / 2)) * 2;
            float A0 = 1.f, B0 = 0.f, A1 = 1.f, B1 = 0.f;
            for (int tt = 0; tt < 128; ++tt) { const size_t o = (size_t)(ch * 128 + tt) * DM + c;
                const unsigned lw = *(const unsigned*)(la + o), gw = *(const unsigned*)(gx + o);
                const float l0 = bflo(lw), l1 = bfhi(lw); const float a0 = __expf(l0), a1 = __expf(l1);
                float m0 = sqrtf(fmaxf(-expm1f(2.f * l0), 0.f)), m1 = sqrtf(fmaxf(-expm1f(2.f * l1), 0.f));
                if (ch == 0 && tt == 0) { m0 = 1.f; m1 = 1.f; }
                A0 *= a0; B0 = a0 * B0 + m0 * bflo(gw); A1 *= a1; B1 = a1 * B1 + m1 * bfhi(gw); }
            *(f32x4*)(agg + ((size_t)ch * DM + c) * 2) = (f32x4){A0, B0, A1, B1}; }
    }
    SYNC_AFTER(4);
    if (IN(5)) {
        for (int i = gtid; i < 64 * (DM / 2); i += gthreads) { const int ch = i / (DM / 2), c = (i % (DM / 2)) * 2;
            float h0 = 0.f, h1v = 0.f;
            for (int cc = 0; cc < ch; ++cc) { const f32x4 ab = *(const f32x4*)(agg + ((size_t)cc * DM + c) * 2); h0 = ab[0] * h0 + ab[1]; h1v = ab[2] * h1v + ab[3]; }
            for (int tt = 0; tt < 128; ++tt) { const size_t o = (size_t)(ch * 128 + tt) * DM + c;
                const unsigned lw = *(const unsigned*)(la + o), gw = *(const unsigned*)(gx + o), yw = *(const unsigned*)(gy + o);
                const float l0 = bflo(lw), l1 = bfhi(lw); const float a0 = __expf(l0), a1 = __expf(l1);
                float m0 = sqrtf(fmaxf(-expm1f(2.f * l0), 0.f)), m1 = sqrtf(fmaxf(-expm1f(2.f * l1), 0.f));
                if (ch == 0 && tt == 0) { m0 = 1.f; m1 = 1.f; }
                h0 = a0 * h0 + m0 * bflo(gw); h1v = a1 * h1v + m1 * bfhi(gw);
                *(unsigned*)(Yb + o) = pk2(h0 * bflo(yw), h1v * bfhi(yw)); } }
    }
    SYNC_AFTER(5);
    if (IN(6)) {
        { GemmDesc g{qn, DM, 0, wt_ao, DM, 0, S / 256, 8, 1, DM}; EpiMixA E{gat, mixa}; gemm_simple(lds, g, E); }
        asm volatile("s_waitcnt vmcnt(0)" ::: "memory"); __syncthreads();
        { GemmDesc g{Yb, DM, 0, wt_ro, DM, 0, S / 256, 8, 1, DM}; EpiMix E{grn, mixa, mix}; gemm_simple(lds, g, E); }
    }
    SYNC_AFTER(6);
    if (IN(7)) { GemmDesc g{mix, DM, 0, wt_out, DM, 0, S / 256, 8, 1, DM}; EpiOut E{P.in[I_X], hres, h1b, (u64*)(small + SM_SSQ1)}; gemm_simple(lds, g, E); }
    SYNC_AFTER(7);
    if (IN(8)) {
        { GemmDesc g{h1b, DM, 0, wt_pq, DM, 0, S / 256, 8, 1, DM}; EpiPeerQ E{(const u64*)(small + SM_SSQ1), qpeer}; gemm_simple(lds, g, E); }
        { GemmDesc g{pb, PLE, 0, wt_pp, PLE, 0, S / 256, 8, 1, PLE}; EpiPlain E{ppb}; gemm_simple(lds, g, E); }
    }
    SYNC_AFTER(8);
    if (IN(9)) { GemmDesc g{qpeer, DM, 256, wt_sk, 256, 256 * 256, S / 256, 1, PH, 256}; EpiScores E{scores}; gemm_simple(lds, g, E); }
    SYNC_AFTER(9);
    if (IN(10)) peer_phase(lds, scores, hres, h1b, (const u64*)(small + SM_SSQ1), tu, tvt, hres, xn3);
    SYNC_AFTER(10);
    if (IN(11)) { GemmDesc g{xn3, DM, 0, wt_pg, DM, 0, S / 256, 8, 1, DM}; EpiPle E{ppb, hres, (u64*)(small + SM_SSQ3)}; gemm_simple(lds, g, E); }
    SYNC_AFTER(11);
    if (IN(12)) {
        const float* fn = P.in[I_FINAL_NORM];
        for (int i = gtid; i < S * DM / 4; i += gthreads) { const int t = i / (DM / 4), c = (i % (DM / 4)) * 4;
            const float rs = rsqrtf(ssq_get((const u64*)(small + SM_SSQ3), t) * (1.f / DM) + EPS);
            const f32x4 v = *(const f32x4*)(hres + (size_t)i * 4), g4 = *(const f32x4*)(fn + c);
            *(f32x4*)(hres + (size_t)i * 4) = v * rs * g4; }
    }
}

constexpr int NPHASES = 13;
#ifndef MK_N_LAUNCHES
#define MK_N_LAUNCHES 1
#endif

extern "C" void kernel_launch(void* const* d_in, const int* in_sizes, int n_in, void* d_out, int out_size, void* d_ws, size_t ws_size, hipStream_t stream) {
    static int grid = 0;
    if (grid == 0) {
        if (n_in != 28 || out_size != S * DM || ws_size < WS_END) { fprintf(stderr, "kernel_launch: unexpected shapes (n_in %d out %d ws %zu)\n", n_in, out_size, ws_size); grid = -1; return; }
        int dev = 0, cus = 0, per_cu = 0;
        (void)hipGetDevice(&dev);
        (void)hipDeviceGetAttribute(&cus, hipDeviceAttributeMultiprocessorCount, dev);
        if (hipFuncSetAttribute((const void*)fwd_kernel, hipFuncAttributeMaxDynamicSharedMemorySize, LDS_BYTES) != hipSuccess) { fprintf(stderr, "kernel_launch: hipFuncSetAttribute failed\n"); grid = -1; return; }
        if (hipOccupancyMaxActiveBlocksPerMultiprocessor(&per_cu, (const void*)fwd_kernel, NTHREADS, LDS_BYTES) != hipSuccess || per_cu < 1) { fprintf(stderr, "kernel_launch: occupancy query failed (%d)\n", per_cu); (void)hipGetLastError(); per_cu = 1; }
        if (per_cu > 1) per_cu = 1;
        grid = cus * per_cu;
        if (grid <= 0) grid = 256;
    }
    if (grid < 0) return;
    Params p{};
    for (int i = 0; i < 28; ++i) p.in[i] = (const float*)d_in[i];
    p.out = (float*)d_out; p.ws = (unsigned char*)d_ws;
    if (MK_N_LAUNCHES == 1) {
        p.ph_lo = 0; p.ph_hi = NPHASES;
        void* args[] = {&p};
        hipError_t e = hipLaunchCooperativeKernel((const void*)fwd_kernel, dim3(grid), dim3(NTHREADS), args, LDS_BYTES, stream);
        if (e != hipSuccess) fprintf(stderr, "cooperative launch failed: %s (grid %d)\n", hipGetErrorString(e), grid);
    } else {
        for (int k = 0; k < NPHASES; ++k) { p.ph_lo = k; p.ph_hi = k + 1; hipLaunchKernelGGL(fwd_kernel, dim3(grid), dim3(NTHREADS), LDS_BYTES, stream, p); }
    }
}
```

```cpp
#include <hip/hip_runtime.h>
#include <hip/hip_cooperative_groups.h>
#include <cstdio>
#include <cstdint>
namespace cg = cooperative_groups;

#define DEV __device__ __forceinline__
typedef unsigned short bf16_t;
typedef float f32x4 __attribute__((ext_vector_type(4)));
typedef float f32x2 __attribute__((ext_vector_type(2)));
typedef unsigned u32x2 __attribute__((ext_vector_type(2)));
typedef unsigned u32x4 __attribute__((ext_vector_type(4)));

constexpr int S = 8192, DM = 2048, PLE = 256;
constexpr int NH = 16, DN = 128, DR = 64, DV = 128;
constexpr int QL = 768, KVL = 512;
constexpr int NBLK = 16, BD = 128;
constexpr int PH = 8, NK = 128, TOPK = 16;
constexpr int NIN_PAD = 9728;
constexpr float EPS = 1e-6f;
constexpr float QSCALE = 0.07216878364870322f * 1.4426950408889634f;
constexpr int NTHREADS = 512;
#ifndef DBG_PEER
#define DBG_PEER 1
#endif
constexpr int LDS_BYTES = 147456;

constexpr size_t MiB = 1u << 20;
constexpr size_t WS_WIN = 0, WS_WUQ = 38 * MiB, WS_WUKV = WS_WUQ + 9 * MiB / 2, WS_WAO = WS_WUKV + 4 * MiB, WS_WRO = WS_WAO + 8 * MiB,
                 WS_WOUT = WS_WRO + 8 * MiB, WS_WPQ = WS_WOUT + 8 * MiB, WS_WPG = WS_WPQ + 8 * MiB, WS_WPP = WS_WPG + 8 * MiB,
                 WS_WG = WS_WPP + 1 * MiB, WS_WSK = WS_WG + 1 * MiB, WS_ROPE = WS_WSK + 1 * MiB, WS_PB = WS_ROPE + 2 * MiB, WS_SMALL = WS_PB + 4 * MiB;
static_assert(WS_SMALL == 95 * MiB + MiB / 2, "ws map");
constexpr size_t WS_A0 = 96 * MiB;
constexpr size_t WS_A2 = 128 * MiB;
constexpr size_t WS_A3 = 160 * MiB;
constexpr size_t WS_A4 = 192 * MiB;
constexpr size_t WS_A5 = 224 * MiB;
constexpr size_t WS_A6 = 256 * MiB;
constexpr size_t WS_A7 = 288 * MiB;
constexpr size_t WS_A8 = 320 * MiB;
constexpr size_t WS_A9 = 352 * MiB;
constexpr size_t WS_KPE = 368 * MiB;
constexpr size_t WS_TU = 384 * MiB, WS_TV = 448 * MiB, WS_END = 512 * MiB;
constexpr int SM_SSQ0 = 0, SM_SSQQ = 8192, SM_SSQKV = 24576, SM_SSQ1 = 40960, SM_SSQ3 = 57344, SM_N8SP = 73728;
typedef unsigned long long u64;

DEV unsigned f2bf(float f) { unsigned u = __float_as_uint(f); return (u + 0x7fffu + ((u >> 16) & 1u)) >> 16; }
DEV unsigned pk2(float lo, float hi) { return f2bf(lo) | (f2bf(hi) << 16); }
DEV float bflo(unsigned w) { return __uint_as_float(w << 16); }
DEV float bfhi(unsigned w) { return __uint_as_float(w & 0xffff0000u); }
DEV u32x2 pk4(f32x4 v) { u32x2 r; r.x = pk2(v[0], v[1]); r.y = pk2(v[2], v[3]); return r; }
DEV f32x4 unpk4(u32x2 w) { return (f32x4){bflo(w.x), bfhi(w.x), bflo(w.y), bfhi(w.y)}; }
DEV float sigmoidf_(float x) { return 1.f / (1.f + __expf(-x)); }
DEV float gelu_tanh(float x) { const float y = 0.7978845608028654f * (x + 0.044715f * x * x * x); const float t = 1.f - 2.f / (1.f + __expf(2.f * y)); return 0.5f * x * (1.f + t); }
DEV float wave_sum(float v) {
#pragma unroll
    for (int o = 1; o < 64; o <<= 1) v += __shfl_xor(v, o);
    return v;
}

struct Params { const float* in[28]; float* out; unsigned char* ws; int ph_lo, ph_hi; };
enum { I_X = 0, I_P, I_ATTN_NORM, I_W_IN, I_B_GATE, I_Q_NORM, I_W_UQ, I_KV_NORM, I_W_UKV, I_W_ATTN_O, I_CONV_W, I_CONV_B, I_W_RG_A, I_B_RG_A, I_W_RG_X,
       I_B_RG_X, I_LAMBDA, I_W_RNN_O, I_W_OUT, I_FFN_NORM, I_W_PEER_Q, I_SUBKEYS, I_PEER_U, I_PEER_V, I_PLE_NORM, I_W_PLE_GATE, I_W_PLE_PROJ, I_FINAL_NORM };

struct MapIdent { DEV int operator()(int n) const { return n; } };
struct MapWin { DEV int operator()(int n) const {
    if (n < 1280) return n;
    if (n < 1344) { const int j = n - 1280, g = j >> 5, w = j & 31; return 1280 + ((w < 16) ? (16 * g + w) : (32 + 16 * g + (w - 16))); }
    if (n < 1536) return -1;
    return n - 192; } };
struct MapWuq { DEV int operator()(int n) const {
    if (n < 2048) { const int h = n >> 7, d = n & 127; return h * 192 + d; }
    const int r = n - 2048, h = r >> 6, j = r & 63, g = j >> 5, w = j & 31;
    return h * 192 + 128 + ((w < 16) ? (16 * g + w) : (32 + 16 * g + (w - 16))); } };

template <class MAP>
DEV void transpose_items(float* lds, const float* W, int K, int N, int Nd, bf16_t* WT, const float* gain, float scale, MAP map, int& item_base, int gw, int ngw) {
    const int tid = threadIdx.x;
    const int nkt = K / 64, nnt = Nd / 64, nitems = nkt * nnt;
    float* T = lds;
    for (int it = 0; it < nitems; ++it) {
        if (((item_base + it) % ngw) != gw) continue;
        const int kt = it % nkt, nt = it / nkt, k0 = kt * 64, n0 = nt * 64;
        __syncthreads();
        {
            const int c4 = (tid & 15) * 4, src = map(n0 + c4);
#pragma unroll
            for (int h = 0; h < 2; ++h) { const int kk = (tid >> 4) + 32 * h;
                f32x4 v = (f32x4){0.f, 0.f, 0.f, 0.f};
                if (src >= 0) v = *(const f32x4*)(W + (size_t)(k0 + kk) * N + src);
                const float g = (gain ? gain[k0 + kk] : 1.f) * scale;
                T[kk * 65 + c4 + 0] = v[0] * g; T[kk * 65 + c4 + 1] = v[1] * g; T[kk * 65 + c4 + 2] = v[2] * g; T[kk * 65 + c4 + 3] = v[3] * g; }
        }
        __syncthreads();
        {
            const int n = tid >> 3, kc = (tid & 7) * 8;
            u32x4 o;
            o.x = pk2(T[(kc + 0) * 65 + n], T[(kc + 1) * 65 + n]); o.y = pk2(T[(kc + 2) * 65 + n], T[(kc + 3) * 65 + n]);
            o.z = pk2(T[(kc + 4) * 65 + n], T[(kc + 5) * 65 + n]); o.w = pk2(T[(kc + 6) * 65 + n], T[(kc + 7) * 65 + n]);
            *(u32x4*)(WT + (size_t)(n0 + n) * K + k0 + kc) = o;
        }
    }
    item_base += nitems;
}

struct Unit { int pm, pn, b; };
struct GemmDesc { const bf16_t* A; int lda; long a_bs; const bf16_t* Bt; int ldb; long b_bs; int nM, nN, nB, K; };
template <class Epi>
DEV void gemm_simple(float* lds, const GemmDesc g, const Epi& E) {
    const int tid = threadIdx.x, lane = tid & 63, wid = tid >> 6, wr = wid >> 2, wc = wid & 3, fr = lane & 15, fq = lane >> 4;
    float* As = lds; float* Bs = lds + 256 * 20;
    const int total = g.nM * g.nN * g.nB;
    for (int u = blockIdx.x; u < total; u += gridDim.x) {
        Unit un; un.pm = u % g.nM; un.pn = (u / g.nM) % g.nN; un.b = u / (g.nM * g.nN);
        const bf16_t* Ab = g.A + (size_t)un.b * g.a_bs + (size_t)un.pm * 256 * g.lda;
        const bf16_t* Bb = g.Bt + (size_t)un.b * g.b_bs + (size_t)un.pn * 256 * g.ldb;
        f32x4 acc[2][2][4][2];
#pragma unroll
        for (int a = 0; a < 2; ++a)
#pragma unroll
            for (int b = 0; b < 2; ++b)
#pragma unroll
                for (int m = 0; m < 4; ++m)
#pragma unroll
                    for (int n = 0; n < 2; ++n) acc[a][b][m][n] = (f32x4){0.f, 0.f, 0.f, 0.f};
        for (int k0 = 0; k0 < g.K; k0 += 16) {
            __syncthreads();
            { const int r = tid >> 1, kk = (tid & 1) * 8;
              const u32x4 a = *(const u32x4*)(Ab + (size_t)r * g.lda + k0 + kk);
              const u32x4 b = *(const u32x4*)(Bb + (size_t)r * g.ldb + k0 + kk);
              float* ap = As + r * 20 + kk; float* bp = Bs + r * 20 + kk;
              *(f32x4*)ap = (f32x4){bflo(a.x), bfhi(a.x), bflo(a.y), bfhi(a.y)}; *(f32x4*)(ap + 4) = (f32x4){bflo(a.z), bfhi(a.z), bflo(a.w), bfhi(a.w)};
              *(f32x4*)bp = (f32x4){bflo(b.x), bfhi(b.x), bflo(b.y), bfhi(b.y)}; *(f32x4*)(bp + 4) = (f32x4){bflo(b.z), bfhi(b.z), bflo(b.w), bfhi(b.w)}; }
            __syncthreads();
#pragma unroll 1
            for (int k4 = 0; k4 < 16; k4 += 4) {
#pragma unroll
                for (int ai = 0; ai < 2; ++ai) {
                    f32x4 av[4];
#pragma unroll
                    for (int m = 0; m < 4; ++m) av[m] = *(const f32x4*)(As + (ai * 128 + wr * 64 + m * 16 + fr) * 20 + k4);
#pragma unroll
                    for (int bj = 0; bj < 2; ++bj)
#pragma unroll
                        for (int n = 0; n < 2; ++n)
#pragma unroll
                            for (int i = 0; i < 4; ++i) {
                                const f32x4 b = *(const f32x4*)(Bs + (bj * 128 + wc * 32 + n * 16 + fq * 4 + i) * 20 + k4);
#pragma unroll
                                for (int m = 0; m < 4; ++m) { const f32x4 a = av[m]; float c = acc[ai][bj][m][n][i];
                                    c = fmaf(a[0], b[0], c); c = fmaf(a[1], b[1], c); c = fmaf(a[2], b[2], c); c = fmaf(a[3], b[3], c); acc[ai][bj][m][n][i] = c; }
                                asm volatile("" ::: "memory");
                            }
                }
            }
        }
        { int fr2 = fr, fq2 = fq, wr2 = wr, wc2 = wc; asm volatile("" : "+v"(fr2), "+v"(fq2), "+v"(wr2), "+v"(wc2));
          E(acc, un, wr2, wc2, fr2, fq2); }
    }
}

#define LAS __attribute__((address_space(3)))
typedef short bf16x8 __attribute__((ext_vector_type(8)));
constexpr int BM = 256, BK = 64, HALF = 128, HTB = HALF * BK * 2, STAGE_BYTES = 8 * HTB;
DEV int lds_byte(int r, int c) { const int st = (r >> 4) * 2 + (c >> 5), rr = r & 15, cc = c & 31, ob = rr * 64 + cc * 2; return st * 1024 + (ob ^ (((ob >> 9) & 1) << 5)); }
DEV void stage_rc(int b, int& R, int& C) { const int st = b / 1024, sb = b % 1024, swz = sb ^ (((sb >> 9) & 1) << 5); R = (st >> 1) * 16 + swz / 64; C = (st & 1) * 32 + (swz % 64) / 2; }
struct UnitOrder { int nM, nN, total, G, c;
    DEV bool next(int i, Unit& u) const { const int L = i * G + c; if (L >= total) return false; u.pm = L % nM; u.pn = (L / nM) % nN; u.b = L / (nM * nN); return true; } };
template <class Epi, bool ALIGN_EPI, bool SP2>
__device__ __forceinline__ void gemm_mfma(LAS unsigned char* lds, const GemmDesc g, const Epi& E) {
    const UnitOrder S{g.nM, g.nN, g.nM * g.nN * g.nB, (int)gridDim.x, (int)blockIdx.x};
    const int tid = threadIdx.x, wid = __builtin_amdgcn_readfirstlane(tid >> 6), lane = tid & 63, wr = wid >> 2, wc = wid & 3, fr = lane & 15, fq = lane >> 4;
    const int K = g.K, nt = K / BK;
    unsigned voffA[2], voffB[2];
#pragma unroll
    for (int i = 0; i < 2; ++i) { int R, C; stage_rc(tid * 16 + i * 8192, R, C); voffA[i] = (unsigned)(R * g.lda + C) * 2u; voffB[i] = (unsigned)(R * g.ldb + C) * 2u; }
    const size_t kstep = (size_t)(BK * 2);
    const size_t hstepA = (size_t)HALF * g.lda * 2, hstepB = (size_t)HALF * g.ldb * 2;
    const unsigned ldsw = (unsigned)wid * 1024u;
    const int aoff = lds_byte(wr * 64 + fr, fq * 8), boff = lds_byte(wc * 32 + fr, fq * 8);
#define PG8_SA(b, h) (((b) * 2 + (h)) * HTB)
#define PG8_SB(b, h) ((4 + (b) * 2 + (h)) * HTB)
#define PG8_STAGE(bufoff, gbase, voff) do { _Pragma("unroll") for (int _i = 0; _i < 2; ++_i) \
        __builtin_amdgcn_global_load_lds((const unsigned*)((const char*)(gbase) + (voff)[_i]), (LAS unsigned*)(lds + (bufoff) + ldsw + _i * 8192), 16, 0, 0); } while (0)
#define PG8_LDA(dst, b, h) do { _Pragma("unroll") for (int m = 0; m < 4; ++m) _Pragma("unroll") for (int k = 0; k < 2; ++k) dst[m][k] = *(const LAS bf16x8*)(lds + PG8_SA(b, h) + aoff + m * 2048 + k * 1024); } while (0)
#define PG8_LDB(dst, b, h) do { _Pragma("unroll") for (int n = 0; n < 2; ++n) _Pragma("unroll") for (int k = 0; k < 2; ++k) dst[n][k] = *(const LAS bf16x8*)(lds + PG8_SB(b, h) + boff + n * 2048 + k * 1024); } while (0)
#define PG8_MMA(ai, bj, At, Bt) do { __builtin_amdgcn_s_setprio(1); _Pragma("unroll") for (int m = 0; m < 4; ++m) _Pragma("unroll") for (int n = 0; n < 2; ++n) _Pragma("unroll") for (int k = 0; k < 2; ++k) \
        acc[ai][bj][m][n] = __builtin_amdgcn_mfma_f32_16x16x32_bf16(Bt[n][k], At[m][k], acc[ai][bj][m][n], 0, 0, 0); __builtin_amdgcn_s_setprio(0); } while (0)
#define PG8_WAIT_V(n) asm volatile("s_waitcnt vmcnt(" #n ")" ::: "memory")
#define PG8_WAIT_L(n) asm volatile("s_waitcnt lgkmcnt(" #n ")" ::: "memory")
#define PG8_BAR __builtin_amdgcn_s_barrier()
#define PG8_SCHED __builtin_amdgcn_sched_barrier(0)
    Unit cur, nxt; int ui = 0;
    if (!S.next(0, cur)) return;
    f32x4 acc[2][2][4][2];
#pragma unroll
    for (int a = 0; a < 2; ++a)
#pragma unroll
        for (int b = 0; b < 2; ++b)
#pragma unroll
            for (int m = 0; m < 4; ++m)
#pragma unroll
                for (int n = 0; n < 2; ++n) acc[a][b][m][n] = (f32x4){0.f, 0.f, 0.f, 0.f};
    bf16x8 At[4][2], B0[2][2], B1[2][2];
    const char* cA = (const char*)(g.A + (size_t)cur.b * g.a_bs) + (size_t)cur.pm * 2 * hstepA; const char* cB = (const char*)(g.Bt + (size_t)cur.b * g.b_bs) + (size_t)cur.pn * 2 * hstepB;
    if constexpr (SP2) {
        PG8_STAGE(PG8_SB(0, 0), cB, voffB); PG8_STAGE(PG8_SB(0, 1), cB + hstepB, voffB); PG8_STAGE(PG8_SA(0, 0), cA, voffA); PG8_STAGE(PG8_SA(0, 1), cA + hstepA, voffA);
        if (wr == 1) PG8_BAR;
        PG8_WAIT_V(2); PG8_BAR;
        PG8_STAGE(PG8_SB(1, 0), cB + kstep, voffB); PG8_STAGE(PG8_SA(1, 0), cA + kstep, voffA); PG8_STAGE(PG8_SB(1, 1), cB + hstepB + kstep, voffB);
        PG8_WAIT_V(6); PG8_BAR;
    } else {
        PG8_STAGE(PG8_SB(0, 0), cB, voffB); PG8_STAGE(PG8_SA(0, 0), cA, voffA); PG8_STAGE(PG8_SB(0, 1), cB + hstepB, voffB); PG8_STAGE(PG8_SA(0, 1), cA + hstepA, voffA);
        if (wr == 1) PG8_BAR;
        PG8_WAIT_V(4); PG8_BAR;
        PG8_STAGE(PG8_SB(1, 0), cB + kstep, voffB); PG8_STAGE(PG8_SA(1, 0), cA + kstep, voffA); PG8_STAGE(PG8_SB(1, 1), cB + hstepB + kstep, voffB);
        PG8_WAIT_V(6); PG8_BAR;
    }
    for (;;) {
        const bool has_next = S.next(ui + 1, nxt);
        const char* nA = has_next ? (const char*)(g.A + (size_t)nxt.b * g.a_bs) + (size_t)nxt.pm * 2 * hstepA : cA; const char* nB = has_next ? (const char*)(g.Bt + (size_t)nxt.b * g.b_bs) + (size_t)nxt.pn * 2 * hstepB : cB;
        for (int t = 0; t < nt; t += 2) {
            const bool last = (t == nt - 2);
            const char* a1 = cA + (size_t)(t + 1) * kstep;
            const char* a2 = last ? nA : cA + (size_t)(t + 2) * kstep; const char* b2 = last ? nB : cB + (size_t)(t + 2) * kstep;
            const char* a3 = a2 + kstep; const char* b3 = b2 + kstep;
            if constexpr (SP2) {
            PG8_LDB(B0, 0, 0); PG8_LDB(B1, 0, 1); PG8_SCHED; PG8_LDA(At, 0, 0); PG8_STAGE(PG8_SA(1, 1), a1 + hstepA, voffA);
            PG8_WAIT_V(8); PG8_WAIT_L(0); PG8_BAR; PG8_MMA(0, 0, At, B0); PG8_MMA(0, 1, At, B1); PG8_BAR; PG8_SCHED;
            PG8_LDA(At, 0, 1); PG8_STAGE(PG8_SB(0, 0), b2, voffB); PG8_STAGE(PG8_SB(0, 1), b2 + hstepB, voffB); PG8_STAGE(PG8_SA(0, 0), a2, voffA);
            PG8_WAIT_V(8); PG8_WAIT_L(0); PG8_BAR; PG8_MMA(1, 0, At, B0); PG8_MMA(1, 1, At, B1); PG8_BAR; PG8_SCHED;
            PG8_LDB(B0, 1, 0); PG8_LDB(B1, 1, 1); PG8_SCHED; PG8_LDA(At, 1, 0); PG8_STAGE(PG8_SA(0, 1), a2 + hstepA, voffA);
            PG8_WAIT_V(8); PG8_WAIT_L(0); PG8_BAR; PG8_MMA(0, 0, At, B0); PG8_MMA(0, 1, At, B1); PG8_BAR; PG8_SCHED;
            PG8_LDA(At, 1, 1); PG8_STAGE(PG8_SB(1, 0), b3, voffB); PG8_STAGE(PG8_SB(1, 1), b3 + hstepB, voffB); PG8_STAGE(PG8_SA(1, 0), a3, voffA);
            PG8_WAIT_V(8); PG8_WAIT_L(0); PG8_BAR; PG8_MMA(1, 0, At, B0); PG8_MMA(1, 1, At, B1); PG8_BAR; PG8_SCHED;
            } else {
            PG8_LDB(B0, 0, 0); PG8_SCHED; PG8_LDA(At, 0, 0); PG8_STAGE(PG8_SA(1, 1), a1 + hstepA, voffA);
            PG8_WAIT_L(8); PG8_BAR; PG8_WAIT_L(0); PG8_MMA(0, 0, At, B0); PG8_BAR; PG8_SCHED;
            PG8_LDB(B1, 0, 1); PG8_STAGE(PG8_SB(0, 0), b2, voffB);
            PG8_BAR; PG8_WAIT_L(0); PG8_MMA(0, 1, At, B1); PG8_BAR;
            PG8_LDA(At, 0, 1); PG8_STAGE(PG8_SA(0, 0), a2, voffA);
            PG8_BAR; PG8_WAIT_L(0); PG8_MMA(1, 0, At, B0); PG8_BAR; PG8_SCHED;
            PG8_STAGE(PG8_SB(0, 1), b2 + hstepB, voffB);
            PG8_WAIT_V(6); PG8_BAR; PG8_MMA(1, 1, At, B1); PG8_BAR;
            PG8_LDB(B0, 1, 0); PG8_SCHED; PG8_LDA(At, 1, 0); PG8_STAGE(PG8_SA(0, 1), a2 + hstepA, voffA);
            PG8_WAIT_L(8); PG8_BAR; PG8_WAIT_L(0); PG8_MMA(0, 0, At, B0); PG8_BAR; PG8_SCHED;
            PG8_LDB(B1, 1, 1); PG8_STAGE(PG8_SB(1, 0), b3, voffB);
            PG8_BAR; PG8_WAIT_L(0); PG8_MMA(0, 1, At, B1); PG8_BAR;
            PG8_LDA(At, 1, 1); PG8_STAGE(PG8_SA(1, 0), a3, voffA);
            PG8_BAR; PG8_WAIT_L(0); PG8_MMA(1, 0, At, B0); PG8_BAR; PG8_SCHED;
            PG8_STAGE(PG8_SB(1, 1), b3 + hstepB, voffB);
            PG8_WAIT_V(6); PG8_BAR; PG8_MMA(1, 1, At, B1); PG8_BAR;
            }
        }
        if constexpr (ALIGN_EPI) { if (wr == 0) PG8_BAR; }
        { int fr2 = fr, fq2 = fq, wr2 = wr, wc2 = wc; asm volatile("" : "+v"(fr2), "+v"(fq2), "+v"(wr2), "+v"(wc2)); E(acc, cur, wr2, wc2, fr2, fq2); }
        if (!has_next) break;
#pragma unroll
        for (int a = 0; a < 2; ++a)
#pragma unroll
            for (int b = 0; b < 2; ++b)
#pragma unroll
                for (int m = 0; m < 4; ++m)
#pragma unroll
                    for (int n = 0; n < 2; ++n) acc[a][b][m][n] = (f32x4){0.f, 0.f, 0.f, 0.f};
        cur = nxt; cA = nA; cB = nB; ++ui;
        if constexpr (ALIGN_EPI) { if (wr == 1) PG8_BAR; }
    }
    PG8_WAIT_V(0);
    if constexpr (!ALIGN_EPI) { if (wr == 0) PG8_BAR; }
    PG8_BAR;
#undef PG8_SA
#undef PG8_SB
#undef PG8_STAGE
#undef PG8_LDA
#undef PG8_LDB
#undef PG8_MMA
#undef PG8_WAIT_V
#undef PG8_WAIT_L
#undef PG8_BAR
#undef PG8_SCHED
}

#define EPI_ARGS const f32x4 (&acc)[2][2][4][2], const Unit& u, int wr, int wc, int fr, int fq
#define ROW_OF(ai, m) (u.pm * 256 + (ai) * 128 + wr * 64 + (m) * 16 + fr)
#define COL_OF(bj, n) (u.pn * 256 + (bj) * 128 + wc * 32 + (n) * 16 + fq * 4)
#define FOR_AI_M _Pragma("unroll") for (int ai = 0; ai < 2; ++ai) _Pragma("unroll") for (int m = 0; m < 4; ++m)
#define FOR_BJ_N _Pragma("unroll") for (int bj = 0; bj < 2; ++bj) _Pragma("unroll") for (int n = 0; n < 2; ++n)

DEV float sumsq4(f32x4 v) { return (v[0] * v[0] + v[1] * v[1]) + (v[2] * v[2] + v[3] * v[3]); }
DEV void row_atomic(u64* dst, int row, float s, int fq) { s += __shfl_xor(s, 16); s += __shfl_xor(s, 32); if (fq == 0) atomicAdd(dst + row, (u64)(s * 4294967296.f)); }
DEV float ssq_get(const u64* p, int row) { return (float)p[row] * 2.3283064365386963e-10f; }

struct EpiIn {
    const float* ssq0; const float* rope; const float* b_gate;
    bf16_t *cq, *kpe, *xr, *gy; u64 *ssqq;
    DEV void operator()(EPI_ARGS) const {
        const int pn = u.pn;
#define FENCE __builtin_amdgcn_sched_barrier(0)
        if (pn < 5) {
            FOR_AI_M { const int row = ROW_OF(ai, m); const float rs = rsqrtf(ssq0[row] * (1.f / DM) + EPS);
                float s = 0.f;
                const size_t ro = pn < 3 ? (size_t)row * QL : (size_t)6 * 1024 * 1024 + (size_t)row * KVL - 768;
                FOR_BJ_N { const f32x4 v = acc[ai][bj][m][n] * rs; s += sumsq4(v); *(u32x2*)(cq + ro + COL_OF(bj, n)) = pk4(v); }
                row_atomic(ssqq + (pn < 3 ? 0 : 8192), row, s, fq); FENCE; }
        } else if (pn == 5) {
            if (wc < 2) { FOR_AI_M { const int row = ROW_OF(ai, m); const float rs = rsqrtf(ssq0[row] * (1.f / DM) + EPS);
                const f32x4 x1 = acc[ai][0][m][0] * rs, x2 = acc[ai][0][m][1] * rs; f32x4 o1, o2;
#pragma unroll
                for (int i = 0; i < 4; ++i) { const f32x2 cs = *(const f32x2*)(rope + ((size_t)row * 32 + 16 * wc + 4 * fq + i) * 2);
                    o1[i] = x1[i] * cs.x - x2[i] * cs.y; o2[i] = x2[i] * cs.x + x1[i] * cs.y; }
                *(u32x2*)(kpe + (size_t)row * 64 + 32 * wc + 4 * fq) = pk4(o1); *(u32x2*)(kpe + (size_t)row * 64 + 32 * wc + 16 + 4 * fq) = pk4(o2); FENCE; } }
        } else {
            const int seg = (pn - 6) >> 3;
            bf16_t* dst = seg == 0 ? xr : gy + (size_t)(seg - 1) * (16 * 1024 * 1024);
            const int colb = (pn - 6 - 8 * seg) * 256 + wc * 32 + fq * 4;
            FOR_AI_M { const int row = ROW_OF(ai, m); const float rs = rsqrtf(ssq0[row] * (1.f / DM) + EPS);
                FOR_BJ_N { f32x4 v = acc[ai][bj][m][n] * rs; const int col = colb + bj * 128 + n * 16;
                    if (seg == 1) { v[0] = gelu_tanh(v[0]); v[1] = gelu_tanh(v[1]); v[2] = gelu_tanh(v[2]); v[3] = gelu_tanh(v[3]); }
                    if (seg >= 2) { const f32x4 bb = *(const f32x4*)(b_gate + (seg - 2) * DM + col);
                        v[0] = sigmoidf_(v[0] + bb[0]); v[1] = sigmoidf_(v[1] + bb[1]); v[2] = sigmoidf_(v[2] + bb[2]); v[3] = sigmoidf_(v[3] + bb[3]); }
                    *(u32x2*)(dst + (size_t)row * DM + col) = pk4(v); }
                FENCE; }
        }
    }
};
struct EpiQ {
    const u64* ssqq; const float* rope; bf16_t *qn, *qp;
    DEV void operator()(EPI_ARGS) const {
        if (u.pn < 8) {
            FOR_AI_M { const int row = ROW_OF(ai, m); const float rs = rsqrtf(ssq_get(ssqq, row) * (1.f / QL) + EPS);
                FOR_BJ_N { *(u32x2*)(qn + (size_t)row * DM + COL_OF(bj, n)) = pk4(acc[ai][bj][m][n] * rs); } FENCE; }
        } else {
            const int g = wc & 1;
            FOR_AI_M { const int row = ROW_OF(ai, m); const float rs = rsqrtf(ssq_get(ssqq, row) * (1.f / QL) + EPS);
                f32x2 cs[4];
#pragma unroll
                for (int i = 0; i < 4; ++i) cs[i] = *(const f32x2*)(rope + ((size_t)row * 32 + 16 * g + 4 * fq + i) * 2);
#pragma unroll
                for (int bj = 0; bj < 2; ++bj) { const f32x4 x1 = acc[ai][bj][m][0] * rs, x2 = acc[ai][bj][m][1] * rs; f32x4 o1, o2;
#pragma unroll
                    for (int i = 0; i < 4; ++i) { o1[i] = x1[i] * cs[i].x - x2[i] * cs[i].y; o2[i] = x2[i] * cs[i].x + x1[i] * cs[i].y; }
                    const int col = (u.pn - 8) * 256 + bj * 128 + wc * 32 + fq * 4;
                    *(u32x2*)(qp + (size_t)row * 1024 + col) = pk4(o1); *(u32x2*)(qp + (size_t)row * 1024 + col + 16) = pk4(o2); }
                FENCE; }
        }
    }
};
struct EpiKV {
    const u64* ssqkv; bf16_t *kn, *vv;
    DEV void operator()(EPI_ARGS) const {
        FOR_AI_M {
            const int row = ROW_OF(ai, m);
            const float rs = rsqrtf(ssq_get(ssqkv, row) * (1.f / KVL) + EPS);
            FOR_BJ_N { bf16_t* dst = bj == 0 ? kn : vv; *(u32x2*)(dst + (size_t)row * DM + u.pn * 128 + wc * 32 + n * 16 + fq * 4) = pk4(acc[ai][bj][m][n] * rs); }
        }
    }
};
struct EpiGates {
    const float *b_a, *b_x, *n8sp; const bf16_t* xc; bf16_t *la, *gx;
    DEV void operator()(EPI_ARGS) const {
        FOR_AI_M {
            const int row = ROW_OF(ai, m);
#pragma unroll
            for (int n = 0; n < 2; ++n) { const int c = u.b * 128 + wc * 32 + n * 16 + fq * 4;
                const f32x4 ba = *(const f32x4*)(b_a + c), bx = *(const f32x4*)(b_x + c), sp = *(const f32x4*)(n8sp + c);
                const f32x4 xv = unpk4(*(const u32x2*)(xc + (size_t)row * DM + c));
                f32x4 l, g;
#pragma unroll
                for (int i = 0; i < 4; ++i) { const float r = sigmoidf_(acc[ai][0][m][n][i] + ba[i]), ig = sigmoidf_(acc[ai][1][m][n][i] + bx[i]); l[i] = sp[i] * r; g[i] = ig * xv[i]; }
                *(u32x2*)(la + (size_t)row * DM + c) = pk4(l); *(u32x2*)(gx + (size_t)row * DM + c) = pk4(g); }
        }
    }
};
struct EpiMixA { const bf16_t* ga; bf16_t* mixa;
    DEV void operator()(EPI_ARGS) const { FOR_AI_M { const int row = ROW_OF(ai, m); FOR_BJ_N { const size_t o = (size_t)row * DM + COL_OF(bj, n);
        *(u32x2*)(mixa + o) = pk4(acc[ai][bj][m][n] * unpk4(*(const u32x2*)(ga + o))); } } } };
struct EpiMix { const bf16_t* gr; const bf16_t* mixa; bf16_t* mix;
    DEV void operator()(EPI_ARGS) const { FOR_AI_M { const int row = ROW_OF(ai, m); FOR_BJ_N { const size_t o = (size_t)row * DM + COL_OF(bj, n);
        const u32x2 ma = __builtin_nontemporal_load((const u32x2*)(mixa + o));
        *(u32x2*)(mix + o) = pk4(unpk4(ma) + acc[ai][bj][m][n] * unpk4(*(const u32x2*)(gr + o))); } } } };
struct EpiOut { const float* x; float* h1; bf16_t* h1b; u64* ssq1;
    DEV void operator()(EPI_ARGS) const { FOR_AI_M { const int row = ROW_OF(ai, m); float s = 0.f;
        FOR_BJ_N { const size_t o = (size_t)row * DM + COL_OF(bj, n); const f32x4 v = *(const f32x4*)(x + o) + acc[ai][bj][m][n]; s += sumsq4(v);
            *(f32x4*)(h1 + o) = v; *(u32x2*)(h1b + o) = pk4(v); }
        row_atomic(ssq1, row, s, fq); } } };
struct EpiPeerQ { const u64* ssq1; bf16_t* q;
    DEV void operator()(EPI_ARGS) const { FOR_AI_M { const int row = ROW_OF(ai, m); const float rs = rsqrtf(ssq_get(ssq1, row) * (1.f / DM) + EPS);
        FOR_BJ_N { *(u32x2*)(q + (size_t)row * DM + COL_OF(bj, n)) = pk4(acc[ai][bj][m][n] * rs); } } } };
struct EpiPlain { bf16_t* o;
    DEV void operator()(EPI_ARGS) const { FOR_AI_M { const int row = ROW_OF(ai, m); FOR_BJ_N { *(u32x2*)(o + (size_t)row * DM + COL_OF(bj, n)) = pk4(acc[ai][bj][m][n]); } } } };
struct EpiScores { float* sc;
    DEV void operator()(EPI_ARGS) const { FOR_AI_M { const int row = ROW_OF(ai, m); FOR_BJ_N { *(f32x4*)(sc + (size_t)row * DM + u.b * 256 + bj * 128 + wc * 32 + n * 16 + fq * 4) = acc[ai][bj][m][n]; } } } };
struct EpiPle { const bf16_t* pp; float* h; u64* ssq3;
    DEV void operator()(EPI_ARGS) const { FOR_AI_M { const int row = ROW_OF(ai, m); float s = 0.f;
        FOR_BJ_N { const size_t o = (size_t)row * DM + COL_OF(bj, n); const f32x4 a = acc[ai][bj][m][n], p4 = unpk4(*(const u32x2*)(pp + o)); f32x4 v = *(const f32x4*)(h + o);
            v[0] += sigmoidf_(a[0]) * p4[0]; v[1] += sigmoidf_(a[1]) * p4[1]; v[2] += sigmoidf_(a[2]) * p4[2]; v[3] += sigmoidf_(a[3]) * p4[3]; s += sumsq4(v);
            *(f32x4*)(h + o) = v; }
        row_atomic(ssq3, row, s, fq); } } };

DEV void attn_simple(float* lds, const bf16_t* qn, const bf16_t* qp, const bf16_t* kn, const bf16_t* kpe, const bf16_t* vv, bf16_t* o_out) {
    const int tid = threadIdx.x, sub = tid & 7, rloc = tid >> 3;
    float* Ks = lds;
    float* Vs = lds + 32 * 196;
    const int nunits = NH * (S / 64);
    for (int ui = blockIdx.x; ui < nunits; ui += gridDim.x) {
        const int h = ui & 15, qb = (S / 64 - 1) - (ui >> 4);
        const int t = qb * 64 + rloc;
        float q[24];
        { const u32x4 a = *(const u32x4*)(qn + (size_t)t * DM + h * 128 + sub * 16), b = *(const u32x4*)(qn + (size_t)t * DM + h * 128 + sub * 16 + 8);
          const u32x4 c = *(const u32x4*)(qp + (size_t)t * 1024 + h * 64 + sub * 8);
          q[0] = bflo(a.x); q[1] = bfhi(a.x); q[2] = bflo(a.y); q[3] = bfhi(a.y); q[4] = bflo(a.z); q[5] = bfhi(a.z); q[6] = bflo(a.w); q[7] = bfhi(a.w);
          q[8] = bflo(b.x); q[9] = bfhi(b.x); q[10] = bflo(b.y); q[11] = bfhi(b.y); q[12] = bflo(b.z); q[13] = bfhi(b.z); q[14] = bflo(b.w); q[15] = bfhi(b.w);
          q[16] = bflo(c.x); q[17] = bfhi(c.x); q[18] = bflo(c.y); q[19] = bfhi(c.y); q[20] = bflo(c.z); q[21] = bfhi(c.z); q[22] = bflo(c.w); q[23] = bfhi(c.w); }
        float o[16];
#pragma unroll
        for (int i = 0; i < 16; ++i) o[i] = 0.f;
        float mrun = -1e30f, l = 0.f;
        const int ntiles = 2 * qb + 2;
        for (int kt = 0; kt < ntiles; ++kt) {
            __syncthreads();
            {
                const int key = tid >> 4, c8 = (tid & 15) * 8; const size_t tk = (size_t)(kt * 32 + key);
                const u32x4 a = *(const u32x4*)(kn + tk * DM + h * 128 + c8), b = *(const u32x4*)(vv + tk * DM + h * 128 + c8);
                float* kd = Ks + key * 196 + c8; float* vd = Vs + key * 132 + c8;
                *(f32x4*)kd = (f32x4){bflo(a.x), bfhi(a.x), bflo(a.y), bfhi(a.y)}; *(f32x4*)(kd + 4) = (f32x4){bflo(a.z), bfhi(a.z), bflo(a.w), bfhi(a.w)};
                *(f32x4*)vd = (f32x4){bflo(b.x), bfhi(b.x), bflo(b.y), bfhi(b.y)}; *(f32x4*)(vd + 4) = (f32x4){bflo(b.z), bfhi(b.z), bflo(b.w), bfhi(b.w)};
                if (tid < 256) { const int key2 = tid >> 3, d8 = (tid & 7) * 8; const u32x4 c = *(const u32x4*)(kpe + (size_t)(kt * 32 + key2) * 64 + d8);
                    float* pd = Ks + key2 * 196 + 128 + d8;
                    *(f32x4*)pd = (f32x4){bflo(c.x), bfhi(c.x), bflo(c.y), bfhi(c.y)}; *(f32x4*)(pd + 4) = (f32x4){bflo(c.z), bfhi(c.z), bflo(c.w), bfhi(c.w)}; }
            }
            __syncthreads();
#pragma unroll 1
            for (int j0 = 0; j0 < 32; j0 += 8) {
                float sc[8]; float tmax = -1e30f;
#pragma unroll
                for (int jj = 0; jj < 8; ++jj) {
                    const float* kr = Ks + (j0 + jj) * 196;
                    float p = 0.f;
#pragma unroll
                    for (int d4 = 0; d4 < 4; ++d4) { const f32x4 kv = *(const f32x4*)(kr + sub * 16 + d4 * 4); p += (q[d4 * 4] * kv[0] + q[d4 * 4 + 1] * kv[1]) + (q[d4 * 4 + 2] * kv[2] + q[d4 * 4 + 3] * kv[3]); }
#pragma unroll
                    for (int d4 = 0; d4 < 2; ++d4) { const f32x4 kv = *(const f32x4*)(kr + 128 + sub * 8 + d4 * 4); p += (q[16 + d4 * 4] * kv[0] + q[17 + d4 * 4] * kv[1]) + (q[18 + d4 * 4] * kv[2] + q[19 + d4 * 4] * kv[3]); }
                    p += __shfl_xor(p, 1); p += __shfl_xor(p, 2); p += __shfl_xor(p, 4);
                    if (kt * 32 + j0 + jj > t) p = -__builtin_inff();
                    sc[jj] = p; tmax = fmaxf(tmax, p);
                }
                const float mn = fmaxf(mrun, tmax), alpha = exp2f(mrun - mn); mrun = mn;
                l *= alpha;
#pragma unroll
                for (int i = 0; i < 16; ++i) o[i] *= alpha;
#pragma unroll
                for (int jj = 0; jj < 8; ++jj) {
                    const float p = exp2f(sc[jj] - mn); l += p;
                    const float* vr = Vs + (j0 + jj) * 132 + sub * 16;
#pragma unroll
                    for (int d4 = 0; d4 < 4; ++d4) { const f32x4 v4 = *(const f32x4*)(vr + d4 * 4); o[d4 * 4] += p * v4[0]; o[d4 * 4 + 1] += p * v4[1]; o[d4 * 4 + 2] += p * v4[2]; o[d4 * 4 + 3] += p * v4[3]; }
                }
            }
        }
        const float il = 1.f / l;
        u32x4 w0, w1;
        w0.x = pk2(o[0] * il, o[1] * il); w0.y = pk2(o[2] * il, o[3] * il); w0.z = pk2(o[4] * il, o[5] * il); w0.w = pk2(o[6] * il, o[7] * il);
        w1.x = pk2(o[8] * il, o[9] * il); w1.y = pk2(o[10] * il, o[11] * il); w1.z = pk2(o[12] * il, o[13] * il); w1.w = pk2(o[14] * il, o[15] * il);
        *(u32x4*)(o_out + (size_t)t * DM + h * 128 + sub * 16) = w0; *(u32x4*)(o_out + (size_t)t * DM + h * 128 + sub * 16 + 8) = w1;
    }
}


typedef short s16x4 __attribute__((ext_vector_type(4)));
typedef float f32x16 __attribute__((ext_vector_type(16)));
constexpr int AT_SHM_V = 64 * 128 * 2, AT_SHM_K = 64 * 128 * 2, AT_SHM_P = 64 * 64 * 2;
constexpr int AT_V = 0, AT_K = 2 * AT_SHM_V, AT_P = AT_K + 2 * AT_SHM_K, AT_WS = AT_P + 2 * AT_SHM_P, AT_LDS = AT_WS + 8 * 64 * 4;
#define KSWZ(row, colB) ((row) * 256 + ((colB) ^ (((row) & 7) << 4)))
#define PSWZ(row, ch) ((row) * 128 + ((((ch) ^ (((row) >> 1) & 7))) << 4))
#define SBAR() __builtin_amdgcn_sched_barrier(0)
DEV int v_st(int k, int c) { const int kk = (k & ~0xC) | ((k & 4) << 1) | ((k & 8) >> 1); return ((kk >> 3) * 4 + (c >> 5)) * 512 + ((kk & 7) * 32 + (c & 31)) * 2; }
DEV int v_rd_base(int lane) { return ((lane & 3) << 3) | (((lane >> 2) & 3) << 6) | (((lane >> 4) & 1) << 5) | (((lane >> 5) & 1) << 8); }
constexpr int v_rd_off(int d0, int ks, int half) { return d0 * 512 + ks * 4096 + half * 2048; }
DEV int crow(int r, int hi) { return (r & 3) + 8 * (r >> 2) + 4 * hi; }
DEV unsigned cvtpk(float lo, float hi) { unsigned r; asm volatile("v_cvt_pk_bf16_f32 %0, %1, %2" : "=v"(r) : "v"(lo), "v"(hi)); return r; }
DEV void at_mask(f32x16& p0, f32x16& p1, int dq) {
    const float NEG = -__builtin_inff();
#pragma unroll
    for (int r = 0; r < 16; ++r) { const int c = (r & 3) + 8 * (r >> 2); if (dq - c < 0) p0[r] = NEG; if (dq - c - 32 < 0) p1[r] = NEG; }
}
constexpr float AT_THR = 11.5f;
DEV void at_partialSM(f32x16& p0, f32x16& p1, float& m_reg, float& alpha) {
    float pmax = p0[0];
#pragma unroll
    for (int r = 1; r < 16; ++r) pmax = fmaxf(pmax, p0[r]);
#pragma unroll
    for (int r = 0; r < 16; ++r) pmax = fmaxf(pmax, p1[r]);
    { auto rr = __builtin_amdgcn_permlane32_swap(__float_as_uint(pmax), __float_as_uint(pmax), false, false); pmax = fmaxf(__uint_as_float(rr[0]), __uint_as_float(rr[1])); }
    float mn;
    if (__builtin_expect(__all((pmax - m_reg) <= AT_THR), 1)) { mn = m_reg; alpha = 1.f; }
    else { mn = fmaxf(m_reg, pmax); alpha = __builtin_amdgcn_exp2f(m_reg - mn); m_reg = mn; }
#pragma unroll
    for (int r = 0; r < 16; ++r) { p0[r] = __builtin_amdgcn_exp2f(p0[r] - mn); p1[r] = __builtin_amdgcn_exp2f(p1[r] - mn); }
}
DEV void at_finishSM(const f32x16& p0, const f32x16& p1, float alpha, float& l_reg, bf16x8& pa0, bf16x8& pa1, bf16x8& pa2, bf16x8& pa3) {
    float ps = 0;
#pragma unroll
    for (int r = 0; r < 16; ++r) ps += p0[r];
#pragma unroll
    for (int r = 0; r < 16; ++r) ps += p1[r];
    { auto rr = __builtin_amdgcn_permlane32_swap(__float_as_uint(ps), __float_as_uint(ps), false, false); ps = __uint_as_float(rr[0]) + __uint_as_float(rr[1]); }
    l_reg = l_reg * alpha + ps;
#define PK4(P, B_, OUT) do { unsigned a0 = cvtpk(P[B_+0], P[B_+1]), a1 = cvtpk(P[B_+2], P[B_+3]); unsigned b0 = cvtpk(P[B_+4], P[B_+5]), b1 = cvtpk(P[B_+6], P[B_+7]); \
        auto r0 = __builtin_amdgcn_permlane32_swap(a0, b0, false, false); auto r1 = __builtin_amdgcn_permlane32_swap(a1, b1, false, false); \
        u32x4 w = {r0[0], r1[0], r0[1], r1[1]}; OUT = *reinterpret_cast<bf16x8*>(&w); } while (0)
    PK4(p0, 0, pa0); PK4(p0, 8, pa1); PK4(p1, 0, pa2); PK4(p1, 8, pa3);
#undef PK4
}
template <int KB>
DEV void at_qkt(f32x16& p0, f32x16& p1, const char* lds, int r32, int hi, const bf16x8* qr) {
    p0 = f32x16{}; p1 = f32x16{};
#pragma unroll
    for (int g = 0; g < 2; ++g) {
        bf16x8 b0[4], b1[4];
#pragma unroll
        for (int dd = 0; dd < 4; ++dd) { const char* a = lds + AT_K + KB * AT_SHM_K + KSWZ(r32, (dd * 16 + hi * 8) * 2) + g * 128;
            b0[dd] = *reinterpret_cast<const bf16x8*>(a); b1[dd] = *reinterpret_cast<const bf16x8*>(a + 32 * 256); }
#pragma unroll
        for (int dd = 0; dd < 4; ++dd) { p0 = __builtin_amdgcn_mfma_f32_32x32x16_bf16(b0[dd], qr[g * 4 + dd], p0, 0, 0, 0); p1 = __builtin_amdgcn_mfma_f32_32x32x16_bf16(b1[dd], qr[g * 4 + dd], p1, 0, 0, 0); }
        SBAR();
    }
    {
        bf16x8 b0[4], b1[4];
#pragma unroll
        for (int d0 = 0; d0 < 4; ++d0) { const char* a = lds + AT_P + KB * AT_SHM_P + PSWZ(r32, 2 * d0 + hi);
            b0[d0] = *reinterpret_cast<const bf16x8*>(a); b1[d0] = *reinterpret_cast<const bf16x8*>(a + 32 * 128); }
#pragma unroll
        for (int d0 = 0; d0 < 4; ++d0) { p0 = __builtin_amdgcn_mfma_f32_32x32x16_bf16(b0[d0], qr[8 + d0], p0, 0, 0, 0); p1 = __builtin_amdgcn_mfma_f32_32x32x16_bf16(b1[d0], qr[8 + d0], p1, 0, 0, 0); }
        SBAR();
    }
}
template <int VB>
DEV void at_pv(f32x16* o, int vb0, bf16x8 pa0, bf16x8 pa1, bf16x8 pa2, bf16x8 pa3) {
#define TRRD(dst, off) asm volatile("ds_read_b64_tr_b16 %0, %1 offset:%2" : "=&v"(dst) : "v"(vb0), "i"(off) : "memory")
#define PV_D0(d0) do { s16x4 l0, l1, l2, l3, h0, h1, h2, h3; constexpr int b_ = AT_V + VB * AT_SHM_V + v_rd_off(d0, 0, 0); \
        TRRD(l0, b_); TRRD(h0, b_ + 2048); TRRD(l1, b_ + 4096); TRRD(h1, b_ + 6144); TRRD(l2, b_ + 8192); TRRD(h2, b_ + 10240); TRRD(l3, b_ + 12288); TRRD(h3, b_ + 14336); \
        asm volatile("s_waitcnt lgkmcnt(0)" ::: "memory"); SBAR(); \
        o[d0] = __builtin_amdgcn_mfma_f32_32x32x16_bf16(pa0, (bf16x8){l0[0], l0[1], l0[2], l0[3], h0[0], h0[1], h0[2], h0[3]}, o[d0], 0, 0, 0); \
        o[d0] = __builtin_amdgcn_mfma_f32_32x32x16_bf16(pa1, (bf16x8){l1[0], l1[1], l1[2], l1[3], h1[0], h1[1], h1[2], h1[3]}, o[d0], 0, 0, 0); \
        o[d0] = __builtin_amdgcn_mfma_f32_32x32x16_bf16(pa2, (bf16x8){l2[0], l2[1], l2[2], l2[3], h2[0], h2[1], h2[2], h2[3]}, o[d0], 0, 0, 0); \
        o[d0] = __builtin_amdgcn_mfma_f32_32x32x16_bf16(pa3, (bf16x8){l3[0], l3[1], l3[2], l3[3], h3[0], h3[1], h3[2], h3[3]}, o[d0], 0, 0, 0); } while (0)
    PV_D0(0); PV_D0(1); PV_D0(2); PV_D0(3);
#undef PV_D0
#undef TRRD
}
DEV void attn_unit(char* lds, int h, int qb, const bf16_t* qn, const bf16_t* qp, const bf16_t* kn, const bf16_t* kpe, const bf16_t* vv, bf16_t* o_out) {
    const int tid = threadIdx.x, wid = __builtin_amdgcn_readfirstlane(tid >> 6), lane = tid & 63, r32 = lane & 31, hi = lane >> 5;
    const int q0 = qb * 256, qlo = q0 + wid * 32, NT = 4 * (qb + 1);
    float* ws = (float*)(lds + AT_WS) + wid * 64; float* li_l = ws; float* al_l = ws + 32;
    unsigned kof[2], vof[2], pof;
#pragma unroll
    for (int i = 0; i < 2; ++i) { const int off = (wid * 2 + i) * 1024 + lane * 16;
        { const int row = off >> 8, colB = (off & 255) ^ ((row & 7) << 4); kof[i] = (unsigned)(row * DM + h * 128 + (colB >> 1)); }
        { const int sub = off >> 9, within = off & 511, kk = (sub >> 2) * 8 + (within >> 6), c = (sub & 3) * 32 + ((within & 63) >> 1);
          const int k = (kk & ~0xC) | ((kk & 4) << 1) | ((kk & 8) >> 1); vof[i] = (unsigned)(k * DM + h * 128 + c); } }
    { const int off = wid * 1024 + lane * 16, row = off >> 7, ch = ((off >> 4) & 7) ^ ((row >> 1) & 7); pof = (unsigned)(row * 64 + ch * 8); }
    const int vb0 = (int)(uintptr_t)lds + v_rd_base(lane);
    LAS unsigned char* l3 = (LAS unsigned char*)(uintptr_t)lds;
#define AT_GLDS(gp, lo) __builtin_amdgcn_global_load_lds((const unsigned*)(gp), (LAS unsigned*)(l3 + (lo)), 16, 0, 0)
#define AT_STAGE(t, B) do { const bf16_t* kt_ = kn + (size_t)(t) * 64 * DM; const bf16_t* vt_ = vv + (size_t)(t) * 64 * DM; const bf16_t* pt_ = kpe + (size_t)(t) * 64 * 64; \
        AT_GLDS(kt_ + kof[0], AT_K + (B) * AT_SHM_K + (wid * 2 + 0) * 1024); AT_GLDS(kt_ + kof[1], AT_K + (B) * AT_SHM_K + (wid * 2 + 1) * 1024); \
        AT_GLDS(vt_ + vof[0], AT_V + (B) * AT_SHM_V + (wid * 2 + 0) * 1024); AT_GLDS(vt_ + vof[1], AT_V + (B) * AT_SHM_V + (wid * 2 + 1) * 1024); \
        AT_GLDS(pt_ + pof, AT_P + (B) * AT_SHM_P + wid * 1024); } while (0)
    AT_STAGE(0, 0);
    bf16x8 qr[12];
    { const bf16_t* qrow = qn + (size_t)(qlo + r32) * DM + h * 128 + hi * 8; const bf16_t* prow = qp + (size_t)(qlo + r32) * 1024 + h * 64 + hi * 8;
#pragma unroll
      for (int d0 = 0; d0 < 8; ++d0) qr[d0] = *(const bf16x8*)(qrow + d0 * 16);
#pragma unroll
      for (int d0 = 0; d0 < 4; ++d0) qr[8 + d0] = *(const bf16x8*)(prow + d0 * 16); }
    asm volatile("s_waitcnt vmcnt(0)" ::: "memory");
    __syncthreads();
    float m_reg = -1e30f, l_reg = 0.f; f32x16 o[4] = {};
    const int qm = qlo + r32 - 4 * hi;
#define AT_STEP(t, B) do { \
        if ((t) + 1 < NT) AT_STAGE((t) + 1, (B) ^ 1); \
        f32x16 p0, p1; at_qkt<B>(p0, p1, lds, r32, hi, qr); \
        if ((t) * 64 + 63 > qlo) at_mask(p0, p1, qm - (t) * 64); \
        SBAR(); float alpha; at_partialSM(p0, p1, m_reg, alpha); SBAR(); \
        if (__any(alpha < 1.f)) { if (hi == 0) al_l[r32] = alpha; asm volatile("s_waitcnt lgkmcnt(0)" ::: "memory"); \
            _Pragma("unroll") for (int r = 0; r < 16; ++r) { const float a_ = al_l[crow(r, hi)]; o[0][r] *= a_; o[1][r] *= a_; o[2][r] *= a_; o[3][r] *= a_; if ((r & 3) == 3) SBAR(); } } \
        SBAR(); bf16x8 pa0, pa1, pa2, pa3; at_finishSM(p0, p1, alpha, l_reg, pa0, pa1, pa2, pa3); SBAR(); \
        at_pv<B>(o, vb0, pa0, pa1, pa2, pa3); \
        asm volatile("s_waitcnt vmcnt(0)" ::: "memory"); \
        __syncthreads(); } while (0)
    for (int t = 0; t < NT; t += 2) { AT_STEP(t, 0); AT_STEP(t + 1, 1); }
    if (hi == 0) li_l[r32] = l_reg; asm volatile("s_waitcnt lgkmcnt(0)" ::: "memory");
    float rli[16];
#pragma unroll
    for (int r = 0; r < 16; ++r) rli[r] = __builtin_amdgcn_rcpf(li_l[crow(r, hi)]);
    bf16_t* Ow = o_out + (size_t)qlo * DM + h * 128;
#pragma unroll
    for (int r = 0; r < 16; ++r) { const int orow = crow(r, hi);
#pragma unroll
        for (int d0 = 0; d0 < 4; ++d0) { const float v = o[d0][r] * rli[r]; const float vn = __shfl_xor(v, 1);
            if ((r32 & 1) == 0) *(unsigned*)(Ow + (size_t)orow * DM + d0 * 32 + r32) = cvtpk(v, vn); } }
    __syncthreads();
#undef AT_GLDS
#undef AT_STAGE
#undef AT_STEP
}
DEV void attn_mfma(char* lds, const bf16_t* qn, const bf16_t* qp, const bf16_t* kn, const bf16_t* kpe, const bf16_t* vv, bf16_t* o_out) {
    for (int it = blockIdx.x; it < 256; it += gridDim.x) {
        const int vid = (gridDim.x == 256) ? ((it & 7) * 32 + (it >> 3)) : it;
        const int h = vid >> 4, j = vid & 15;
        attn_unit(lds, h, 31 - j, qn, qp, kn, kpe, vv, o_out);
        attn_unit(lds, h, j, qn, qp, kn, kpe, vv, o_out);
    }
}

DEV void wave_argmax(float& v, int& idx) {
#pragma unroll
    for (int o = 1; o < 64; o <<= 1) { const float ov = __shfl_xor(v, o); const int oi = __shfl_xor(idx, o);
        if (ov > v || (ov == v && oi < idx)) { v = ov; idx = oi; } }
}
DEV void peer_phase(float* lds, const float* sc, const float* h1, const bf16_t* h1b, const u64* ssq1, const bf16_t* tu, const bf16_t* tv, float* h2, bf16_t* xn3) {
    const int tid = threadIdx.x, lane = tid & 63, wid = tid >> 6;
    int* ex = (int*)(lds + wid * 256);
    float* gt = lds + wid * 256 + 128;
    const float NEG = -__builtin_inff();
    for (int t = blockIdx.x * 8 + wid; t < S; t += gridDim.x * 8) {
        for (int h = 0; h < PH; ++h) {
            const float* sp = sc + (size_t)t * DM + h * 256;
            float tvv[2]; int tii[2];
#pragma unroll
            for (int c = 0; c < 2; ++c) {
                float a = sp[c * 128 + lane], b = sp[c * 128 + 64 + lane];
                float keepv = NEG; int keepi = 0;
                for (int r = 0; r < TOPK; ++r) {
                    float v; int idx; if (b > a) { v = b; idx = lane + 64; } else { v = a; idx = lane; }
                    wave_argmax(v, idx);
                    if (idx == lane) a = NEG; if (idx == lane + 64) b = NEG;
                    if (lane == r) { keepv = v; keepi = idx; }
                }
                tvv[c] = keepv; tii[c] = keepi;
            }
            const float a1 = __shfl(tvv[0], lane >> 2);
            float cv[4];
#pragma unroll
            for (int j = 0; j < 4; ++j) cv[j] = a1 + __shfl(tvv[1], (lane & 3) * 4 + j);
            float bs = NEG; int bc = 0;
            for (int r = 0; r < TOPK; ++r) {
                float v = cv[0]; int idx = lane * 4;
#pragma unroll
                for (int j = 1; j < 4; ++j) if (cv[j] > v) { v = cv[j]; idx = lane * 4 + j; }
                wave_argmax(v, idx);
                if ((idx >> 2) == lane) {
#pragma unroll
                    for (int j = 0; j < 4; ++j) if ((idx & 3) == j) cv[j] = NEG;
                }
                if (lane == r) { bs = v; bc = idx; }
            }
            const int i1 = __shfl(tii[0], bc >> 4), i2 = __shfl(tii[1], bc & 15);
            const float mx = __shfl(bs, 0);
            float e = (lane < 16) ? __expf(bs - mx) : 0.f;
            float sum = e;
#pragma unroll
            for (int o = 1; o < 16; o <<= 1) sum += __shfl_xor(sum, o);
            if (lane < 16) { ex[h * 16 + lane] = i1 * NK + i2; gt[h * 16 + lane] = e / sum; }
        }
        asm volatile("s_waitcnt lgkmcnt(0)" ::: "memory");
        const float rs1 = rsqrtf(ssq_get(ssq1, t) * (1.f / DM) + EPS);
        float hv[32];
#pragma unroll
        for (int j = 0; j < 4; ++j) { const u32x4 w = *(const u32x4*)(h1b + (size_t)t * DM + j * 512 + lane * 8);
            hv[j * 8 + 0] = bflo(w.x); hv[j * 8 + 1] = bfhi(w.x); hv[j * 8 + 2] = bflo(w.y); hv[j * 8 + 3] = bfhi(w.y);
            hv[j * 8 + 4] = bflo(w.z); hv[j * 8 + 5] = bfhi(w.z); hv[j * 8 + 6] = bflo(w.w); hv[j * 8 + 7] = bfhi(w.w); }
        float ac[32];
#pragma unroll
        for (int i = 0; i < 32; ++i) ac[i] = 0.f;
        for (int k = 0; k < PH * TOPK * DBG_PEER; ++k) {
            const int e = ex[k]; const float g = gt[k];
            const bf16_t* ur = tu + (size_t)e * DM + lane * 8; const bf16_t* vr = tv + (size_t)e * DM + lane * 8;
            u32x4 uw[4], vw[4];
#pragma unroll
            for (int j = 0; j < 4; ++j) { uw[j] = *(const u32x4*)(ur + j * 512); vw[j] = *(const u32x4*)(vr + j * 512); }
            float d = 0.f;
#pragma unroll
            for (int j = 0; j < 4; ++j) { d += hv[j * 8 + 0] * bflo(uw[j].x) + hv[j * 8 + 1] * bfhi(uw[j].x) + hv[j * 8 + 2] * bflo(uw[j].y) + hv[j * 8 + 3] * bfhi(uw[j].y)
                                             + hv[j * 8 + 4] * bflo(uw[j].z) + hv[j * 8 + 5] * bfhi(uw[j].z) + hv[j * 8 + 6] * bflo(uw[j].w) + hv[j * 8 + 7] * bfhi(uw[j].w); }
            d = wave_sum(d);
            const float w = g * gelu_tanh(d * rs1);
#pragma unroll
            for (int j = 0; j < 4; ++j) { ac[j * 8 + 0] += w * bflo(vw[j].x); ac[j * 8 + 1] += w * bfhi(vw[j].x); ac[j * 8 + 2] += w * bflo(vw[j].y); ac[j * 8 + 3] += w * bfhi(vw[j].y);
                                          ac[j * 8 + 4] += w * bflo(vw[j].z); ac[j * 8 + 5] += w * bfhi(vw[j].z); ac[j * 8 + 6] += w * bflo(vw[j].w); ac[j * 8 + 7] += w * bfhi(vw[j].w); }
        }
        float ss = 0.f;
#pragma unroll
        for (int j = 0; j < 4; ++j) { const size_t o = (size_t)t * DM + j * 512 + lane * 8;
            const f32x4 x0 = *(const f32x4*)(h1 + o), x1 = *(const f32x4*)(h1 + o + 4);
#pragma unroll
            for (int i = 0; i < 4; ++i) { ac[j * 8 + i] += x0[i]; ac[j * 8 + 4 + i] += x1[i]; }
#pragma unroll
            for (int i = 0; i < 8; ++i) ss += ac[j * 8 + i] * ac[j * 8 + i]; }
        ss = wave_sum(ss);
        const float rs2 = rsqrtf(ss * (1.f / DM) + EPS);
#pragma unroll
        for (int j = 0; j < 4; ++j) { const size_t o = (size_t)t * DM + j * 512 + lane * 8;
            *(f32x4*)(h2 + o) = (f32x4){ac[j * 8], ac[j * 8 + 1], ac[j * 8 + 2], ac[j * 8 + 3]}; *(f32x4*)(h2 + o + 4) = (f32x4){ac[j * 8 + 4], ac[j * 8 + 5], ac[j * 8 + 6], ac[j * 8 + 7]};
            u32x4 w; w.x = pk2(ac[j * 8] * rs2, ac[j * 8 + 1] * rs2); w.y = pk2(ac[j * 8 + 2] * rs2, ac[j * 8 + 3] * rs2); w.z = pk2(ac[j * 8 + 4] * rs2, ac[j * 8 + 5] * rs2); w.w = pk2(ac[j * 8 + 6] * rs2, ac[j * 8 + 7] * rs2);
            *(u32x4*)(xn3 + o) = w; }
    }
}

__global__ void __launch_bounds__(NTHREADS, 2) fwd_kernel(Params P) {
    extern __shared__ __attribute__((aligned(16))) unsigned char lds_raw[];
    float* lds = (float*)lds_raw;
    cg::grid_group grid = cg::this_grid();
    const int G = gridDim.x, bx = blockIdx.x;
    const int gthreads = G * NTHREADS, gwaves = G * 8;
#define PHASE_IDS() int tid = threadIdx.x; asm volatile("" : "+v"(tid)); const int lane = tid & 63, wid = tid >> 6, gtid = bx * NTHREADS + tid, gwave = bx * 8 + wid; (void)lane; (void)wid; (void)gtid; (void)gwave
typedef const float* const __attribute__((address_space(4)))* KARG;
#define PH_PTRS() \
    KARG INP = (KARG)__builtin_amdgcn_kernarg_segment_ptr(); asm volatile("" : "+s"(INP)); \
    unsigned char* ws = (unsigned char*)INP[29]; float* outp = (float*)INP[28]; \
    float* small = (float*)(ws + WS_SMALL); \
    float* rope = (float*)(ws + WS_ROPE); \
    bf16_t* wt_in = (bf16_t*)(ws + WS_WIN); bf16_t* wt_uq = (bf16_t*)(ws + WS_WUQ); bf16_t* wt_ukv = (bf16_t*)(ws + WS_WUKV); \
    bf16_t* wt_ao = (bf16_t*)(ws + WS_WAO); bf16_t* wt_ro = (bf16_t*)(ws + WS_WRO); bf16_t* wt_out = (bf16_t*)(ws + WS_WOUT); \
    bf16_t* wt_pq = (bf16_t*)(ws + WS_WPQ); bf16_t* wt_pg = (bf16_t*)(ws + WS_WPG); bf16_t* wt_pp = (bf16_t*)(ws + WS_WPP); \
    bf16_t* wt_g = (bf16_t*)(ws + WS_WG); bf16_t* wt_sk = (bf16_t*)(ws + WS_WSK); bf16_t* pb = (bf16_t*)(ws + WS_PB); \
    bf16_t* tu = (bf16_t*)(ws + WS_TU); bf16_t* tvt = (bf16_t*)(ws + WS_TV); \
    bf16_t* xb = (bf16_t*)(ws + WS_A0); bf16_t* xc = (bf16_t*)(ws + WS_A0); float* agg = (float*)(ws + WS_A0); bf16_t* h1b = (bf16_t*)(ws + WS_A0); \
    bf16_t* Yb = (bf16_t*)(ws + WS_A2); bf16_t* qpeer = (bf16_t*)(ws + WS_A2); \
    bf16_t* gy = (bf16_t*)(ws + WS_A3); float* scores = (float*)(ws + WS_A3); \
    bf16_t* gat = (bf16_t*)(ws + WS_A4); bf16_t* grn = (bf16_t*)(ws + WS_A5); bf16_t* ppb = (bf16_t*)(ws + WS_A5); \
    bf16_t* qn = (bf16_t*)(ws + WS_A6); bf16_t* kn = (bf16_t*)(ws + WS_A7); bf16_t* mixa = (bf16_t*)(ws + WS_A7); bf16_t* xn3 = (bf16_t*)(ws + WS_A7); \
    bf16_t* vv = (bf16_t*)(ws + WS_A8); bf16_t* mix = (bf16_t*)(ws + WS_A8); \
    bf16_t* qp = (bf16_t*)(ws + WS_A9); bf16_t* kpe = (bf16_t*)(ws + WS_KPE); \
    bf16_t* cq = (bf16_t*)outp; bf16_t* ckv = (bf16_t*)((unsigned char*)outp + 12 * MiB); bf16_t* xr = (bf16_t*)((unsigned char*)outp + 20 * MiB); \
    bf16_t* la = (bf16_t*)outp; bf16_t* gx = (bf16_t*)((unsigned char*)outp + 32 * MiB); \
    float* hres = outp;
    const int lo = P.ph_lo, hi = P.ph_hi;
#ifndef PHMASK
#define PHMASK 0xFFFF
#endif
#define IN(k) (((PHMASK >> (k)) & 1) && lo <= (k) && (k) < hi)
#define SYNC_AFTER(k) do { if (IN(k) && IN((k) + 1)) { asm volatile("s_waitcnt vmcnt(0)" ::: "memory"); __syncthreads(); grid.sync(); \
        if (threadIdx.x == 0) { __builtin_amdgcn_fence(__ATOMIC_ACQUIRE, "agent"); asm volatile("s_waitcnt vmcnt(0)" ::: "memory"); } __syncthreads(); } } while (0)

#ifndef SIMPLE_ATTN
#define SIMPLE_ATTN 0
#endif
#ifndef SIMPLE_GEMM
#define SIMPLE_GEMM 0
#endif
#define GEMM(g, E) do { if (SIMPLE_GEMM) gemm_simple(lds, g, E); else gemm_mfma<decltype(E), true, true>((LAS unsigned char*)lds_raw, g, E); } while (0)
    if (IN(0)) { PH_PTRS();
        PHASE_IDS();
        int ib = 0;
        transpose_items(lds, INP[I_W_IN], DM, 9536, NIN_PAD, wt_in, INP[I_ATTN_NORM], 1.f, MapWin(), ib, bx, G);
        transpose_items(lds, INP[I_W_UQ], QL, 3072, 3072, wt_uq, INP[I_Q_NORM], QSCALE, MapWuq(), ib, bx, G);
        transpose_items(lds, INP[I_W_UKV], KVL, 4096, 4096, wt_ukv, INP[I_KV_NORM], 1.f, MapIdent(), ib, bx, G);
        transpose_items(lds, INP[I_W_ATTN_O], DM, DM, DM, wt_ao, nullptr, 1.f, MapIdent(), ib, bx, G);
        transpose_items(lds, INP[I_W_RNN_O], DM, DM, DM, wt_ro, nullptr, 1.f, MapIdent(), ib, bx, G);
        transpose_items(lds, INP[I_W_OUT], DM, DM, DM, wt_out, nullptr, 1.f, MapIdent(), ib, bx, G);
        transpose_items(lds, INP[I_W_PEER_Q], DM, DM, DM, wt_pq, INP[I_FFN_NORM], 1.f, MapIdent(), ib, bx, G);
        transpose_items(lds, INP[I_W_PLE_GATE], DM, DM, DM, wt_pg, INP[I_PLE_NORM], 1.f, MapIdent(), ib, bx, G);
        transpose_items(lds, INP[I_W_PLE_PROJ], PLE, DM, DM, wt_pp, nullptr, 1.f, MapIdent(), ib, bx, G);
        for (int b = 0; b < NBLK; ++b) {
            transpose_items(lds, INP[I_W_RG_A] + (size_t)b * BD * BD, BD, BD, BD, wt_g + (size_t)b * 256 * BD, nullptr, 1.f, MapIdent(), ib, bx, G);
            transpose_items(lds, INP[I_W_RG_X] + (size_t)b * BD * BD, BD, BD, BD, wt_g + (size_t)b * 256 * BD + 128 * BD, nullptr, 1.f, MapIdent(), ib, bx, G);
        }
        for (int i = gtid; i < PH * 256 * 256; i += gthreads) { const int h = i >> 16, n = (i >> 8) & 255, k = i & 255, c = n >> 7;
            float v = 0.f; if ((k >> 7) == c) v = INP[I_SUBKEYS][(((size_t)h * 2 + c) * NK + (n & 127)) * 128 + (k & 127)];
            wt_sk[i] = (bf16_t)f2bf(v); }
        { const float* pu = INP[I_PEER_U]; const float* pv = INP[I_PEER_V]; const float* gn = INP[I_FFN_NORM];
          const size_t n8 = (size_t)NK * NK * DM / 8;
          for (size_t i = gtid; i < n8; i += gthreads) { const size_t o = i * 8; const int d = (int)(o & (DM - 1));
              const f32x4 a0 = *(const f32x4*)(pu + o), a1 = *(const f32x4*)(pu + o + 4), g0 = *(const f32x4*)(gn + d), g1 = *(const f32x4*)(gn + d + 4);
              const f32x4 b0 = *(const f32x4*)(pv + o), b1 = *(const f32x4*)(pv + o + 4);
              u32x4 w; w.x = pk2(a0[0] * g0[0], a0[1] * g0[1]); w.y = pk2(a0[2] * g0[2], a0[3] * g0[3]); w.z = pk2(a1[0] * g1[0], a1[1] * g1[1]); w.w = pk2(a1[2] * g1[2], a1[3] * g1[3]);
              *(u32x4*)(tu + o) = w;
              u32x4 w2; w2.x = pk2(b0[0], b0[1]); w2.y = pk2(b0[2], b0[3]); w2.z = pk2(b1[0], b1[1]); w2.w = pk2(b1[2], b1[3]);
              *(u32x4*)(tvt + o) = w2; } }
        for (int i = gtid; i < S * PLE / 4; i += gthreads) { const f32x4 v = *(const f32x4*)(INP[I_P] + (size_t)i * 4); *(u32x2*)(pb + (size_t)i * 4) = pk4(v); }
        for (int t = gwave; t < S; t += gwaves) { const float* xrw = INP[I_X] + (size_t)t * DM; float s = 0.f;
#pragma unroll
            for (int j = 0; j < 8; ++j) { const f32x4 v = *(const f32x4*)(xrw + j * 256 + lane * 4); s += sumsq4(v); *(u32x2*)(xb + (size_t)t * DM + j * 256 + lane * 4) = pk4(v); }
            s = wave_sum(s); if (lane == 0) small[SM_SSQ0 + t] = s; }
        for (int i = gtid; i < S * 32; i += gthreads) { const int t = i >> 5, j = i & 31; const float inv = 1.0f / powf(10000.f, (float)j / 32.f); const float ang = (float)t * inv;
            rope[2 * i] = cosf(ang); rope[2 * i + 1] = sinf(ang); }
        for (int i = gtid; i < 4 * 2 * S; i += gthreads) small[SM_SSQQ + i] = 0.f;
        for (int i = gtid; i < DM; i += gthreads) { const float lam = INP[I_LAMBDA][i]; small[SM_N8SP + i] = -8.f * log1pf(__expf(-lam)); }
    }
    SYNC_AFTER(0);
    if (IN(1)) { PH_PTRS();
        GemmDesc g{xb, DM, 0, wt_in, DM, 0, S / 256, NIN_PAD / 256, 1, DM};
        static_assert(WS_A4 - WS_A3 == 32 * MiB && WS_A5 - WS_A4 == 32 * MiB && SM_SSQKV - SM_SSQQ == 16384, "EpiIn layout");
        EpiIn E{small + SM_SSQ0, rope, INP[I_B_GATE], cq, kpe, xr, gy, (u64*)(small + SM_SSQQ)};
        GEMM(g, E);
    }
    SYNC_AFTER(1);
    if (IN(2)) { PH_PTRS();
        PHASE_IDS();
        { GemmDesc g{cq, QL, 0, wt_uq, QL, 0, S / 256, 12, 1, QL}; EpiQ E{(const u64*)(small + SM_SSQQ), rope, qn, qp}; GEMM(g, E); }
        { GemmDesc g{ckv, KVL, 0, wt_ukv, KVL, 0, S / 256, 16, 1, KVL}; EpiKV E{(const u64*)(small + SM_SSQKV), kn, vv}; GEMM(g, E); }
        const float* cw = INP[I_CONV_W]; const float* cb = INP[I_CONV_B];
        for (int i = gtid; i < S * DM / 4; i += gthreads) { const int t = i / (DM / 4), c = (i % (DM / 4)) * 4;
            f32x4 a = *(const f32x4*)(cb + c);
#pragma unroll
            for (int w = 0; w < 4; ++w) { const int tt = t - 3 + w; if (tt >= 0) a += *(const f32x4*)(cw + w * DM + c) * unpk4(*(const u32x2*)(xr + (size_t)tt * DM + c)); }
            *(u32x2*)(xc + (size_t)t * DM + c) = pk4(a); }
    }
    SYNC_AFTER(2);
    if (IN(3)) { PH_PTRS();
        if (SIMPLE_ATTN) attn_simple(lds, qn, qp, kn, kpe, vv, qn); else attn_mfma((char*)lds_raw, qn, qp, kn, kpe, vv, qn);
#ifndef SKIP_GATES
        GemmDesc g{xc, DM, BD, wt_g, BD, 256 * BD, S / 256, 1, NBLK, BD};
        EpiGates E{INP[I_B_RG_A], INP[I_B_RG_X], small + SM_N8SP, xc, la, gx};
        GEMM(g, E);
#endif
    }
    SYNC_AFTER(3);
    if (IN(4)) { PH_PTRS();
        PHASE_IDS();
        for (int i = gtid; i < 64 * (DM / 2); i += gthreads) { const int ch = i / (DM / 2), c = (i % (DM / 2)) * 2;
            float A0 = 1.f, B0 = 0.f, A1 = 1.f, B1 = 0.f;
            for (int tt = 0; tt < 128; ++tt) { const size_t o = (size_t)(ch * 128 + tt) * DM + c;
                const unsigned lw = *(const unsigned*)(la + o), gw = *(const unsigned*)(gx + o);
                const float l0 = bflo(lw), l1 = bfhi(lw); const float a0 = __expf(l0), a1 = __expf(l1);
                float m0 = sqrtf(fmaxf(-expm1f(2.f * l0), 0.f)), m1 = sqrtf(fmaxf(-expm1f(2.f * l1), 0.f));
                if (ch == 0 && tt == 0) { m0 = 1.f; m1 = 1.f; }
                A0 *= a0; B0 = a0 * B0 + m0 * bflo(gw); A1 *= a1; B1 = a1 * B1 + m1 * bfhi(gw); }
            *(f32x4*)(agg + ((size_t)ch * DM + c) * 2) = (f32x4){A0, B0, A1, B1}; }
    }
    SYNC_AFTER(4);
    if (IN(5)) { PH_PTRS();
        PHASE_IDS();
        for (int i = gtid; i < 64 * (DM / 2); i += gthreads) { const int ch = i / (DM / 2), c = (i % (DM / 2)) * 2;
            float h0 = 0.f, h1v = 0.f;
            for (int cc = 0; cc < ch; ++cc) { const f32x4 ab = *(const f32x4*)(agg + ((size_t)cc * DM + c) * 2); h0 = ab[0] * h0 + ab[1]; h1v = ab[2] * h1v + ab[3]; }
            for (int tt = 0; tt < 128; ++tt) { const size_t o = (size_t)(ch * 128 + tt) * DM + c;
                const unsigned lw = *(const unsigned*)(la + o), gw = *(const unsigned*)(gx + o), yw = *(const unsigned*)(gy + o);
                const float l0 = bflo(lw), l1 = bfhi(lw); const float a0 = __expf(l0), a1 = __expf(l1);
                float m0 = sqrtf(fmaxf(-expm1f(2.f * l0), 0.f)), m1 = sqrtf(fmaxf(-expm1f(2.f * l1), 0.f));
                if (ch == 0 && tt == 0) { m0 = 1.f; m1 = 1.f; }
                h0 = a0 * h0 + m0 * bflo(gw); h1v = a1 * h1v + m1 * bfhi(gw);
                *(unsigned*)(Yb + o) = pk2(h0 * bflo(yw), h1v * bfhi(yw)); } }
    }
    SYNC_AFTER(5);
    if (IN(6)) { PH_PTRS();
        { GemmDesc g{qn, DM, 0, wt_ao, DM, 0, S / 256, 8, 1, DM}; EpiMixA E{gat, mixa}; GEMM(g, E); }
        asm volatile("s_waitcnt vmcnt(0)" ::: "memory"); __syncthreads();
        { GemmDesc g{Yb, DM, 0, wt_ro, DM, 0, S / 256, 8, 1, DM}; EpiMix E{grn, mixa, mix}; GEMM(g, E); }
    }
    SYNC_AFTER(6);
    if (IN(7)) { PH_PTRS(); GemmDesc g{mix, DM, 0, wt_out, DM, 0, S / 256, 8, 1, DM}; EpiOut E{INP[I_X], hres, h1b, (u64*)(small + SM_SSQ1)}; GEMM(g, E); }
    SYNC_AFTER(7);
    if (IN(8)) { PH_PTRS();
        { GemmDesc g{h1b, DM, 0, wt_pq, DM, 0, S / 256, 8, 1, DM}; EpiPeerQ E{(const u64*)(small + SM_SSQ1), qpeer}; GEMM(g, E); }
        { GemmDesc g{pb, PLE, 0, wt_pp, PLE, 0, S / 256, 8, 1, PLE}; EpiPlain E{ppb}; GEMM(g, E); }
    }
    SYNC_AFTER(8);
    if (IN(9)) { PH_PTRS(); GemmDesc g{qpeer, DM, 256, wt_sk, 256, 256 * 256, S / 256, 1, PH, 256}; EpiScores E{scores}; GEMM(g, E); }
    SYNC_AFTER(9);
    if (IN(10)) { PH_PTRS(); peer_phase(lds, scores, hres, h1b, (const u64*)(small + SM_SSQ1), tu, tvt, hres, xn3); }
    SYNC_AFTER(10);
    if (IN(11)) { PH_PTRS(); GemmDesc g{xn3, DM, 0, wt_pg, DM, 0, S / 256, 8, 1, DM}; EpiPle E{ppb, hres, (u64*)(small + SM_SSQ3)}; GEMM(g, E); }
    SYNC_AFTER(11);
    if (IN(12)) { PH_PTRS();
        PHASE_IDS();
        const float* fn = INP[I_FINAL_NORM];
        for (int i = gtid; i < S * DM / 4; i += gthreads) { const int t = i / (DM / 4), c = (i % (DM / 4)) * 4;
            const float rs = rsqrtf(ssq_get((const u64*)(small + SM_SSQ3), t) * (1.f / DM) + EPS);
            const f32x4 v = *(const f32x4*)(hres + (size_t)i * 4), g4 = *(const f32x4*)(fn + c);
            *(f32x4*)(hres + (size_t)i * 4) = v * rs * g4; }
    }
}

constexpr int NPHASES = 13;
#ifndef MK_N_LAUNCHES
#define MK_N_LAUNCHES 1
#endif

extern "C" void kernel_launch(void* const* d_in, const int* in_sizes, int n_in, void* d_out, int out_size, void* d_ws, size_t ws_size, hipStream_t stream) {
    static int grid = 0;
    if (grid == 0) {
        if (n_in != 28 || out_size != S * DM || ws_size < WS_END) { fprintf(stderr, "kernel_launch: unexpected shapes (n_in %d out %d ws %zu)\n", n_in, out_size, ws_size); grid = -1; return; }
        int dev = 0, cus = 0, per_cu = 0;
        (void)hipGetDevice(&dev);
        (void)hipDeviceGetAttribute(&cus, hipDeviceAttributeMultiprocessorCount, dev);
        if (hipFuncSetAttribute((const void*)fwd_kernel, hipFuncAttributeMaxDynamicSharedMemorySize, LDS_BYTES) != hipSuccess) { fprintf(stderr, "kernel_launch: hipFuncSetAttribute failed\n"); grid = -1; return; }
        if (hipOccupancyMaxActiveBlocksPerMultiprocessor(&per_cu, (const void*)fwd_kernel, NTHREADS, LDS_BYTES) != hipSuccess || per_cu < 1) { fprintf(stderr, "kernel_launch: occupancy query failed (%d)\n", per_cu); (void)hipGetLastError(); per_cu = 1; }
        if (per_cu > 1) per_cu = 1;
        grid = cus * per_cu;
        if (grid <= 0) grid = 256;
    }
    if (grid < 0) return;
    Params p{};
    for (int i = 0; i < 28; ++i) p.in[i] = (const float*)d_in[i];
    p.out = (float*)d_out; p.ws = (unsigned char*)d_ws;
    if (MK_N_LAUNCHES == 1) {
        p.ph_lo = 0; p.ph_hi = NPHASES;
        void* args[] = {&p};
        hipError_t e = hipLaunchCooperativeKernel((const void*)fwd_kernel, dim3(grid), dim3(NTHREADS), args, LDS_BYTES, stream);
        if (e != hipSuccess) fprintf(stderr, "cooperative launch failed: %s (grid %d)\n", hipGetErrorString(e), grid);
    } else {
        for (int k = 0; k < NPHASES; ++k) { p.ph_lo = k; p.ph_hi = k + 1; hipLaunchKernelGGL(fwd_kernel, dim3(grid), dim3(NTHREADS), LDS_BYTES, stream, p); }
    }
}
```

```cpp
#include <hip/hip_runtime.h>
#include <hip/hip_cooperative_groups.h>
#include <cstdio>
#include <cstdint>
namespace cg = cooperative_groups;

#define STAMP_A 0
#define STAMP_BLK 0
#define ROT_EXP 0
#define UREP 1
#define EXP_MASK 0x3FFF
#define STAMP_B 2
#ifndef STAMP_Q
#define STAMP_Q 4.f
#endif
#define DEV __device__ __forceinline__
typedef unsigned short bf16_t;
typedef float f32x4 __attribute__((ext_vector_type(4)));
typedef float f32x2 __attribute__((ext_vector_type(2)));
typedef unsigned u32x2 __attribute__((ext_vector_type(2)));
typedef unsigned u32x4 __attribute__((ext_vector_type(4)));

constexpr int S = 8192, DM = 2048, PLE = 256;
constexpr int NH = 16, DN = 128, DR = 64, DV = 128;
constexpr int QL = 768, KVL = 512;
constexpr int NBLK = 16, BD = 128;
constexpr int PH = 8, NK = 128, TOPK = 16;
constexpr int NIN_PAD = 9728;
constexpr float EPS = 1e-6f;
constexpr float QSCALE = 0.07216878364870322f * 1.4426950408889634f;
constexpr int NTHREADS = 512;
constexpr float WIN_SCALE = 64.f, X_SCALE = 16.f, O_SCALE = 32.f, Y_SCALE = 16.f, MIX_SCALE = 32.f;
constexpr float TU_SCALE = 1024.f, TV_SCALE = 64.f, H_SCALE = 16.f;
#ifndef DBG_PEER
#define DBG_PEER 1
#endif
constexpr int LDS_BYTES = 147456;

constexpr size_t MiB = 1u << 20;
constexpr size_t WS_WIN = 0, WS_WUQ = 38 * MiB, WS_WUKV = WS_WUQ + 9 * MiB / 2, WS_WAO = WS_WUKV + 4 * MiB, WS_WRO = WS_WAO + 8 * MiB,
                 WS_WOUT = WS_WRO + 8 * MiB, WS_WPQ = WS_WOUT + 8 * MiB, WS_WPG = WS_WPQ + 8 * MiB, WS_WPP = WS_WPG + 8 * MiB,
                 WS_WG = WS_WPP + 1 * MiB, WS_WSK = WS_WG + 1 * MiB, WS_ROPE = WS_WSK + 1 * MiB, WS_PB = WS_ROPE + 2 * MiB, WS_SMALL = WS_PB + 4 * MiB;
static_assert(WS_SMALL == 95 * MiB + MiB / 2, "ws map");
constexpr size_t WS_A0 = 96 * MiB;
constexpr size_t WS_A2 = 128 * MiB;
constexpr size_t WS_A3 = 160 * MiB;
constexpr size_t WS_A4 = 192 * MiB;
constexpr size_t WS_A5 = 224 * MiB;
constexpr size_t WS_A6 = 256 * MiB;
constexpr size_t WS_A7 = 288 * MiB;
constexpr size_t WS_A8 = 320 * MiB;
constexpr size_t WS_A9 = 352 * MiB;
constexpr size_t WS_KPE = 368 * MiB;
constexpr size_t WS_TU = 384 * MiB, WS_TV = 448 * MiB, WS_END = 512 * MiB;
constexpr size_t WS_BAR = WS_SMALL + 352 * 1024;
constexpr int MISC_OFF = LDS_BYTES - 64;
constexpr int SM_SSQ0 = 0, SM_SSQQ = 8192, SM_SSQKV = 24576, SM_SSQ1 = 40960, SM_SSQ3 = 57344, SM_N8SP = 73728, SM_SSQ2 = 75776;
typedef unsigned long long u64;

DEV unsigned f2bf(float f) { unsigned u = __float_as_uint(f); return (u + 0x7fffu + ((u >> 16) & 1u)) >> 16; }
DEV unsigned pk2(float lo, float hi) { return f2bf(lo) | (f2bf(hi) << 16); }
DEV float bflo(unsigned w) { return __uint_as_float(w << 16); }
DEV float bfhi(unsigned w) { return __uint_as_float(w & 0xffff0000u); }
DEV u32x2 pk4(f32x4 v) { u32x2 r; r.x = pk2(v[0], v[1]); r.y = pk2(v[2], v[3]); return r; }
DEV f32x4 unpk4(u32x2 w) { return (f32x4){bflo(w.x), bfhi(w.x), bflo(w.y), bfhi(w.y)}; }
DEV u32x4 pk8(f32x4 a, f32x4 b) { u32x4 r; r.x = pk2(a[0], a[1]); r.y = pk2(a[2], a[3]); r.z = pk2(b[0], b[1]); r.w = pk2(b[2], b[3]); return r; }
DEV f32x4 unpk4lo(u32x4 w) { return (f32x4){bflo(w.x), bfhi(w.x), bflo(w.y), bfhi(w.y)}; }
DEV f32x4 unpk4hi(u32x4 w) { return (f32x4){bflo(w.z), bfhi(w.z), bflo(w.w), bfhi(w.w)}; }
DEV int perm_p(int R) { return (R & ~0x1C) | ((R & 0x0C) << 1) | ((R & 0x10) >> 2); }
DEV unsigned q8(float x) { return (unsigned)(int)fminf(fmaxf(rintf(x), -127.f), 127.f) & 0xffu; }
DEV unsigned q8pack(f32x4 v) { return q8(v[0]) | (q8(v[1]) << 8) | (q8(v[2]) << 16) | (q8(v[3]) << 24); }
DEV unsigned f8pack(f32x4 v) { unsigned w = 0; w = __builtin_amdgcn_cvt_pk_fp8_f32(v[0], v[1], w, false); w = __builtin_amdgcn_cvt_pk_fp8_f32(v[2], v[3], w, true); return w; }
DEV float sigmoidf_(float x) { return 1.f / (1.f + __expf(-x)); }
DEV float gelu_tanh(float x) { const float y = 0.7978845608028654f * (x + 0.044715f * x * x * x); const float t = 1.f - 2.f / (1.f + __expf(2.f * y)); return 0.5f * x * (1.f + t); }
DEV float wave_sum(float v) {
#pragma unroll
    for (int o = 1; o < 64; o <<= 1) v += __shfl_xor(v, o);
    return v;
}

struct Params { const float* in[28]; float* out; unsigned char* ws; int ph_lo, ph_hi; };
enum { I_X = 0, I_P, I_ATTN_NORM, I_W_IN, I_B_GATE, I_Q_NORM, I_W_UQ, I_KV_NORM, I_W_UKV, I_W_ATTN_O, I_CONV_W, I_CONV_B, I_W_RG_A, I_B_RG_A, I_W_RG_X,
       I_B_RG_X, I_LAMBDA, I_W_RNN_O, I_W_OUT, I_FFN_NORM, I_W_PEER_Q, I_SUBKEYS, I_PEER_U, I_PEER_V, I_PLE_NORM, I_W_PLE_GATE, I_W_PLE_PROJ, I_FINAL_NORM };

struct MapIdent { DEV int operator()(int n) const { return n; } };
struct MapWin { DEV int operator()(int n) const {
    if (n < 1280) return n;
    if (n < 1344) { const int j = n - 1280; return 1280 + 16 * (j >> 5) + 4 * ((j >> 3) & 3) + (j & 3) + 32 * ((j >> 2) & 1); }
    if (n < 1536) return -1;
    return n - 192; } };
struct MapWuq { DEV int operator()(int n) const {
    if (n < 2048) { const int h = n >> 7, d = n & 127; return h * 192 + d; }
    const int r = n - 2048, h = r >> 6, j = r & 63;
    return h * 192 + 128 + 16 * (j >> 5) + 4 * ((j >> 3) & 3) + (j & 3) + 32 * ((j >> 2) & 1); } };

template <class MAP, bool FP8 = false>
DEV void transpose_items(float* lds, const float* W, int K, int N, int Nd, bf16_t* WT, const float* gain, float scale, MAP map, int& item_base, int gw, int ngw) {
    const int lane = threadIdx.x & 63, wid = threadIdx.x >> 6;
    const int nkt = K / 64, nnt = Nd / 64, nitems = nkt * nnt;
    float* T = lds + wid * (64 * 65);
    int first = (gw - item_base) % ngw; if (first < 0) first += ngw;
    for (int it = first; it < nitems; it += ngw) {
        const int kt = it % nkt, nt = it / nkt, k0 = kt * 64, n0 = nt * 64;
        const int c4 = (lane & 15) * 4, src = map(n0 + c4), kq = lane >> 4;
        f32x4 v[16];
#pragma unroll
        for (int i = 0; i < 16; ++i) { v[i] = (f32x4){0.f, 0.f, 0.f, 0.f}; if (src >= 0) v[i] = *(const f32x4*)(W + (size_t)(k0 + i * 4 + kq) * N + src); }
#pragma unroll
        for (int i = 0; i < 16; ++i) { const int kk = i * 4 + kq; const float g = (gain ? gain[k0 + kk] : 1.f) * scale;
            T[kk * 65 + c4 + 0] = v[i][0] * g; T[kk * 65 + c4 + 1] = v[i][1] * g; T[kk * 65 + c4 + 2] = v[i][2] * g; T[kk * 65 + c4 + 3] = v[i][3] * g; }
        asm volatile("s_waitcnt lgkmcnt(0)" ::: "memory");
        const int kc = (lane & 7) * 8;
#pragma unroll
        for (int i = 0; i < 8; ++i) { const int n = (lane >> 3) + 8 * i; u32x4 o;
            o.x = pk2(T[(kc + 0) * 65 + n], T[(kc + 1) * 65 + n]); o.y = pk2(T[(kc + 2) * 65 + n], T[(kc + 3) * 65 + n]);
            o.z = pk2(T[(kc + 4) * 65 + n], T[(kc + 5) * 65 + n]); o.w = pk2(T[(kc + 6) * 65 + n], T[(kc + 7) * 65 + n]);
            if constexpr (FP8) { u32x2 o8; unsigned w1 = 0, w2 = 0;
                w1 = __builtin_amdgcn_cvt_pk_fp8_f32(T[(kc + 0) * 65 + n], T[(kc + 1) * 65 + n], w1, false); w1 = __builtin_amdgcn_cvt_pk_fp8_f32(T[(kc + 2) * 65 + n], T[(kc + 3) * 65 + n], w1, true);
                w2 = __builtin_amdgcn_cvt_pk_fp8_f32(T[(kc + 4) * 65 + n], T[(kc + 5) * 65 + n], w2, false); w2 = __builtin_amdgcn_cvt_pk_fp8_f32(T[(kc + 6) * 65 + n], T[(kc + 7) * 65 + n], w2, true);
                o8.x = w1; o8.y = w2; *(u32x2*)((unsigned char*)WT + (size_t)(n0 + n) * K + k0 + kc) = o8; }
            else *(u32x4*)(WT + (size_t)(n0 + n) * K + k0 + kc) = o; }
        asm volatile("s_waitcnt lgkmcnt(0)" ::: "memory");
    }
    item_base += nitems;
}

struct Unit { int pm, pn, b; };
struct GemmDesc { const bf16_t* A; int lda; long a_bs; const bf16_t* Bt; int ldb; long b_bs; int nM, nN, nB, K; int vG, vc; };
template <class Epi>
DEV void gemm_simple(float* lds, const GemmDesc g, const Epi& E) {
    const int tid = threadIdx.x, lane = tid & 63, wid = tid >> 6, wr = wid >> 2, wc = wid & 3, fr = lane & 15, fq = lane >> 4;
    float* As = lds; float* Bs = lds + 256 * 20;
    const int total = g.nM * g.nN * g.nB;
    for (int u = blockIdx.x; u < total; u += gridDim.x) {
        Unit un; un.pm = u % g.nM; un.pn = (u / g.nM) % g.nN; un.b = u / (g.nM * g.nN);
        const bf16_t* Ab = g.A + (size_t)un.b * g.a_bs + (size_t)un.pm * 256 * g.lda;
        const bf16_t* Bb = g.Bt + (size_t)un.b * g.b_bs + (size_t)un.pn * 256 * g.ldb;
        f32x4 acc[2][2][4][2];
#pragma unroll
        for (int a = 0; a < 2; ++a)
#pragma unroll
            for (int b = 0; b < 2; ++b)
#pragma unroll
                for (int m = 0; m < 4; ++m)
#pragma unroll
                    for (int n = 0; n < 2; ++n) acc[a][b][m][n] = (f32x4){0.f, 0.f, 0.f, 0.f};
        for (int k0 = 0; k0 < g.K; k0 += 16) {
            __syncthreads();
            { const int r = tid >> 1, kk = (tid & 1) * 8;
              const u32x4 a = *(const u32x4*)(Ab + (size_t)r * g.lda + k0 + kk);
              const u32x4 b = *(const u32x4*)(Bb + (size_t)(Epi::PM ? perm_p(r) : r) * g.ldb + k0 + kk);
              float* ap = As + r * 20 + kk; float* bp = Bs + r * 20 + kk;
              *(f32x4*)ap = (f32x4){bflo(a.x), bfhi(a.x), bflo(a.y), bfhi(a.y)}; *(f32x4*)(ap + 4) = (f32x4){bflo(a.z), bfhi(a.z), bflo(a.w), bfhi(a.w)};
              *(f32x4*)bp = (f32x4){bflo(b.x), bfhi(b.x), bflo(b.y), bfhi(b.y)}; *(f32x4*)(bp + 4) = (f32x4){bflo(b.z), bfhi(b.z), bflo(b.w), bfhi(b.w)}; }
            __syncthreads();
#pragma unroll 1
            for (int k4 = 0; k4 < 16; k4 += 4) {
#pragma unroll
                for (int ai = 0; ai < 2; ++ai) {
                    f32x4 av[4];
#pragma unroll
                    for (int m = 0; m < 4; ++m) av[m] = *(const f32x4*)(As + (ai * 128 + wr * 64 + m * 16 + fr) * 20 + k4);
#pragma unroll
                    for (int bj = 0; bj < 2; ++bj)
#pragma unroll
                        for (int n = 0; n < 2; ++n)
#pragma unroll
                            for (int i = 0; i < 4; ++i) {
                                const f32x4 b = *(const f32x4*)(Bs + (bj * 128 + wc * 32 + n * 16 + fq * 4 + i) * 20 + k4);
#pragma unroll
                                for (int m = 0; m < 4; ++m) { const f32x4 a = av[m]; float c = acc[ai][bj][m][n][i];
                                    c = fmaf(a[0], b[0], c); c = fmaf(a[1], b[1], c); c = fmaf(a[2], b[2], c); c = fmaf(a[3], b[3], c); acc[ai][bj][m][n][i] = c; }
                                asm volatile("" ::: "memory");
                            }
                }
            }
        }
        { int fr2 = fr, fq2 = fq, wr2 = wr, wc2 = wc; asm volatile("" : "+v"(fr2), "+v"(fq2), "+v"(wr2), "+v"(wc2));
          E(acc, un, wr2, wc2, fr2, fq2); }
    }
}

#define LAS __attribute__((address_space(3)))
typedef short bf16x8 __attribute__((ext_vector_type(8)));
constexpr int BM = 256, BK = 64, HALF = 128, HTB = HALF * BK * 2, STAGE_BYTES = 8 * HTB;
DEV int lds_byte(int r, int c) { const int st = (r >> 4) * 2 + (c >> 5), rr = r & 15, cc = c & 31, ob = rr * 64 + cc * 2; return st * 1024 + (ob ^ (((ob >> 9) & 1) << 5)); }
DEV void stage_rc(int b, int& R, int& C) { const int st = b / 1024, sb = b % 1024, swz = sb ^ (((sb >> 9) & 1) << 5); R = (st >> 1) * 16 + swz / 64; C = (st & 1) * 32 + (swz % 64) / 2; }
struct UnitOrder { int nM, nN, total, G, c;
    DEV bool next(int i, Unit& u) const { const int L = i * G + c; if (L >= total) return false; u.pm = L % nM; u.pn = (L / nM) % nN; u.b = L / (nM * nN); return true; } };
template <class Epi, bool ALIGN_EPI, bool SP2>
__device__ __forceinline__ void gemm_mfma(LAS unsigned char* lds, const GemmDesc g, const Epi& E) {
    const UnitOrder S{g.nM, g.nN, g.nM * g.nN * g.nB, g.vG ? g.vG : (int)gridDim.x, g.vG ? g.vc : (int)blockIdx.x};
    const int tid = threadIdx.x, wid = __builtin_amdgcn_readfirstlane(tid >> 6), lane = tid & 63, wr = wid >> 2, wc = wid & 3, fr = lane & 15, fq = lane >> 4;
    int K = g.K; asm volatile("" : "+s"(K));
    const int nt = K / BK;
    unsigned voffA[2], voffB[2];
#pragma unroll
    for (int i = 0; i < 2; ++i) { int R, C; stage_rc(tid * 16 + i * 8192, R, C); voffA[i] = (unsigned)(R * g.lda + C) * 2u; voffB[i] = (unsigned)((Epi::PM ? perm_p(R) : R) * g.ldb + C) * 2u; }
    const size_t kstep = (size_t)(BK * 2);
    const size_t hstepA = (size_t)HALF * g.lda * 2, hstepB = (size_t)HALF * g.ldb * 2;
    const unsigned ldsw = (unsigned)wid * 1024u;
    const int aoff = lds_byte(wr * 64 + fr, fq * 8), boff = lds_byte(wc * 32 + fr, fq * 8);
#define PG8_SA(b, h) (((b) * 2 + (h)) * HTB)
#define PG8_SB(b, h) ((4 + (b) * 2 + (h)) * HTB)
#define PG8_STAGE(bufoff, gbase, voff) do { _Pragma("unroll") for (int _i = 0; _i < 2; ++_i) \
        __builtin_amdgcn_global_load_lds((const unsigned*)((const char*)(gbase) + (voff)[_i]), (LAS unsigned*)(lds + (bufoff) + ldsw + _i * 8192), 16, 0, 0); } while (0)
#define PG8_LDA(dst, b, h) do { _Pragma("unroll") for (int m = 0; m < 4; ++m) _Pragma("unroll") for (int k = 0; k < 2; ++k) dst[m][k] = *(const LAS bf16x8*)(lds + PG8_SA(b, h) + aoff + m * 2048 + k * 1024); } while (0)
#define PG8_LDB(dst, b, h) do { _Pragma("unroll") for (int n = 0; n < 2; ++n) _Pragma("unroll") for (int k = 0; k < 2; ++k) dst[n][k] = *(const LAS bf16x8*)(lds + PG8_SB(b, h) + boff + n * 2048 + k * 1024); } while (0)
#define PG8_MMA(ai, bj, At, Bt) do { __builtin_amdgcn_s_setprio(1); _Pragma("unroll") for (int m = 0; m < 4; ++m) _Pragma("unroll") for (int n = 0; n < 2; ++n) _Pragma("unroll") for (int k = 0; k < 2; ++k) \
        acc[ai][bj][m][n] = __builtin_amdgcn_mfma_f32_16x16x32_bf16(Bt[n][k], At[m][k], acc[ai][bj][m][n], 0, 0, 0); __builtin_amdgcn_s_setprio(0); } while (0)
#define PG8_WAIT_V(n) asm volatile("s_waitcnt vmcnt(" #n ")" ::: "memory")
#define PG8_WAIT_L(n) asm volatile("s_waitcnt lgkmcnt(" #n ")" ::: "memory")
#define PG8_BAR __builtin_amdgcn_s_barrier()
#define PG8_SCHED __builtin_amdgcn_sched_barrier(0)
    Unit cur, nxt; int ui = 0;
    if (!S.next(0, cur)) return;
    f32x4 acc[2][2][4][2];
#pragma unroll
    for (int a = 0; a < 2; ++a)
#pragma unroll
        for (int b = 0; b < 2; ++b)
#pragma unroll
            for (int m = 0; m < 4; ++m)
#pragma unroll
                for (int n = 0; n < 2; ++n) acc[a][b][m][n] = (f32x4){0.f, 0.f, 0.f, 0.f};
    bf16x8 At[4][2], B0[2][2], B1[2][2];
    const char* cA = (const char*)(g.A + (size_t)cur.b * g.a_bs) + (size_t)cur.pm * 2 * hstepA; const char* cB = (const char*)(g.Bt + (size_t)cur.b * g.b_bs) + (size_t)cur.pn * 2 * hstepB;
    if constexpr (SP2) {
        PG8_STAGE(PG8_SB(0, 0), cB, voffB); PG8_STAGE(PG8_SB(0, 1), cB + hstepB, voffB); PG8_STAGE(PG8_SA(0, 0), cA, voffA); PG8_STAGE(PG8_SA(0, 1), cA + hstepA, voffA);
        if (wr == 1) PG8_BAR;
        PG8_WAIT_V(2); PG8_BAR;
        PG8_STAGE(PG8_SB(1, 0), cB + kstep, voffB); PG8_STAGE(PG8_SA(1, 0), cA + kstep, voffA); PG8_STAGE(PG8_SB(1, 1), cB + hstepB + kstep, voffB);
        PG8_WAIT_V(6); PG8_BAR;
    } else {
        PG8_STAGE(PG8_SB(0, 0), cB, voffB); PG8_STAGE(PG8_SA(0, 0), cA, voffA); PG8_STAGE(PG8_SB(0, 1), cB + hstepB, voffB); PG8_STAGE(PG8_SA(0, 1), cA + hstepA, voffA);
        if (wr == 1) PG8_BAR;
        PG8_WAIT_V(4); PG8_BAR;
        PG8_STAGE(PG8_SB(1, 0), cB + kstep, voffB); PG8_STAGE(PG8_SA(1, 0), cA + kstep, voffA); PG8_STAGE(PG8_SB(1, 1), cB + hstepB + kstep, voffB);
        PG8_WAIT_V(6); PG8_BAR;
    }
    for (;;) {
        const bool has_next = S.next(ui + 1, nxt);
        const char* nA = has_next ? (const char*)(g.A + (size_t)nxt.b * g.a_bs) + (size_t)nxt.pm * 2 * hstepA : cA; const char* nB = has_next ? (const char*)(g.Bt + (size_t)nxt.b * g.b_bs) + (size_t)nxt.pn * 2 * hstepB : cB;
        for (int t = 0; t < nt; t += 2) {
            const bool last = (t == nt - 2);
            const char* a1 = cA + (size_t)(t + 1) * kstep;
            const char* a2 = last ? nA : cA + (size_t)(t + 2) * kstep; const char* b2 = last ? nB : cB + (size_t)(t + 2) * kstep;
            const char* a3 = a2 + kstep; const char* b3 = b2 + kstep;
            if constexpr (SP2) {
            PG8_LDB(B0, 0, 0); PG8_LDB(B1, 0, 1); PG8_SCHED; PG8_LDA(At, 0, 0); PG8_STAGE(PG8_SA(1, 1), a1 + hstepA, voffA);
            PG8_WAIT_V(8); PG8_WAIT_L(0); PG8_BAR; PG8_MMA(0, 0, At, B0); PG8_MMA(0, 1, At, B1); PG8_BAR; PG8_SCHED;
            PG8_LDA(At, 0, 1); PG8_STAGE(PG8_SB(0, 0), b2, voffB); PG8_STAGE(PG8_SB(0, 1), b2 + hstepB, voffB); PG8_STAGE(PG8_SA(0, 0), a2, voffA);
            PG8_WAIT_V(8); PG8_WAIT_L(0); PG8_BAR; PG8_MMA(1, 0, At, B0); PG8_MMA(1, 1, At, B1); PG8_BAR; PG8_SCHED;
            PG8_LDB(B0, 1, 0); PG8_LDB(B1, 1, 1); PG8_SCHED; PG8_LDA(At, 1, 0); PG8_STAGE(PG8_SA(0, 1), a2 + hstepA, voffA);
            PG8_WAIT_V(8); PG8_WAIT_L(0); PG8_BAR; PG8_MMA(0, 0, At, B0); PG8_MMA(0, 1, At, B1); PG8_BAR; PG8_SCHED;
            PG8_LDA(At, 1, 1); PG8_STAGE(PG8_SB(1, 0), b3, voffB); PG8_STAGE(PG8_SB(1, 1), b3 + hstepB, voffB); PG8_STAGE(PG8_SA(1, 0), a3, voffA);
            PG8_WAIT_V(8); PG8_WAIT_L(0); PG8_BAR; PG8_MMA(1, 0, At, B0); PG8_MMA(1, 1, At, B1); PG8_BAR; PG8_SCHED;
            } else {
            PG8_LDB(B0, 0, 0); PG8_SCHED; PG8_LDA(At, 0, 0); PG8_STAGE(PG8_SA(1, 1), a1 + hstepA, voffA);
            PG8_WAIT_L(8); PG8_BAR; PG8_WAIT_L(0); PG8_MMA(0, 0, At, B0); PG8_BAR; PG8_SCHED;
            PG8_LDB(B1, 0, 1); PG8_STAGE(PG8_SB(0, 0), b2, voffB);
            PG8_BAR; PG8_WAIT_L(0); PG8_MMA(0, 1, At, B1); PG8_BAR;
            PG8_LDA(At, 0, 1); PG8_STAGE(PG8_SA(0, 0), a2, voffA);
            PG8_BAR; PG8_WAIT_L(0); PG8_MMA(1, 0, At, B0); PG8_BAR; PG8_SCHED;
            PG8_STAGE(PG8_SB(0, 1), b2 + hstepB, voffB);
            PG8_WAIT_V(6); PG8_BAR; PG8_MMA(1, 1, At, B1); PG8_BAR;
            PG8_LDB(B0, 1, 0); PG8_SCHED; PG8_LDA(At, 1, 0); PG8_STAGE(PG8_SA(0, 1), a2 + hstepA, voffA);
            PG8_WAIT_L(8); PG8_BAR; PG8_WAIT_L(0); PG8_MMA(0, 0, At, B0); PG8_BAR; PG8_SCHED;
            PG8_LDB(B1, 1, 1); PG8_STAGE(PG8_SB(1, 0), b3, voffB);
            PG8_BAR; PG8_WAIT_L(0); PG8_MMA(0, 1, At, B1); PG8_BAR;
            PG8_LDA(At, 1, 1); PG8_STAGE(PG8_SA(1, 0), a3, voffA);
            PG8_BAR; PG8_WAIT_L(0); PG8_MMA(1, 0, At, B0); PG8_BAR; PG8_SCHED;
            PG8_STAGE(PG8_SB(1, 1), b3 + hstepB, voffB);
            PG8_WAIT_V(6); PG8_BAR; PG8_MMA(1, 1, At, B1); PG8_BAR;
            }
        }
        if constexpr (ALIGN_EPI) { if (wr == 0) PG8_BAR; }
        { int fr2 = fr, fq2 = fq, wr2 = wr, wc2 = wc; asm volatile("" : "+v"(fr2), "+v"(fq2), "+v"(wr2), "+v"(wc2)); E(acc, cur, wr2, wc2, fr2, fq2); }
        if (!has_next) break;
#pragma unroll
        for (int a = 0; a < 2; ++a)
#pragma unroll
            for (int b = 0; b < 2; ++b)
#pragma unroll
                for (int m = 0; m < 4; ++m)
#pragma unroll
                    for (int n = 0; n < 2; ++n) acc[a][b][m][n] = (f32x4){0.f, 0.f, 0.f, 0.f};
        cur = nxt; cA = nA; cB = nB; ++ui;
        if constexpr (ALIGN_EPI) { if (wr == 1) PG8_BAR; }
    }
    PG8_WAIT_V(0);
    if constexpr (!ALIGN_EPI) { if (wr == 0) PG8_BAR; }
    PG8_BAR;
#undef PG8_SA
#undef PG8_SB
#undef PG8_STAGE
#undef PG8_LDA
#undef PG8_LDB
#undef PG8_MMA
#undef PG8_WAIT_V
#undef PG8_WAIT_L
#undef PG8_BAR
#undef PG8_SCHED
}

typedef int i32x4_t __attribute__((ext_vector_type(4)));
typedef int i32x8_t __attribute__((ext_vector_type(8)));
#ifdef STAMP_SEL
#ifndef GST_UNIT
#define GST_UNIT 1
#endif
#ifndef GST_NN
#define GST_NN 38
#endif
#define GSTAMP(k) do { if (g.nN == GST_NN && blockIdx.x == STAMP_BLK && threadIdx.x == 0 && ui == GST_UNIT) ((unsigned long long*)(((unsigned char* const __attribute__((address_space(4)))*)__builtin_amdgcn_kernarg_segment_ptr())[29] + WS_SMALL + 400 * 1024))[40 + (k)] = __builtin_amdgcn_s_memrealtime(); } while (0)
#else
#define GSTAMP(k) do {} while (0)
#endif
template <class Epi, bool ALIGN_EPI, bool SP2>
__device__ __forceinline__ void gemm_mfma8(LAS unsigned char* lds, const GemmDesc g, const Epi& E) {
    const UnitOrder S{g.nM, g.nN, g.nM * g.nN * g.nB, g.vG ? g.vG : (int)gridDim.x, g.vG ? g.vc : (int)blockIdx.x};
    const int tid = threadIdx.x, wid = __builtin_amdgcn_readfirstlane(tid >> 6), lane = tid & 63, wr = wid >> 2, wc = wid & 3, fr = lane & 15, fq = lane >> 4;
    int K = g.K; asm volatile("" : "+s"(K));
    const int nt = K / 128;
    unsigned voffA[2], voffB[2];
#pragma unroll
    for (int i = 0; i < 2; ++i) { int R, C; stage_rc(tid * 16 + i * 8192, R, C); voffA[i] = (unsigned)(R * g.lda + C * 2); voffB[i] = (unsigned)((Epi::PM ? perm_p(R) : R) * g.ldb + C * 2); }
    const size_t kstep = (size_t)(BK * 2);
    const size_t hstepA = (size_t)HALF * g.lda, hstepB = (size_t)HALF * g.ldb;
    const unsigned ldsw = (unsigned)wid * 1024u;
    const int aoff = lds_byte(wr * 64 + fr, fq * 8), boff = lds_byte(wc * 32 + fr, fq * 8);
#define PG8_SA(b, h) (((b) * 2 + (h)) * HTB)
#define PG8_SB(b, h) ((4 + (b) * 2 + (h)) * HTB)
#define PG8_STAGE(bufoff, gbase, voff) do { _Pragma("unroll") for (int _i = 0; _i < 2; ++_i) \
        __builtin_amdgcn_global_load_lds((const unsigned*)((const char*)(gbase) + (voff)[_i]), (LAS unsigned*)(lds + (bufoff) + ldsw + _i * 8192), 16, 0, 0); } while (0)
#define PG8_LDA(dst, b, h) do { _Pragma("unroll") for (int m = 0; m < 4; ++m) { dst[m].lo = *(const LAS i32x4_t*)(lds + PG8_SA(b, h) + aoff + m * 2048); dst[m].hi = *(const LAS i32x4_t*)(lds + PG8_SA(b, h) + aoff + m * 2048 + 1024); } } while (0)
#define PG8_LDB(dst, b, h) do { _Pragma("unroll") for (int n = 0; n < 2; ++n) { dst[n].lo = *(const LAS i32x4_t*)(lds + PG8_SB(b, h) + boff + n * 2048); dst[n].hi = *(const LAS i32x4_t*)(lds + PG8_SB(b, h) + boff + n * 2048 + 1024); } } while (0)
#define PG8_MMA(ai, bj, At, Bt) do { __builtin_amdgcn_s_setprio(1); _Pragma("unroll") for (int m = 0; m < 4; ++m) _Pragma("unroll") for (int n = 0; n < 2; ++n) \
        asm volatile("v_mfma_scale_f32_16x16x128_f8f6f4 %0, %1, %2, %0, %3, %3 op_sel_hi:[0,0,0]" : "+v"(acc[ai][bj][m][n]) : "v"(Bt[n]), "v"(At[m]), "v"(mxs)); __builtin_amdgcn_s_setprio(0); } while (0)
#define PG8_CAT(x) __builtin_shufflevector(__builtin_bit_cast(i32x4_t, x[0]), __builtin_bit_cast(i32x4_t, x[1]), 0, 1, 2, 3, 4, 5, 6, 7)
#define PG8_WAIT_V(n) asm volatile("s_waitcnt vmcnt(" #n ")" ::: "memory")
#define PG8_WAIT_L(n) asm volatile("s_waitcnt lgkmcnt(" #n ")" ::: "memory")
#define PG8_BAR __builtin_amdgcn_s_barrier()
#define PG8_SCHED __builtin_amdgcn_sched_barrier(0)
    const int mxs = 0x7F7F7F7F;
    Unit cur, nxt; int ui = 0;
    if (!S.next(0, cur)) return;
    f32x4 acc[2][2][4][2];
#pragma unroll
    for (int a = 0; a < 2; ++a)
#pragma unroll
        for (int b = 0; b < 2; ++b)
#pragma unroll
            for (int m = 0; m < 4; ++m)
#pragma unroll
                for (int n = 0; n < 2; ++n) acc[a][b][m][n] = (f32x4){0.f, 0.f, 0.f, 0.f};
    i32x8_t At[4], B0[2], B1[2];
    const char* cA = ((const char*)g.A + (size_t)cur.b * g.a_bs) + (size_t)cur.pm * 2 * hstepA; const char* cB = ((const char*)g.Bt + (size_t)cur.b * g.b_bs) + (size_t)cur.pn * 2 * hstepB;
    if constexpr (SP2) {
        PG8_STAGE(PG8_SB(0, 0), cB, voffB); PG8_STAGE(PG8_SB(0, 1), cB + hstepB, voffB); PG8_STAGE(PG8_SA(0, 0), cA, voffA); PG8_STAGE(PG8_SA(0, 1), cA + hstepA, voffA);
        if (wr == 1) PG8_BAR;
        PG8_WAIT_V(2); PG8_BAR;
        PG8_STAGE(PG8_SB(1, 0), cB + kstep, voffB); PG8_STAGE(PG8_SA(1, 0), cA + kstep, voffA); PG8_STAGE(PG8_SB(1, 1), cB + hstepB + kstep, voffB);
        PG8_WAIT_V(6); PG8_BAR;
    } else {
        PG8_STAGE(PG8_SB(0, 0), cB, voffB); PG8_STAGE(PG8_SA(0, 0), cA, voffA); PG8_STAGE(PG8_SB(0, 1), cB + hstepB, voffB); PG8_STAGE(PG8_SA(0, 1), cA + hstepA, voffA);
        if (wr == 1) PG8_BAR;
        PG8_WAIT_V(4); PG8_BAR;
        PG8_STAGE(PG8_SB(1, 0), cB + kstep, voffB); PG8_STAGE(PG8_SA(1, 0), cA + kstep, voffA); PG8_STAGE(PG8_SB(1, 1), cB + hstepB + kstep, voffB);
        PG8_WAIT_V(6); PG8_BAR;
    }
    for (;;) {
        const bool has_next = S.next(ui + 1, nxt);
        const char* nA = has_next ? ((const char*)g.A + (size_t)nxt.b * g.a_bs) + (size_t)nxt.pm * 2 * hstepA : cA; const char* nB = has_next ? ((const char*)g.Bt + (size_t)nxt.b * g.b_bs) + (size_t)nxt.pn * 2 * hstepB : cB;
        GSTAMP(0);
        for (int t = 0; t < nt; t += 2) {
            const bool last = (t == nt - 2);
            const char* a1 = cA + (size_t)(t + 1) * kstep;
            const char* a2 = last ? nA : cA + (size_t)(t + 2) * kstep; const char* b2 = last ? nB : cB + (size_t)(t + 2) * kstep;
            const char* a3 = a2 + kstep; const char* b3 = b2 + kstep;
            if constexpr (SP2) {
            PG8_LDB(B0, 0, 0); PG8_LDB(B1, 0, 1); PG8_SCHED; PG8_LDA(At, 0, 0); PG8_STAGE(PG8_SA(1, 1), a1 + hstepA, voffA);
            PG8_WAIT_V(8); PG8_WAIT_L(0); PG8_BAR; PG8_MMA(0, 0, At, B0); PG8_MMA(0, 1, At, B1); PG8_BAR; PG8_SCHED;
            PG8_LDA(At, 0, 1); PG8_STAGE(PG8_SB(0, 0), b2, voffB); PG8_STAGE(PG8_SB(0, 1), b2 + hstepB, voffB); PG8_STAGE(PG8_SA(0, 0), a2, voffA);
            PG8_WAIT_V(8); PG8_WAIT_L(0); PG8_BAR; PG8_MMA(1, 0, At, B0); PG8_MMA(1, 1, At, B1); PG8_BAR; PG8_SCHED;
            PG8_LDB(B0, 1, 0); PG8_LDB(B1, 1, 1); PG8_SCHED; PG8_LDA(At, 1, 0); PG8_STAGE(PG8_SA(0, 1), a2 + hstepA, voffA);
            PG8_WAIT_V(8); PG8_WAIT_L(0); PG8_BAR; PG8_MMA(0, 0, At, B0); PG8_MMA(0, 1, At, B1); PG8_BAR; PG8_SCHED;
            PG8_LDA(At, 1, 1); PG8_STAGE(PG8_SB(1, 0), b3, voffB); PG8_STAGE(PG8_SB(1, 1), b3 + hstepB, voffB); PG8_STAGE(PG8_SA(1, 0), a3, voffA);
            PG8_WAIT_V(8); PG8_WAIT_L(0); PG8_BAR; PG8_MMA(1, 0, At, B0); PG8_MMA(1, 1, At, B1); PG8_BAR; PG8_SCHED;
            } else {
            PG8_LDB(B0, 0, 0); PG8_SCHED; PG8_LDA(At, 0, 0); PG8_STAGE(PG8_SA(1, 1), a1 + hstepA, voffA);
            PG8_WAIT_L(8); PG8_BAR; PG8_WAIT_L(0); PG8_MMA(0, 0, At, B0); PG8_BAR; PG8_SCHED;
            PG8_LDB(B1, 0, 1); PG8_STAGE(PG8_SB(0, 0), b2, voffB);
            PG8_BAR; PG8_WAIT_L(0); PG8_MMA(0, 1, At, B1); PG8_BAR;
            PG8_LDA(At, 0, 1); PG8_STAGE(PG8_SA(0, 0), a2, voffA);
            PG8_BAR; PG8_WAIT_L(0); PG8_MMA(1, 0, At, B0); PG8_BAR; PG8_SCHED;
            PG8_STAGE(PG8_SB(0, 1), b2 + hstepB, voffB);
            PG8_WAIT_V(6); PG8_BAR; PG8_MMA(1, 1, At, B1); PG8_BAR;
            PG8_LDB(B0, 1, 0); PG8_SCHED; PG8_LDA(At, 1, 0); PG8_STAGE(PG8_SA(0, 1), a2 + hstepA, voffA);
            PG8_WAIT_L(8); PG8_BAR; PG8_WAIT_L(0); PG8_MMA(0, 0, At, B0); PG8_BAR; PG8_SCHED;
            PG8_LDB(B1, 1, 1); PG8_STAGE(PG8_SB(1, 0), b3, voffB);
            PG8_BAR; PG8_WAIT_L(0); PG8_MMA(0, 1, At, B1); PG8_BAR;
            PG8_LDA(At, 1, 1); PG8_STAGE(PG8_SA(1, 0), a3, voffA);
            PG8_BAR; PG8_WAIT_L(0); PG8_MMA(1, 0, At, B0); PG8_BAR; PG8_SCHED;
            PG8_STAGE(PG8_SB(1, 1), b3 + hstepB, voffB);
            PG8_WAIT_V(6); PG8_BAR; PG8_MMA(1, 1, At, B1); PG8_BAR;
            }
        }
        GSTAMP(1);
        if constexpr (ALIGN_EPI) { if (wr == 0) PG8_BAR; }
        asm volatile("s_nop 15\n\ts_nop 7" ::: "memory");
        { int fr2 = fr, fq2 = fq, wr2 = wr, wc2 = wc; asm volatile("" : "+v"(fr2), "+v"(fq2), "+v"(wr2), "+v"(wc2)); E(acc, cur, wr2, wc2, fr2, fq2); }
        GSTAMP(2);
        if (!has_next) break;
#pragma unroll
        for (int a = 0; a < 2; ++a)
#pragma unroll
            for (int b = 0; b < 2; ++b)
#pragma unroll
                for (int m = 0; m < 4; ++m)
#pragma unroll
                    for (int n = 0; n < 2; ++n) acc[a][b][m][n] = (f32x4){0.f, 0.f, 0.f, 0.f};
        cur = nxt; cA = nA; cB = nB; ++ui;
        if constexpr (ALIGN_EPI) { if (wr == 1) PG8_BAR; }
    }
    PG8_WAIT_V(0);
    if constexpr (!ALIGN_EPI) { if (wr == 0) PG8_BAR; }
    PG8_BAR;
#undef PG8_SA
#undef PG8_SB
#undef PG8_STAGE
#undef PG8_LDA
#undef PG8_LDB
#undef PG8_MMA
#undef PG8_WAIT_V
#undef PG8_WAIT_L
#undef PG8_BAR
#undef PG8_SCHED
}


#define EPI_ARGS const f32x4 (&acc)[2][2][4][2], const Unit& u, int wr, int wc, int fr, int fq
#define ROW_OF(ai, m) (u.pm * 256 + (ai) * 128 + wr * 64 + (m) * 16 + fr)
#define COL_OF(bj, n) (u.pn * 256 + (bj) * 128 + wc * 32 + (n) * 16 + fq * 4)
#define FOR_AI_M _Pragma("unroll") for (int ai = 0; ai < 2; ++ai) _Pragma("unroll") for (int m = 0; m < 4; ++m)
#define FOR_BJ_N _Pragma("unroll") for (int bj = 0; bj < 2; ++bj) _Pragma("unroll") for (int n = 0; n < 2; ++n)
#define FOR_BJ _Pragma("unroll") for (int bj = 0; bj < 2; ++bj)
#define COLP(bj) (u.pn * 256 + (bj) * 128 + wc * 32 + fq * 8)

DEV float sumsq4(f32x4 v) { return (v[0] * v[0] + v[1] * v[1]) + (v[2] * v[2] + v[3] * v[3]); }
DEV void row_atomic(u64* dst, int row, float s, int fq) { s += __shfl_xor(s, 16); s += __shfl_xor(s, 32); if (fq == 0) atomicAdd(dst + row, (u64)(s * 4294967296.f)); }
DEV float ssq_get(const u64* p, int row) { return (float)p[row] * 2.3283064365386963e-10f; }

struct EpiIn { static constexpr int PM = 1;
    const float* ssq0; const float* rope; const float* b_gate;
    bf16_t *cq, *kpe, *xr, *gy; u64 *ssqq; float oscale;
    DEV void operator()(EPI_ARGS) const {
        const int pn = u.pn;
#define FENCE __builtin_amdgcn_sched_barrier(0)
        if (pn < 5) {
            FOR_AI_M { const int row = ROW_OF(ai, m); const float rs = rsqrtf(ssq0[row] * (1.f / DM) + EPS) * oscale;
                float s = 0.f;
                const size_t ro = pn < 3 ? (size_t)row * QL : (size_t)6 * 1024 * 1024 + (size_t)row * KVL - 768;
                FOR_BJ { const f32x4 v0 = acc[ai][bj][m][0] * rs, v1 = acc[ai][bj][m][1] * rs; s += sumsq4(v0) + sumsq4(v1); *(u32x4*)(cq + ro + COLP(bj)) = pk8(v0, v1); }
                row_atomic(ssqq + (pn < 3 ? 0 : 8192), row, s, fq); FENCE; }
        } else if (pn == 5) {
            if (wc < 2) { FOR_AI_M { const int row = ROW_OF(ai, m); const float rs = rsqrtf(ssq0[row] * (1.f / DM) + EPS) * oscale;
                const f32x4 x1 = acc[ai][0][m][0] * rs, x2 = acc[ai][0][m][1] * rs; f32x4 o1, o2;
#pragma unroll
                for (int i = 0; i < 4; ++i) { const f32x2 cs = *(const f32x2*)(rope + ((size_t)row * 32 + 16 * wc + 4 * fq + i) * 2);
                    o1[i] = x1[i] * cs.x - x2[i] * cs.y; o2[i] = x2[i] * cs.x + x1[i] * cs.y; }
                *(u32x4*)(kpe + (size_t)row * 64 + 32 * wc + 8 * fq) = pk8(o1, o2); FENCE; } }
        } else {
            const int seg = (pn - 6) >> 3;
            bf16_t* dst = seg == 0 ? xr : gy + (size_t)(seg - 1) * (16 * 1024 * 1024);
            const int colb = (pn - 6 - 8 * seg) * 256 + wc * 32 + fq * 8;
            FOR_AI_M { const int row = ROW_OF(ai, m); const float rs = rsqrtf(ssq0[row] * (1.f / DM) + EPS) * oscale;
                FOR_BJ { const int col = colb + bj * 128; f32x4 v[2];
#pragma unroll
                    for (int n = 0; n < 2; ++n) { v[n] = acc[ai][bj][m][n] * rs;
                        if (seg == 1) { v[n][0] = gelu_tanh(v[n][0]); v[n][1] = gelu_tanh(v[n][1]); v[n][2] = gelu_tanh(v[n][2]); v[n][3] = gelu_tanh(v[n][3]); }
                        if (seg >= 2) { const f32x4 bb = *(const f32x4*)(b_gate + (seg - 2) * DM + col + 4 * n);
                            v[n][0] = sigmoidf_(v[n][0] + bb[0]); v[n][1] = sigmoidf_(v[n][1] + bb[1]); v[n][2] = sigmoidf_(v[n][2] + bb[2]); v[n][3] = sigmoidf_(v[n][3] + bb[3]); } }
                    *(u32x4*)(dst + (size_t)row * DM + col) = pk8(v[0], v[1]); }
                FENCE; }
        }
    }
};
struct EpiQ { static constexpr int PM = 1;
    const u64* ssqq; const float* rope; bf16_t *qn, *qp;
    DEV void operator()(EPI_ARGS) const {
        if (u.pn < 8) {
            FOR_AI_M { const int row = ROW_OF(ai, m); const float rs = rsqrtf(ssq_get(ssqq, row) * (1.f / QL) + EPS);
                FOR_BJ { *(u32x4*)(qn + (size_t)row * DM + COLP(bj)) = pk8(acc[ai][bj][m][0] * rs, acc[ai][bj][m][1] * rs); } FENCE; }
        } else {
            const int g = wc & 1;
            FOR_AI_M { const int row = ROW_OF(ai, m); const float rs = rsqrtf(ssq_get(ssqq, row) * (1.f / QL) + EPS);
                f32x2 cs[4];
#pragma unroll
                for (int i = 0; i < 4; ++i) cs[i] = *(const f32x2*)(rope + ((size_t)row * 32 + 16 * g + 4 * fq + i) * 2);
#pragma unroll
                for (int bj = 0; bj < 2; ++bj) { const f32x4 x1 = acc[ai][bj][m][0] * rs, x2 = acc[ai][bj][m][1] * rs; f32x4 o1, o2;
#pragma unroll
                    for (int i = 0; i < 4; ++i) { o1[i] = x1[i] * cs[i].x - x2[i] * cs[i].y; o2[i] = x2[i] * cs[i].x + x1[i] * cs[i].y; }
                    const int col = (u.pn - 8) * 256 + bj * 128 + wc * 32 + fq * 8;
                    *(u32x4*)(qp + (size_t)row * 1024 + col) = pk8(o1, o2); }
                FENCE; }
        }
    }
};
struct EpiKV { static constexpr int PM = 1;
    const u64* ssqkv; bf16_t *kn, *vv;
    DEV void operator()(EPI_ARGS) const {
        FOR_AI_M {
            const int row = ROW_OF(ai, m);
            const float rs = rsqrtf(ssq_get(ssqkv, row) * (1.f / KVL) + EPS);
            FOR_BJ { bf16_t* dst = bj == 0 ? kn : vv; *(u32x4*)(dst + (size_t)row * DM + u.pn * 128 + wc * 32 + fq * 8) = pk8(acc[ai][bj][m][0] * rs, acc[ai][bj][m][1] * rs); }
        }
    }
};
struct EpiGates { static constexpr int PM = 1;
    const float *b_a, *b_x, *n8sp; const bf16_t* xc; bf16_t *la, *gx;
    DEV void operator()(EPI_ARGS) const {
        FOR_AI_M {
            const int row = ROW_OF(ai, m);
            const int c0 = u.b * 128 + wc * 32 + fq * 8;
            const u32x4 xraw = *(const u32x4*)(xc + (size_t)row * DM + c0);
            f32x4 lv[2], gv[2];
#pragma unroll
            for (int n = 0; n < 2; ++n) { const int c = c0 + 4 * n;
                const f32x4 ba = *(const f32x4*)(b_a + c), bx = *(const f32x4*)(b_x + c), sp = *(const f32x4*)(n8sp + c);
                const f32x4 xv = n == 0 ? unpk4lo(xraw) : unpk4hi(xraw);
                f32x4 l, g;
#pragma unroll
                for (int i = 0; i < 4; ++i) { const float r = sigmoidf_(acc[ai][0][m][n][i] + ba[i]), ig = sigmoidf_(acc[ai][1][m][n][i] + bx[i]); const float lg = sp[i] * r, x2 = 2.f * lg;
                    const float em1 = (x2 > -0.02f) ? x2 * (1.f + x2 * (0.5f + x2 * (1.f / 6.f))) : (__expf(x2) - 1.f);
                    l[i] = lg * 1.4426950408889634f; g[i] = (row == 0 ? 1.f : sqrtf(fmaxf(-em1, 0.f))) * (ig * xv[i]); }
                lv[n] = l; gv[n] = g; }
            *(u32x4*)(la + (size_t)row * DM + c0) = pk8(lv[0], lv[1]); *(u32x4*)(gx + (size_t)row * DM + c0) = pk8(gv[0], gv[1]);
        }
    }
};
struct EpiMixA { static constexpr int PM = 1; const bf16_t* ga; bf16_t* mixa;
    DEV void operator()(EPI_ARGS) const { FOR_AI_M { const int row = ROW_OF(ai, m); FOR_BJ { const size_t o = (size_t)row * DM + COLP(bj); const u32x4 gv = *(const u32x4*)(ga + o);
        *(u32x4*)(mixa + o) = pk8(acc[ai][bj][m][0] * (1.f / (O_SCALE * WIN_SCALE)) * unpk4lo(gv), acc[ai][bj][m][1] * (1.f / (O_SCALE * WIN_SCALE)) * unpk4hi(gv)); } } } };
struct EpiMix { static constexpr int PM = 1; const bf16_t* gr; const bf16_t* mixa; unsigned char* mix;
    DEV void operator()(EPI_ARGS) const { FOR_AI_M { const int row = ROW_OF(ai, m); FOR_BJ { const size_t o = (size_t)row * DM + COLP(bj);
        const u32x4 ma = __builtin_nontemporal_load((const u32x4*)(mixa + o)); const u32x4 gv = *(const u32x4*)(gr + o); u32x2 w;
        w.x = f8pack((unpk4lo(ma) + acc[ai][bj][m][0] * (1.f / (Y_SCALE * WIN_SCALE)) * unpk4lo(gv)) * MIX_SCALE);
        w.y = f8pack((unpk4hi(ma) + acc[ai][bj][m][1] * (1.f / (Y_SCALE * WIN_SCALE)) * unpk4hi(gv)) * MIX_SCALE);
        *(u32x2*)(mix + o) = w; } } } };
struct EpiOut { static constexpr int PM = 1; const float* x; bf16_t* h1b; u64* ssq1;
    DEV void operator()(EPI_ARGS) const { FOR_AI_M { const int row = ROW_OF(ai, m); float s = 0.f;
        FOR_BJ { const size_t o = (size_t)row * DM + COLP(bj);
            const f32x4 v0 = *(const f32x4*)(x + o) + acc[ai][bj][m][0] * (1.f / (MIX_SCALE * WIN_SCALE)), v1 = *(const f32x4*)(x + o + 4) + acc[ai][bj][m][1] * (1.f / (MIX_SCALE * WIN_SCALE));
            s += sumsq4(v0) + sumsq4(v1); *(u32x4*)(h1b + o) = pk8(v0, v1); }
        row_atomic(ssq1, row, s, fq); } } };
struct EpiPeerQ { static constexpr int PM = 0; const u64* ssq1; bf16_t* q;
    DEV void operator()(EPI_ARGS) const { FOR_AI_M { const int row = ROW_OF(ai, m); const float rs = rsqrtf(ssq_get(ssq1, row) * (1.f / DM) + EPS);
        FOR_BJ_N { *(u32x2*)(q + (size_t)row * DM + COL_OF(bj, n)) = pk4(acc[ai][bj][m][n] * rs); } } } };
struct EpiPlain { static constexpr int PM = 1; bf16_t* o;
    DEV void operator()(EPI_ARGS) const { FOR_AI_M { const int row = ROW_OF(ai, m); FOR_BJ { *(u32x4*)(o + (size_t)row * DM + COLP(bj)) = pk8(acc[ai][bj][m][0], acc[ai][bj][m][1]); } } } };
struct EpiScores { static constexpr int PM = 0; float* sc; const u64* ssq1;
    DEV void operator()(EPI_ARGS) const { FOR_AI_M { const int row = ROW_OF(ai, m); const float rs = rsqrtf(ssq_get(ssq1, row) * (1.f / DM) + EPS);
        const unsigned i0 = (unsigned)((((row >> 5) * 16 + u.pn * 2) * 128 + wc * 32 + fq * 4) * 32 + (row & 31));
#pragma unroll
        for (int bj = 0; bj < 2; ++bj)
#pragma unroll
            for (int n = 0; n < 2; ++n) { const f32x4 v = acc[ai][bj][m][n] * rs; const unsigned i1 = i0 + bj * 4096 + n * 512; sc[i1] = v[0]; sc[i1 + 32] = v[1]; sc[i1 + 64] = v[2]; sc[i1 + 96] = v[3]; }
        FENCE; } } };
struct EpiWf { static constexpr int PM = 1; bf16_t* o;
    DEV void operator()(EPI_ARGS) const { FOR_AI_M { const int row = u.b * 256 + ai * 128 + wr * 64 + m * 16 + fr; FOR_BJ { *(u32x4*)(o + (size_t)row * DM + COLP(bj)) = pk8(acc[ai][bj][m][0], acc[ai][bj][m][1]); } } } };
struct EpiPle { static constexpr int PM = 0; const bf16_t* pp; const bf16_t* h; float* hout; u64* ssq3; const float* ssq2;
    DEV void operator()(EPI_ARGS) const { FOR_AI_M { const int row = ROW_OF(ai, m); float s = 0.f; const float rs2 = rsqrtf(ssq2[row] * (1.f / DM) + EPS) * (1.f / (WIN_SCALE * X_SCALE));
        FOR_BJ_N { const size_t o = (size_t)row * DM + COL_OF(bj, n); const f32x4 a = acc[ai][bj][m][n] * rs2, p4 = unpk4(*(const u32x2*)(pp + o)); f32x4 v = unpk4(*(const u32x2*)(h + o));
            v[0] += sigmoidf_(a[0]) * p4[0]; v[1] += sigmoidf_(a[1]) * p4[1]; v[2] += sigmoidf_(a[2]) * p4[2]; v[3] += sigmoidf_(a[3]) * p4[3]; s += sumsq4(v);
            *(f32x4*)(hout + o) = v; }
        row_atomic(ssq3, row, s, fq); } } };

struct EpiPleFinal { static constexpr int PM = 0; const bf16_t* pp; const bf16_t* h; float* out; u64* ssq3; const float* ssq2; const float* fn; unsigned* pcnt;
    DEV void operator()(EPI_ARGS) const {
        f32x4 (&acm)[2][2][4][2] = const_cast<f32x4 (&)[2][2][4][2]>(acc);
        FOR_AI_M { const int row = ROW_OF(ai, m); float s = 0.f; const float rs2 = rsqrtf(ssq2[row] * (1.f / DM) + EPS) * (1.f / (WIN_SCALE * X_SCALE));
            FOR_BJ_N { const size_t o = (size_t)row * DM + COL_OF(bj, n); const f32x4 a = acm[ai][bj][m][n] * rs2, p4 = unpk4(*(const u32x2*)(pp + o)); f32x4 v = unpk4(*(const u32x2*)(h + o));
                v[0] += sigmoidf_(a[0]) * p4[0]; v[1] += sigmoidf_(a[1]) * p4[1]; v[2] += sigmoidf_(a[2]) * p4[2]; v[3] += sigmoidf_(a[3]) * p4[3]; s += sumsq4(v);
                acm[ai][bj][m][n] = v; }
            row_atomic(ssq3, row, s, fq); FENCE; }
        asm volatile("s_waitcnt vmcnt(0)" ::: "memory");
        __syncthreads();
        if (threadIdx.x == 0) {
            unsigned* c_ = pcnt + 64 * u.pm;
            __hip_atomic_fetch_add(c_, 1u, __ATOMIC_RELAXED, __HIP_MEMORY_SCOPE_AGENT);
            unsigned sp_ = 0;
            while (__hip_atomic_load(c_, __ATOMIC_RELAXED, __HIP_MEMORY_SCOPE_AGENT) < 8u) { __builtin_amdgcn_s_sleep(1); if (++sp_ > (1u << 20)) break; }
            __builtin_amdgcn_fence(__ATOMIC_ACQUIRE, "agent");
            asm volatile("s_waitcnt vmcnt(0)" ::: "memory");
        }
        __syncthreads();
        FOR_AI_M { const int row = ROW_OF(ai, m);
            const float rs = rsqrtf((float)__hip_atomic_load(ssq3 + row, __ATOMIC_RELAXED, __HIP_MEMORY_SCOPE_AGENT) * 2.3283064365386963e-10f * (1.f / DM) + EPS);
            FOR_BJ_N { const int col = COL_OF(bj, n); *(f32x4*)(out + (size_t)row * DM + col) = acm[ai][bj][m][n] * rs * *(const f32x4*)(fn + col); }
            FENCE; }
    }
};

DEV void attn_simple(float* lds, const bf16_t* qn, const bf16_t* qp, const bf16_t* kn, const bf16_t* kpe, const bf16_t* vv, bf16_t* o_out) {
    const int tid = threadIdx.x, sub = tid & 7, rloc = tid >> 3;
    float* Ks = lds;
    float* Vs = lds + 32 * 196;
    const int nunits = NH * (S / 64);
    for (int ui = blockIdx.x; ui < nunits; ui += gridDim.x) {
        const int h = ui & 15, qb = (S / 64 - 1) - (ui >> 4);
        const int t = qb * 64 + rloc;
        float q[24];
        { const u32x4 a = *(const u32x4*)(qn + (size_t)t * DM + h * 128 + sub * 16), b = *(const u32x4*)(qn + (size_t)t * DM + h * 128 + sub * 16 + 8);
          const u32x4 c = *(const u32x4*)(qp + (size_t)t * 1024 + h * 64 + sub * 8);
          q[0] = bflo(a.x); q[1] = bfhi(a.x); q[2] = bflo(a.y); q[3] = bfhi(a.y); q[4] = bflo(a.z); q[5] = bfhi(a.z); q[6] = bflo(a.w); q[7] = bfhi(a.w);
          q[8] = bflo(b.x); q[9] = bfhi(b.x); q[10] = bflo(b.y); q[11] = bfhi(b.y); q[12] = bflo(b.z); q[13] = bfhi(b.z); q[14] = bflo(b.w); q[15] = bfhi(b.w);
          q[16] = bflo(c.x); q[17] = bfhi(c.x); q[18] = bflo(c.y); q[19] = bfhi(c.y); q[20] = bflo(c.z); q[21] = bfhi(c.z); q[22] = bflo(c.w); q[23] = bfhi(c.w); }
        float o[16];
#pragma unroll
        for (int i = 0; i < 16; ++i) o[i] = 0.f;
        float mrun = -1e30f, l = 0.f;
        const int ntiles = 2 * qb + 2;
        for (int kt = 0; kt < ntiles; ++kt) {
            __syncthreads();
            {
                const int key = tid >> 4, c8 = (tid & 15) * 8; const size_t tk = (size_t)(kt * 32 + key);
                const u32x4 a = *(const u32x4*)(kn + tk * DM + h * 128 + c8), b = *(const u32x4*)(vv + tk * DM + h * 128 + c8);
                float* kd = Ks + key * 196 + c8; float* vd = Vs + key * 132 + c8;
                *(f32x4*)kd = (f32x4){bflo(a.x), bfhi(a.x), bflo(a.y), bfhi(a.y)}; *(f32x4*)(kd + 4) = (f32x4){bflo(a.z), bfhi(a.z), bflo(a.w), bfhi(a.w)};
                *(f32x4*)vd = (f32x4){bflo(b.x), bfhi(b.x), bflo(b.y), bfhi(b.y)}; *(f32x4*)(vd + 4) = (f32x4){bflo(b.z), bfhi(b.z), bflo(b.w), bfhi(b.w)};
                if (tid < 256) { const int key2 = tid >> 3, d8 = (tid & 7) * 8; const u32x4 c = *(const u32x4*)(kpe + (size_t)(kt * 32 + key2) * 64 + d8);
                    float* pd = Ks + key2 * 196 + 128 + d8;
                    *(f32x4*)pd = (f32x4){bflo(c.x), bfhi(c.x), bflo(c.y), bfhi(c.y)}; *(f32x4*)(pd + 4) = (f32x4){bflo(c.z), bfhi(c.z), bflo(c.w), bfhi(c.w)}; }
            }
            __syncthreads();
#pragma unroll 1
            for (int j0 = 0; j0 < 32; j0 += 8) {
                float sc[8]; float tmax = -1e30f;
#pragma unroll
                for (int jj = 0; jj < 8; ++jj) {
                    const float* kr = Ks + (j0 + jj) * 196;
                    float p = 0.f;
#pragma unroll
                    for (int d4 = 0; d4 < 4; ++d4) { const f32x4 kv = *(const f32x4*)(kr + sub * 16 + d4 * 4); p += (q[d4 * 4] * kv[0] + q[d4 * 4 + 1] * kv[1]) + (q[d4 * 4 + 2] * kv[2] + q[d4 * 4 + 3] * kv[3]); }
#pragma unroll
                    for (int d4 = 0; d4 < 2; ++d4) { const f32x4 kv = *(const f32x4*)(kr + 128 + sub * 8 + d4 * 4); p += (q[16 + d4 * 4] * kv[0] + q[17 + d4 * 4] * kv[1]) + (q[18 + d4 * 4] * kv[2] + q[19 + d4 * 4] * kv[3]); }
                    p += __shfl_xor(p, 1); p += __shfl_xor(p, 2); p += __shfl_xor(p, 4);
                    if (kt * 32 + j0 + jj > t) p = -__builtin_inff();
                    sc[jj] = p; tmax = fmaxf(tmax, p);
                }
                const float mn = fmaxf(mrun, tmax), alpha = exp2f(mrun - mn); mrun = mn;
                l *= alpha;
#pragma unroll
                for (int i = 0; i < 16; ++i) o[i] *= alpha;
#pragma unroll
                for (int jj = 0; jj < 8; ++jj) {
                    const float p = exp2f(sc[jj] - mn); l += p;
                    const float* vr = Vs + (j0 + jj) * 132 + sub * 16;
#pragma unroll
                    for (int d4 = 0; d4 < 4; ++d4) { const f32x4 v4 = *(const f32x4*)(vr + d4 * 4); o[d4 * 4] += p * v4[0]; o[d4 * 4 + 1] += p * v4[1]; o[d4 * 4 + 2] += p * v4[2]; o[d4 * 4 + 3] += p * v4[3]; }
                }
            }
        }
        const float il = 1.f / l;
        u32x4 w0, w1;
        w0.x = pk2(o[0] * il, o[1] * il); w0.y = pk2(o[2] * il, o[3] * il); w0.z = pk2(o[4] * il, o[5] * il); w0.w = pk2(o[6] * il, o[7] * il);
        w1.x = pk2(o[8] * il, o[9] * il); w1.y = pk2(o[10] * il, o[11] * il); w1.z = pk2(o[12] * il, o[13] * il); w1.w = pk2(o[14] * il, o[15] * il);
        *(u32x4*)(o_out + (size_t)t * DM + h * 128 + sub * 16) = w0; *(u32x4*)(o_out + (size_t)t * DM + h * 128 + sub * 16 + 8) = w1;
    }
}


typedef short s16x4 __attribute__((ext_vector_type(4)));
typedef float f32x16 __attribute__((ext_vector_type(16)));
constexpr int AT_SHM_V = 64 * 128 * 2, AT_SHM_K = 64 * 128 * 2, AT_SHM_P = 64 * 64 * 2;
constexpr int AT_V = 0, AT_K = 2 * AT_SHM_V, AT_P = AT_K + 2 * AT_SHM_K, AT_WS = AT_P + 2 * AT_SHM_P, AT_LDS = AT_WS + 8 * 64 * 4;
#define KSWZ(row, colB) ((row) * 256 + ((colB) ^ (((row) & 7) << 4)))
#define PSWZ(row, ch) ((row) * 128 + ((((ch) ^ (((row) >> 1) & 7))) << 4))
#define SBAR() __builtin_amdgcn_sched_barrier(0)
DEV int v_st(int k, int c) { const int kk = (k & ~0xC) | ((k & 4) << 1) | ((k & 8) >> 1); return ((kk >> 3) * 4 + (c >> 5)) * 512 + ((kk & 7) * 32 + (c & 31)) * 2; }
DEV int v_rd_base(int lane) { return ((lane & 3) << 3) | (((lane >> 2) & 3) << 6) | (((lane >> 4) & 1) << 5) | (((lane >> 5) & 1) << 8); }
constexpr int v_rd_off(int d0, int ks, int half) { return d0 * 512 + ks * 4096 + half * 2048; }
DEV int crow(int r, int hi) { return (r & 3) + 8 * (r >> 2) + 4 * hi; }
DEV unsigned cvtpk(float lo, float hi) { unsigned r; asm volatile("v_cvt_pk_bf16_f32 %0, %1, %2" : "=v"(r) : "v"(lo), "v"(hi)); return r; }
DEV void at_mask(f32x16& p0, f32x16& p1, int dq) {
    const float NEG = -__builtin_inff();
#pragma unroll
    for (int r = 0; r < 16; ++r) { const int c = (r & 3) + 8 * (r >> 2); if (dq - c < 0) p0[r] = NEG; if (dq - c - 32 < 0) p1[r] = NEG; }
}
constexpr float AT_THR = 11.5f;
DEV void at_partialSM(f32x16& p0, f32x16& p1, float& m_reg, float& alpha) {
    float pmax = p0[0];
#pragma unroll
    for (int r = 1; r < 16; ++r) pmax = fmaxf(pmax, p0[r]);
#pragma unroll
    for (int r = 0; r < 16; ++r) pmax = fmaxf(pmax, p1[r]);
    { auto rr = __builtin_amdgcn_permlane32_swap(__float_as_uint(pmax), __float_as_uint(pmax), false, false); pmax = fmaxf(__uint_as_float(rr[0]), __uint_as_float(rr[1])); }
    float mn;
    if (__builtin_expect(__all((pmax - m_reg) <= AT_THR), 1)) { mn = m_reg; alpha = 1.f; }
    else { mn = fmaxf(m_reg, pmax); alpha = __builtin_amdgcn_exp2f(m_reg - mn); m_reg = mn; }
#pragma unroll
    for (int r = 0; r < 16; ++r) { p0[r] = __builtin_amdgcn_exp2f(p0[r] - mn); p1[r] = __builtin_amdgcn_exp2f(p1[r] - mn); }
}
DEV void at_finishSM(const f32x16& p0, const f32x16& p1, float alpha, float& l_reg, bf16x8& pa0, bf16x8& pa1, bf16x8& pa2, bf16x8& pa3) {
    float ps = 0;
#pragma unroll
    for (int r = 0; r < 16; ++r) ps += p0[r];
#pragma unroll
    for (int r = 0; r < 16; ++r) ps += p1[r];
    { auto rr = __builtin_amdgcn_permlane32_swap(__float_as_uint(ps), __float_as_uint(ps), false, false); ps = __uint_as_float(rr[0]) + __uint_as_float(rr[1]); }
    l_reg = l_reg * alpha + ps;
#define PK4(P, B_, OUT) do { unsigned a0 = cvtpk(P[B_+0], P[B_+1]), a1 = cvtpk(P[B_+2], P[B_+3]); unsigned b0 = cvtpk(P[B_+4], P[B_+5]), b1 = cvtpk(P[B_+6], P[B_+7]); \
        auto r0 = __builtin_amdgcn_permlane32_swap(a0, b0, false, false); auto r1 = __builtin_amdgcn_permlane32_swap(a1, b1, false, false); \
        u32x4 w = {r0[0], r1[0], r0[1], r1[1]}; OUT = *reinterpret_cast<bf16x8*>(&w); } while (0)
    PK4(p0, 0, pa0); PK4(p0, 8, pa1); PK4(p1, 0, pa2); PK4(p1, 8, pa3);
#undef PK4
}
template <int KB>
DEV void at_qkt(f32x16& p0, f32x16& p1, const char* lds, int r32, int hi, const bf16x8* qr) {
    p0 = f32x16{}; p1 = f32x16{};
#pragma unroll
    for (int g = 0; g < 2; ++g) {
        bf16x8 b0[4], b1[4];
#pragma unroll
        for (int dd = 0; dd < 4; ++dd) { const char* a = lds + AT_K + KB * AT_SHM_K + KSWZ(r32, (dd * 16 + hi * 8) * 2) + g * 128;
            b0[dd] = *reinterpret_cast<const bf16x8*>(a); b1[dd] = *reinterpret_cast<const bf16x8*>(a + 32 * 256); }
#pragma unroll
        for (int dd = 0; dd < 4; ++dd) { p0 = __builtin_amdgcn_mfma_f32_32x32x16_bf16(b0[dd], qr[g * 4 + dd], p0, 0, 0, 0); p1 = __builtin_amdgcn_mfma_f32_32x32x16_bf16(b1[dd], qr[g * 4 + dd], p1, 0, 0, 0); }
        SBAR();
    }
    {
        bf16x8 b0[4], b1[4];
#pragma unroll
        for (int d0 = 0; d0 < 4; ++d0) { const char* a = lds + AT_P + KB * AT_SHM_P + PSWZ(r32, 2 * d0 + hi);
            b0[d0] = *reinterpret_cast<const bf16x8*>(a); b1[d0] = *reinterpret_cast<const bf16x8*>(a + 32 * 128); }
#pragma unroll
        for (int d0 = 0; d0 < 4; ++d0) { p0 = __builtin_amdgcn_mfma_f32_32x32x16_bf16(b0[d0], qr[8 + d0], p0, 0, 0, 0); p1 = __builtin_amdgcn_mfma_f32_32x32x16_bf16(b1[d0], qr[8 + d0], p1, 0, 0, 0); }
        SBAR();
    }
}
template <int VB>
DEV void at_pv(f32x16* o, int vb0, bf16x8 pa0, bf16x8 pa1, bf16x8 pa2, bf16x8 pa3) {
#define TRRD(dst, off) asm volatile("ds_read_b64_tr_b16 %0, %1 offset:%2" : "=&v"(dst) : "v"(vb0), "i"(off) : "memory")
#define PV_D0(d0) do { s16x4 l0, l1, l2, l3, h0, h1, h2, h3; constexpr int b_ = AT_V + VB * AT_SHM_V + v_rd_off(d0, 0, 0); \
        TRRD(l0, b_); TRRD(h0, b_ + 2048); TRRD(l1, b_ + 4096); TRRD(h1, b_ + 6144); TRRD(l2, b_ + 8192); TRRD(h2, b_ + 10240); TRRD(l3, b_ + 12288); TRRD(h3, b_ + 14336); \
        asm volatile("s_waitcnt lgkmcnt(0)" ::: "memory"); SBAR(); \
        o[d0] = __builtin_amdgcn_mfma_f32_32x32x16_bf16(pa0, (bf16x8){l0[0], l0[1], l0[2], l0[3], h0[0], h0[1], h0[2], h0[3]}, o[d0], 0, 0, 0); \
        o[d0] = __builtin_amdgcn_mfma_f32_32x32x16_bf16(pa1, (bf16x8){l1[0], l1[1], l1[2], l1[3], h1[0], h1[1], h1[2], h1[3]}, o[d0], 0, 0, 0); \
        o[d0] = __builtin_amdgcn_mfma_f32_32x32x16_bf16(pa2, (bf16x8){l2[0], l2[1], l2[2], l2[3], h2[0], h2[1], h2[2], h2[3]}, o[d0], 0, 0, 0); \
        o[d0] = __builtin_amdgcn_mfma_f32_32x32x16_bf16(pa3, (bf16x8){l3[0], l3[1], l3[2], l3[3], h3[0], h3[1], h3[2], h3[3]}, o[d0], 0, 0, 0); } while (0)
    PV_D0(0); PV_D0(1); PV_D0(2); PV_D0(3);
#undef PV_D0
#undef TRRD
}
DEV void attn_unit(char* lds, int h, int qb, const bf16_t* qn, const bf16_t* qp, const bf16_t* kn, const bf16_t* kpe, const bf16_t* vv, bf16_t* o_out) {
    const int tid = threadIdx.x, wid = __builtin_amdgcn_readfirstlane(tid >> 6), lane = tid & 63, r32 = lane & 31, hi = lane >> 5;
    const int q0 = qb * 256, qlo = q0 + wid * 32, NT = 4 * (qb + 1);
    float* ws = (float*)(lds + AT_WS) + wid * 64; float* li_l = ws; float* al_l = ws + 32;
    unsigned kof[2], vof[2], pof;
#pragma unroll
    for (int i = 0; i < 2; ++i) { const int off = (wid * 2 + i) * 1024 + lane * 16;
        { const int row = off >> 8, colB = (off & 255) ^ ((row & 7) << 4); kof[i] = (unsigned)(row * DM + h * 128 + (colB >> 1)); }
        { const int sub = off >> 9, within = off & 511, kk = (sub >> 2) * 8 + (within >> 6), c = (sub & 3) * 32 + ((within & 63) >> 1);
          const int k = (kk & ~0xC) | ((kk & 4) << 1) | ((kk & 8) >> 1); vof[i] = (unsigned)(k * DM + h * 128 + c); } }
    { const int off = wid * 1024 + lane * 16, row = off >> 7, ch = ((off >> 4) & 7) ^ ((row >> 1) & 7); pof = (unsigned)(row * 64 + ch * 8); }
    const int vb0 = (int)(uintptr_t)lds + v_rd_base(lane);
    LAS unsigned char* l3 = (LAS unsigned char*)(uintptr_t)lds;
#define AT_GLDS(gp, lo) __builtin_amdgcn_global_load_lds((const unsigned*)(gp), (LAS unsigned*)(l3 + (lo)), 16, 0, 0)
#define AT_STAGE(t, B) do { const bf16_t* kt_ = kn + (size_t)(t) * 64 * DM; const bf16_t* vt_ = vv + (size_t)(t) * 64 * DM; const bf16_t* pt_ = kpe + (size_t)(t) * 64 * 64; \
        AT_GLDS(kt_ + kof[0], AT_K + (B) * AT_SHM_K + (wid * 2 + 0) * 1024); AT_GLDS(kt_ + kof[1], AT_K + (B) * AT_SHM_K + (wid * 2 + 1) * 1024); \
        AT_GLDS(vt_ + vof[0], AT_V + (B) * AT_SHM_V + (wid * 2 + 0) * 1024); AT_GLDS(vt_ + vof[1], AT_V + (B) * AT_SHM_V + (wid * 2 + 1) * 1024); \
        AT_GLDS(pt_ + pof, AT_P + (B) * AT_SHM_P + wid * 1024); } while (0)
    AT_STAGE(0, 0);
    bf16x8 qr[12];
    { const bf16_t* qrow = qn + (size_t)(qlo + r32) * DM + h * 128 + hi * 8; const bf16_t* prow = qp + (size_t)(qlo + r32) * 1024 + h * 64 + hi * 8;
#pragma unroll
      for (int d0 = 0; d0 < 8; ++d0) qr[d0] = *(const bf16x8*)(qrow + d0 * 16);
#pragma unroll
      for (int d0 = 0; d0 < 4; ++d0) qr[8 + d0] = *(const bf16x8*)(prow + d0 * 16); }
    asm volatile("s_waitcnt vmcnt(0)" ::: "memory");
    __syncthreads();
    float m_reg = -1e30f, l_reg = 0.f; f32x16 o[4] = {};
    const int qm = qlo + r32 - 4 * hi;
#define AT_STEP(t, B) do { \
        if ((t) + 1 < NT) AT_STAGE((t) + 1, (B) ^ 1); \
        f32x16 p0, p1; at_qkt<B>(p0, p1, lds, r32, hi, qr); \
        if ((t) * 64 + 63 > qlo) at_mask(p0, p1, qm - (t) * 64); \
        SBAR(); float alpha; at_partialSM(p0, p1, m_reg, alpha); SBAR(); \
        if (__any(alpha < 1.f)) { if (hi == 0) al_l[r32] = alpha; asm volatile("s_waitcnt lgkmcnt(0)" ::: "memory"); \
            _Pragma("unroll") for (int r = 0; r < 16; ++r) { const float a_ = al_l[crow(r, hi)]; o[0][r] *= a_; o[1][r] *= a_; o[2][r] *= a_; o[3][r] *= a_; if ((r & 3) == 3) SBAR(); } } \
        SBAR(); bf16x8 pa0, pa1, pa2, pa3; at_finishSM(p0, p1, alpha, l_reg, pa0, pa1, pa2, pa3); SBAR(); \
        at_pv<B>(o, vb0, pa0, pa1, pa2, pa3); \
        asm volatile("s_waitcnt vmcnt(0)" ::: "memory"); \
        __syncthreads(); } while (0)
    for (int t = 0; t < NT; t += 2) { AT_STEP(t, 0); AT_STEP(t + 1, 1); }
    if (hi == 0) li_l[r32] = l_reg; asm volatile("s_waitcnt lgkmcnt(0)" ::: "memory");
    float rli[16];
#pragma unroll
    for (int r = 0; r < 16; ++r) rli[r] = __builtin_amdgcn_rcpf(li_l[crow(r, hi)]);
    unsigned char* Ow = (unsigned char*)o_out + (size_t)qlo * DM + h * 128;
#pragma unroll
    for (int r = 0; r < 16; ++r) { const int orow = crow(r, hi);
#pragma unroll
        for (int d0 = 0; d0 < 4; ++d0) { const float v = o[d0][r] * rli[r] * O_SCALE; const float vn = __shfl_xor(v, 1);
            const unsigned w16 = __builtin_amdgcn_cvt_pk_fp8_f32(v, vn, 0u, false) & 0xffffu; const unsigned w16n = (unsigned)__shfl_xor((int)w16, 2);
            if ((r32 & 3) == 0) *(unsigned*)(Ow + (size_t)orow * DM + d0 * 32 + r32) = w16 | (w16n << 16); } }
    __syncthreads();
#undef AT_GLDS
#undef AT_STAGE
#undef AT_STEP
}
DEV void attn_mfma(char* lds, const bf16_t* qn, const bf16_t* qp, const bf16_t* kn, const bf16_t* kpe, const bf16_t* vv, bf16_t* o_out) {
    for (int it = blockIdx.x; it < 256; it += gridDim.x) {
        const int vid = (gridDim.x == 256) ? ((it & 7) * 32 + (it >> 3)) : it;
        const int h = vid >> 4, j = vid & 15;
        attn_unit(lds, h, 31 - j, qn, qp, kn, kpe, vv, o_out);
        attn_unit(lds, h, j, qn, qp, kn, kpe, vv, o_out);
    }
}

DEV void wave_argmax(float& v, int& idx) {
#pragma unroll
    for (int o = 1; o < 64; o <<= 1) { const float ov = __shfl_xor(v, o); const int oi = __shfl_xor(idx, o);
        if (ov > v || (ov == v && oi < idx)) { v = ov; idx = oi; } }
}
DEV void peer_phase(float* lds, const float* sc, const float* h1, const bf16_t* h1b, const u64* ssq1, const bf16_t* tu, const bf16_t* tv, float* h2, bf16_t* xn3) {
    const int tid = threadIdx.x, lane = tid & 63, wid = tid >> 6;
    int* ex = (int*)(lds + wid * 256);
    float* gt = lds + wid * 256 + 128;
    const float NEG = -__builtin_inff();
    for (int t = blockIdx.x * 8 + wid; t < S; t += gridDim.x * 8) {
        for (int h = 0; h < PH; ++h) {
            const float* sp = sc + (size_t)t * DM + h * 256;
            float tvv[2]; int tii[2];
#pragma unroll
            for (int c = 0; c < 2; ++c) {
                float a = sp[c * 128 + lane], b = sp[c * 128 + 64 + lane];
                float keepv = NEG; int keepi = 0;
                for (int r = 0; r < TOPK; ++r) {
                    float v; int idx; if (b > a) { v = b; idx = lane + 64; } else { v = a; idx = lane; }
                    wave_argmax(v, idx);
                    if (idx == lane) a = NEG; if (idx == lane + 64) b = NEG;
                    if (lane == r) { keepv = v; keepi = idx; }
                }
                tvv[c] = keepv; tii[c] = keepi;
            }
            const float a1 = __shfl(tvv[0], lane >> 2);
            float cv[4];
#pragma unroll
            for (int j = 0; j < 4; ++j) cv[j] = a1 + __shfl(tvv[1], (lane & 3) * 4 + j);
            float bs = NEG; int bc = 0;
            for (int r = 0; r < TOPK; ++r) {
                float v = cv[0]; int idx = lane * 4;
#pragma unroll
                for (int j = 1; j < 4; ++j) if (cv[j] > v) { v = cv[j]; idx = lane * 4 + j; }
                wave_argmax(v, idx);
                if ((idx >> 2) == lane) {
#pragma unroll
                    for (int j = 0; j < 4; ++j) if ((idx & 3) == j) cv[j] = NEG;
                }
                if (lane == r) { bs = v; bc = idx; }
            }
            const int i1 = __shfl(tii[0], bc >> 4), i2 = __shfl(tii[1], bc & 15);
            const float mx = __shfl(bs, 0);
            float e = (lane < 16) ? __expf(bs - mx) : 0.f;
            float sum = e;
#pragma unroll
            for (int o = 1; o < 16; o <<= 1) sum += __shfl_xor(sum, o);
            if (lane < 16) { ex[h * 16 + lane] = i1 * NK + i2; gt[h * 16 + lane] = e / sum; }
        }
        asm volatile("s_waitcnt lgkmcnt(0)" ::: "memory");
        const float rs1 = rsqrtf(ssq_get(ssq1, t) * (1.f / DM) + EPS);
        float hv[32];
#pragma unroll
        for (int j = 0; j < 4; ++j) { const u32x4 w = *(const u32x4*)(h1b + (size_t)t * DM + j * 512 + lane * 8);
            hv[j * 8 + 0] = bflo(w.x); hv[j * 8 + 1] = bfhi(w.x); hv[j * 8 + 2] = bflo(w.y); hv[j * 8 + 3] = bfhi(w.y);
            hv[j * 8 + 4] = bflo(w.z); hv[j * 8 + 5] = bfhi(w.z); hv[j * 8 + 6] = bflo(w.w); hv[j * 8 + 7] = bfhi(w.w); }
        float ac[32];
#pragma unroll
        for (int i = 0; i < 32; ++i) ac[i] = 0.f;
        for (int k = 0; k < PH * TOPK * DBG_PEER; ++k) {
            const int e = ex[k]; const float g = gt[k];
            const bf16_t* ur = tu + (size_t)e * DM + lane * 8; const bf16_t* vr = tv + (size_t)e * DM + lane * 8;
            u32x4 uw[4], vw[4];
#pragma unroll
            for (int j = 0; j < 4; ++j) { uw[j] = *(const u32x4*)(ur + j * 512); vw[j] = *(const u32x4*)(vr + j * 512); }
            float d = 0.f;
#pragma unroll
            for (int j = 0; j < 4; ++j) { d += hv[j * 8 + 0] * bflo(uw[j].x) + hv[j * 8 + 1] * bfhi(uw[j].x) + hv[j * 8 + 2] * bflo(uw[j].y) + hv[j * 8 + 3] * bfhi(uw[j].y)
                                             + hv[j * 8 + 4] * bflo(uw[j].z) + hv[j * 8 + 5] * bfhi(uw[j].z) + hv[j * 8 + 6] * bflo(uw[j].w) + hv[j * 8 + 7] * bfhi(uw[j].w); }
            d = wave_sum(d);
            const float w = g * gelu_tanh(d * rs1);
#pragma unroll
            for (int j = 0; j < 4; ++j) { ac[j * 8 + 0] += w * bflo(vw[j].x); ac[j * 8 + 1] += w * bfhi(vw[j].x); ac[j * 8 + 2] += w * bflo(vw[j].y); ac[j * 8 + 3] += w * bfhi(vw[j].y);
                                          ac[j * 8 + 4] += w * bflo(vw[j].z); ac[j * 8 + 5] += w * bfhi(vw[j].z); ac[j * 8 + 6] += w * bflo(vw[j].w); ac[j * 8 + 7] += w * bfhi(vw[j].w); }
        }
        float ss = 0.f;
#pragma unroll
        for (int j = 0; j < 4; ++j) { const size_t o = (size_t)t * DM + j * 512 + lane * 8;
            const f32x4 x0 = *(const f32x4*)(h1 + o), x1 = *(const f32x4*)(h1 + o + 4);
#pragma unroll
            for (int i = 0; i < 4; ++i) { ac[j * 8 + i] += x0[i]; ac[j * 8 + 4 + i] += x1[i]; }
#pragma unroll
            for (int i = 0; i < 8; ++i) ss += ac[j * 8 + i] * ac[j * 8 + i]; }
        ss = wave_sum(ss);
        const float rs2 = rsqrtf(ss * (1.f / DM) + EPS);
#pragma unroll
        for (int j = 0; j < 4; ++j) { const size_t o = (size_t)t * DM + j * 512 + lane * 8;
            *(f32x4*)(h2 + o) = (f32x4){ac[j * 8], ac[j * 8 + 1], ac[j * 8 + 2], ac[j * 8 + 3]}; *(f32x4*)(h2 + o + 4) = (f32x4){ac[j * 8 + 4], ac[j * 8 + 5], ac[j * 8 + 6], ac[j * 8 + 7]};
            u32x4 w; w.x = pk2(ac[j * 8] * rs2, ac[j * 8 + 1] * rs2); w.y = pk2(ac[j * 8 + 2] * rs2, ac[j * 8 + 3] * rs2); w.z = pk2(ac[j * 8 + 4] * rs2, ac[j * 8 + 5] * rs2); w.w = pk2(ac[j * 8 + 6] * rs2, ac[j * 8 + 7] * rs2);
            *(u32x4*)(xn3 + o) = w; }
    }
}


#define BUBBLE16(v, x) _Pragma("unroll") for (int j_ = 0; j_ < 16; ++j_) { const float hi_ = fmaxf(v[j_], x); x = fminf(v[j_], x); v[j_] = hi_; }
constexpr int PL_KEYS = 0, PL_WL = 0, PL_WTS = 16384, PL_SX = 32768, PL_SG = 49152, PL_TOT = 65536, PL_MB = 65536, PL_OFF = 67584, PL_H8 = 69888, PL_EX = 69888, PL_GT = 86272, PL_CNT = 102656, H8_STRIDE = 2112;
DEV f32x2 fp8x2(unsigned w, bool hi) { return hi ? __builtin_amdgcn_cvt_pk_f32_fp8(w, true) : __builtin_amdgcn_cvt_pk_f32_fp8(w, false); }
DEV float dot16_fp8(const float* h, u32x4 r) {
    float d = 0.f;
#pragma unroll
    for (int q = 0; q < 4; ++q) { const f32x2 lo = __builtin_amdgcn_cvt_pk_f32_fp8(r[q], false), hi2 = __builtin_amdgcn_cvt_pk_f32_fp8(r[q], true);
        d = fmaf(h[q * 4 + 0], lo.x, d); d = fmaf(h[q * 4 + 1], lo.y, d); d = fmaf(h[q * 4 + 2], hi2.x, d); d = fmaf(h[q * 4 + 3], hi2.y, d); }
    return d;
}
DEV void axpy16_fp8(float* acc, float w, u32x4 r) {
#pragma unroll
    for (int q = 0; q < 4; ++q) { const f32x2 lo = __builtin_amdgcn_cvt_pk_f32_fp8(r[q], false), hi2 = __builtin_amdgcn_cvt_pk_f32_fp8(r[q], true);
        acc[q * 4 + 0] = fmaf(w, lo.x, acc[q * 4 + 0]); acc[q * 4 + 1] = fmaf(w, lo.y, acc[q * 4 + 1]); acc[q * 4 + 2] = fmaf(w, hi2.x, acc[q * 4 + 2]); acc[q * 4 + 3] = fmaf(w, hi2.y, acc[q * 4 + 3]); }
}
#define PE_FENCE0 do { asm volatile("" ::: "memory"); __builtin_amdgcn_sched_barrier(0); } while (0)
#ifdef STAMP_SEL
#define PSTAMP(k) do { if (blockIdx.x == STAMP_BLK && threadIdx.x == 0) { ((unsigned long long*)stampp)[32 + (k)] = __builtin_amdgcn_s_memrealtime(); } } while (0)
#else
#define PSTAMP(k) do {} while (0)
#endif
DEV void peer_phase2(void* stampp, char* lds, const float* scT, const bf16_t* h1, const u64* ssq1, const unsigned char* tu8, const unsigned char* tv8, bf16_t* h2, bf16_t* xn3, float* ssq2) {
    const int tid = threadIdx.x, lane = tid & 63, wid = __builtin_amdgcn_readfirstlane(tid >> 6);
    unsigned* keys1 = (unsigned*)(lds + PL_KEYS); int* ex = (int*)(lds + PL_EX); float* gt = (float*)(lds + PL_GT); float* wts = (float*)(lds + PL_WTS) + wid * 512; int* wl = (int*)(lds + PL_WL) + wid * 512; unsigned* wpk = (unsigned*)(lds + PL_EX) + wid * 512; int* mbase = (int*)(lds + PL_MB) + wid * 64;
    int* sx = (int*)(lds + PL_SX); float* sg = (float*)(lds + PL_SG); int* cnth = (int*)(lds + PL_CNT); int* tot = (int*)(lds + PL_TOT); int* offs = (int*)(lds + PL_OFF);
    const float NEGINF = -__builtin_inff();
    for (int grp = blockIdx.x; grp < S / 32; grp += gridDim.x) {
        __syncthreads();
        PSTAMP(0);
        {
            const int tl = tid & 31, hc = tid >> 5;
            const float* sp = scT + ((size_t)(grp * 16 + hc) * 128) * 32 + tl;
            float v[16];
#pragma unroll
            for (int j = 0; j < 16; ++j) v[j] = NEGINF;
#pragma unroll 1
            for (int n0 = 0; n0 < 128; n0 += 8) {
                float sv[8];
#pragma unroll
                for (int q = 0; q < 8; ++q) sv[q] = sp[(n0 + q) * 32];
#pragma unroll
                for (int q = 0; q < 8; ++q) { float x = __uint_as_float((__float_as_uint(sv[q]) & 0xFFFFFF80u) | (unsigned)(127 - (n0 + q))); BUBBLE16(v, x); }
            }
#pragma unroll
            for (int j = 0; j < 16; ++j) keys1[(tl * 16 + hc) * 16 + j] = __float_as_uint(v[j]);
        }
        __syncthreads();
        PSTAMP(1);
        if (tid < 256) {
            const int tl = tid & 31, h = tid >> 5;
            const unsigned* ka = keys1 + (tl * 16 + 2 * h) * 16; const unsigned* kb = ka + 16;
            float a[16], b[16];
#pragma unroll
            for (int j = 0; j < 16; ++j) { a[j] = __uint_as_float(ka[j] & 0xFFFFFF80u); b[j] = __uint_as_float(kb[j] & 0xFFFFFF80u); }
            float w[16];
#pragma unroll
            for (int j = 0; j < 16; ++j) w[j] = NEGINF;
            {
                int cid = 0;
#pragma unroll
                for (int i = 0; i < 16; ++i)
#pragma unroll
                    for (int j = 0; j < 16; ++j) if ((i + 1) * (j + 1) <= 16) { float x = __uint_as_float((__float_as_uint(a[i] + b[j]) & 0xFFFFFFC0u) | (unsigned)(63 - cid)); BUBBLE16(w, x); ++cid; }
            }
            const float mx = __uint_as_float(__float_as_uint(w[0]) & 0xFFFFFFC0u);
            float e[16], sum = 0.f;
#pragma unroll
            for (int k = 0; k < 16; ++k) { e[k] = __expf(__uint_as_float(__float_as_uint(w[k]) & 0xFFFFFFC0u) - mx); sum += e[k]; }
            const float inv = 1.f / sum;
#pragma unroll
            for (int k = 0; k < 16; ++k) {
                const int cid = 63 - (int)(__float_as_uint(w[k]) & 63u);
                int i, j;
                if (cid >= 42) { i = 8 + (cid - 42); j = 0; }
                else { i = (cid >= 16) + (cid >= 24) + (cid >= 29) + (cid >= 33) + (cid >= 36) + (cid >= 38) + (cid >= 40);
                       const int st = i == 0 ? 0 : i == 1 ? 16 : i == 2 ? 24 : i == 3 ? 29 : i == 4 ? 33 : i == 5 ? 36 : i == 6 ? 38 : 40; j = cid - st; }
                const int i1 = 127 - (int)(ka[i] & 127u), i2 = 127 - (int)(kb[j] & 127u);
                ex[tl * 128 + h * 16 + k] = i1 * NK + i2; gt[tl * 128 + h * 16 + k] = e[k] * inv;
            }
            int* crow_ = cnth + (tl * 8 + h) * 16;
#pragma unroll
            for (int r = 0; r < 16; ++r) crow_[r] = 0;
            for (int k = 0; k < 16; ++k) { const int r = ex[tl * 128 + h * 16 + k] >> 10; crow_[r] = crow_[r] + 1; }
        }
        __syncthreads();
        {
            const int tl = tid & 31, r = tid >> 5;
            int t_ = 0;
#pragma unroll
            for (int h = 0; h < 8; ++h) t_ += cnth[(tl * 8 + h) * 16 + r];
            tot[tl * 16 + r] = t_;
        }
        __syncthreads();
        {
            const int tl = tid & 31, r = tid >> 5;
            int b_ = 0;
            for (int r2 = 0; r2 < r; ++r2) b_ += tot[tl * 16 + r2];
            offs[tl * 17 + r] = b_; if (r == 15) offs[tl * 17 + 16] = 128;
#pragma unroll
            for (int h = 0; h < 8; ++h) { const int c_ = cnth[(tl * 8 + h) * 16 + r]; cnth[(tl * 8 + h) * 16 + r] = b_; b_ += c_; }
        }
        __syncthreads();
        if (tid < 256) {
            const int tl = tid & 31, h = tid >> 5; int* crow_ = cnth + (tl * 8 + h) * 16;
            for (int k = 0; k < 16; ++k) { const int e_ = ex[tl * 128 + h * 16 + k]; const int r = e_ >> 10; const int p_ = crow_[r]; crow_[r] = p_ + 1; sx[tl * 128 + p_] = e_; sg[tl * 128 + p_] = gt[tl * 128 + h * 16 + k]; }
        }
        __syncthreads();
#define PE_FENCE do { asm volatile("" ::: "memory"); __builtin_amdgcn_sched_barrier(0); } while (0)
#define PE_TIE16(A, o) asm volatile("" : "+v"(A[o + 0]), "+v"(A[o + 1]), "+v"(A[o + 2]), "+v"(A[o + 3]), "+v"(A[o + 4]), "+v"(A[o + 5]), "+v"(A[o + 6]), "+v"(A[o + 7]), "+v"(A[o + 8]), "+v"(A[o + 9]), \
            "+v"(A[o + 10]), "+v"(A[o + 11]), "+v"(A[o + 12]), "+v"(A[o + 13]), "+v"(A[o + 14]), "+v"(A[o + 15]))
        PSTAMP(2);
#define PE_FENCE do { asm volatile("" ::: "memory"); __builtin_amdgcn_sched_barrier(0); } while (0)
        {
            const int tl0 = wid * 4, t0 = grp * 32 + tl0;
            {
                const int q = lane >> 4, r = lane & 15; int b_ = 0;
#pragma unroll
                for (int q2 = 0; q2 < 4; ++q2) { const int o0 = offs[(tl0 + q2) * 17 + r], o1 = offs[(tl0 + q2) * 17 + r + 1]; b_ += o0; if (q2 < q) b_ += o1 - o0; }
                mbase[lane] = b_;
            }
            asm volatile("s_waitcnt lgkmcnt(0)" ::: "memory");
#pragma unroll
            for (int q = 0; q < 4; ++q)
#pragma unroll
                for (int kk = 0; kk < 2; ++kk) { const int k = lane + 64 * kk; const int e_ = sx[(tl0 + q) * 128 + k]; const int r = e_ >> 10;
                    wl[(k - offs[(tl0 + q) * 17 + r]) + mbase[q * 16 + r]] = e_ | (k << 16) | (q << 23); }
            asm volatile("s_waitcnt lgkmcnt(0)" ::: "memory");
            float rsq[4];
#pragma unroll
            for (int q = 0; q < 4; ++q) rsq[q] = rsqrtf(ssq_get(ssq1, t0 + q) * (1.f / DM) + EPS) * (1.f / (TU_SCALE * H_SCALE));
            {
                int hq[4][8];
#pragma unroll
                for (int q = 0; q < 4; ++q)
#pragma unroll
                    for (int c = 0; c < 8; ++c) hq[q][c] = (int)q8pack(unpk4(*(const u32x2*)(h1 + (size_t)(t0 + q) * DM + (c >> 2) * 1024 + lane * 16 + (c & 3) * 4)) * H_SCALE);
                u32x4 rr[16][2]; int ent[16];
#define PE_LOAD1(j, i) do { ent[j] = __builtin_amdgcn_readfirstlane(wl[(i)]); const unsigned char* p_ = tu8 + (size_t)(ent[j] & 0x3FFF) * DM + lane * 16; \
                    rr[j][0] = *(const u32x4*)p_; rr[j][1] = *(const u32x4*)(p_ + 1024); } while (0)
#define PE_DOT(j, dj) do { int s_[4] = {0, 0, 0, 0}; _Pragma("unroll") for (int hf_ = 0; hf_ < 2; ++hf_) _Pragma("unroll") for (int w_ = 0; w_ < 4; ++w_) { const int x_ = (int)rr[j][hf_][w_]; \
                    s_[0] = __builtin_amdgcn_sdot4(x_, hq[0][hf_ * 4 + w_], s_[0], false); s_[1] = __builtin_amdgcn_sdot4(x_, hq[1][hf_ * 4 + w_], s_[1], false); \
                    s_[2] = __builtin_amdgcn_sdot4(x_, hq[2][hf_ * 4 + w_], s_[2], false); s_[3] = __builtin_amdgcn_sdot4(x_, hq[3][hf_ * 4 + w_], s_[3], false); } \
                    const int q_ = (ent[j] >> 23) & 3; d_[dj] = (float)(q_ == 0 ? s_[0] : q_ == 1 ? s_[1] : q_ == 2 ? s_[2] : s_[3]); } while (0)
#define PE_UREDUCE(i0) do { \
                    float r4_[4]; _Pragma("unroll") for (int i_ = 0; i_ < 4; ++i_) { const bool up_ = (lane & 32) != 0; const float keep_ = up_ ? d_[i_ + 4] : d_[i_], send_ = up_ ? d_[i_] : d_[i_ + 4]; r4_[i_] = keep_ + __shfl_xor(send_, 32); } \
                    float r2_[2]; _Pragma("unroll") for (int i_ = 0; i_ < 2; ++i_) { const bool up_ = (lane & 16) != 0; const float keep_ = up_ ? r4_[i_ + 2] : r4_[i_], send_ = up_ ? r4_[i_] : r4_[i_ + 2]; r2_[i_] = keep_ + __shfl_xor(send_, 16); } \
                    float r1_; { const bool up_ = (lane & 8) != 0; const float keep_ = up_ ? r2_[1] : r2_[0], send_ = up_ ? r2_[0] : r2_[1]; r1_ = keep_ + __shfl_xor(send_, 8); } \
                    r1_ += __shfl_xor(r1_, 4); r1_ += __shfl_xor(r1_, 2); r1_ += __shfl_xor(r1_, 1); \
                    const int en_ = wl[(i0) + (lane >> 3)]; const int q_ = (en_ >> 23) & 3, k_ = (en_ >> 16) & 127; \
                    const float rs_ = q_ == 0 ? rsq[0] : q_ == 1 ? rsq[1] : q_ == 2 ? rsq[2] : rsq[3]; \
                    const float wv_ = sg[(tl0 + q_) * 128 + k_] * gelu_tanh(r1_ * rs_); if ((lane & 7) == 0) wts[q_ * 128 + k_] = wv_; } while (0)
#pragma unroll
                for (int j = 0; j < 16; ++j) PE_LOAD1(j, j);
                PE_FENCE;
#pragma unroll 1
                for (int b = 0; b < 31; ++b) {
                    { float d_[8];
#pragma unroll
                      for (int j = 0; j < 8; ++j) { PE_DOT(j, j); PE_FENCE; PE_LOAD1(j, (b + 1) * 16 + j); PE_FENCE; }
                      PE_UREDUCE(b * 16); }
                    { float d_[8];
#pragma unroll
                      for (int j = 8; j < 16; ++j) { PE_DOT(j, j - 8); PE_FENCE; PE_LOAD1(j, (b + 1) * 16 + j); PE_FENCE; }
                      PE_UREDUCE(b * 16 + 8); }
                }
                { float d_[8];
#pragma unroll
                  for (int j = 0; j < 8; ++j) { PE_DOT(j, j); PE_FENCE; }
                  PE_UREDUCE(31 * 16); }
                { float d_[8];
#pragma unroll
                  for (int j = 8; j < 16; ++j) { PE_DOT(j, j - 8); PE_FENCE; }
                  PE_UREDUCE(31 * 16 + 8); }
#undef PE_LOAD1
#undef PE_DOT
#undef PE_UREDUCE
            }
            asm volatile("s_waitcnt lgkmcnt(0)" ::: "memory");
            PSTAMP(3);
            float swq[4];
            {
#pragma unroll
                for (int q = 0; q < 4; ++q) { float m_ = fmaxf(fabsf(wts[q * 128 + lane]), fabsf(wts[q * 128 + 64 + lane]));
#pragma unroll
                    for (int o = 1; o < 64; o <<= 1) m_ = fmaxf(m_, __shfl_xor(m_, o));
                    swq[q] = 127.f / fmaxf(m_, 1e-20f); }
#pragma unroll
                for (int gg = 0; gg < 2; ++gg) { const int gi = lane + 64 * gg; unsigned pk_[4] = {0u, 0u, 0u, 0u};
#pragma unroll
                    for (int j = 0; j < 4; ++j) { const int en_ = wl[gi * 4 + j]; const int q_ = (en_ >> 23) & 3, k_ = (en_ >> 16) & 127; const float w_ = wts[q_ * 128 + k_];
                        const float sw_ = q_ == 0 ? swq[0] : q_ == 1 ? swq[1] : q_ == 2 ? swq[2] : swq[3]; const unsigned qv_ = q8(w_ * sw_) << (8 * j);
                        pk_[0] |= q_ == 0 ? qv_ : 0u; pk_[1] |= q_ == 1 ? qv_ : 0u; pk_[2] |= q_ == 2 ? qv_ : 0u; pk_[3] |= q_ == 3 ? qv_ : 0u; }
                    wpk[gi] = pk_[0]; wpk[128 + gi] = pk_[1]; wpk[256 + gi] = pk_[2]; wpk[384 + gi] = pk_[3]; }
            }
            asm volatile("s_waitcnt lgkmcnt(0)" ::: "memory");
            float ssq[4] = {0.f, 0.f, 0.f, 0.f};
#pragma unroll 1
            for (int hf = 0; hf < 2; ++hf) {
                int ac[4][16];
#pragma unroll
                for (int q = 0; q < 4; ++q)
#pragma unroll
                    for (int i = 0; i < 16; ++i) ac[q][i] = 0;
                u32x4 rv[16];
#define PE_VLOAD(j, i) do { const int e_ = __builtin_amdgcn_readfirstlane(wl[(i)]) & 0x3FFF; rv[j] = *(const u32x4*)(tv8 + (size_t)e_ * DM + hf * 1024 + lane * 16); } while (0)
#define PE_TIEI(A) asm volatile("" : "+v"(A[0]), "+v"(A[1]), "+v"(A[2]), "+v"(A[3]), "+v"(A[4]), "+v"(A[5]), "+v"(A[6]), "+v"(A[7]), "+v"(A[8]), "+v"(A[9]), "+v"(A[10]), "+v"(A[11]), "+v"(A[12]), "+v"(A[13]), "+v"(A[14]), "+v"(A[15]))
#define PE_GROUP4(j0, gi) do { const int w0_ = (int)wpk[(gi)], w1_ = (int)wpk[128 + (gi)], w2_ = (int)wpk[256 + (gi)], w3_ = (int)wpk[384 + (gi)]; \
                    _Pragma("unroll") for (int w_ = 0; w_ < 4; ++w_) { \
                        const unsigned r0_ = rv[j0][w_], r1_ = rv[j0 + 1][w_], r2_ = rv[j0 + 2][w_], r3_ = rv[j0 + 3][w_]; \
                        const unsigned lo01_ = __builtin_amdgcn_perm(r1_, r0_, 0x05010400u), hi01_ = __builtin_amdgcn_perm(r1_, r0_, 0x07030602u); \
                        const unsigned lo23_ = __builtin_amdgcn_perm(r3_, r2_, 0x05010400u), hi23_ = __builtin_amdgcn_perm(r3_, r2_, 0x07030602u); \
                        const int t_[4] = {(int)__builtin_amdgcn_perm(lo23_, lo01_, 0x05040100u), (int)__builtin_amdgcn_perm(lo23_, lo01_, 0x07060302u), \
                                           (int)__builtin_amdgcn_perm(hi23_, hi01_, 0x05040100u), (int)__builtin_amdgcn_perm(hi23_, hi01_, 0x07060302u)}; \
                        _Pragma("unroll") for (int c_ = 0; c_ < 4; ++c_) { const int o_ = w_ * 4 + c_; \
                            ac[0][o_] = __builtin_amdgcn_sdot4(t_[c_], w0_, ac[0][o_], false); ac[1][o_] = __builtin_amdgcn_sdot4(t_[c_], w1_, ac[1][o_], false); \
                            ac[2][o_] = __builtin_amdgcn_sdot4(t_[c_], w2_, ac[2][o_], false); ac[3][o_] = __builtin_amdgcn_sdot4(t_[c_], w3_, ac[3][o_], false); } } \
                    PE_TIEI(ac[0]); PE_TIEI(ac[1]); PE_TIEI(ac[2]); PE_TIEI(ac[3]); } while (0)
#pragma unroll
                for (int j = 0; j < 16; ++j) PE_VLOAD(j, j);
                PE_FENCE;
#pragma unroll 1
                for (int b = 0; b < 31; ++b) {
#pragma unroll
                    for (int g4 = 0; g4 < 4; ++g4) { PE_GROUP4(g4 * 4, b * 4 + g4); PE_FENCE;
#pragma unroll
                        for (int j = g4 * 4; j < g4 * 4 + 4; ++j) PE_VLOAD(j, (b + 1) * 16 + j);
                        PE_FENCE; }
                }
#pragma unroll
                for (int g4 = 0; g4 < 4; ++g4) { PE_GROUP4(g4 * 4, 31 * 4 + g4); PE_FENCE; }
#undef PE_VLOAD
#undef PE_TIEI
#undef PE_GROUP4
#pragma unroll
                for (int q = 0; q < 4; ++q) { const size_t o = (size_t)(t0 + q) * DM + hf * 1024 + lane * 16; const float f_ = 1.f / (swq[q] * TV_SCALE);
#pragma unroll
                    for (int c2 = 0; c2 < 2; ++c2) { const u32x4 xr_ = *(const u32x4*)(h1 + o + c2 * 8); f32x4 y4[2]; unsigned w8_[2];
#pragma unroll
                        for (int e = 0; e < 2; ++e) { const int c = c2 * 2 + e; const f32x4 x4 = e == 0 ? unpk4lo(xr_) : unpk4hi(xr_);
                            y4[e][0] = (float)ac[q][c * 4] * f_ + x4[0]; y4[e][1] = (float)ac[q][c * 4 + 1] * f_ + x4[1]; y4[e][2] = (float)ac[q][c * 4 + 2] * f_ + x4[2]; y4[e][3] = (float)ac[q][c * 4 + 3] * f_ + x4[3];
                            ssq[q] += sumsq4(y4[e]); w8_[e] = f8pack(y4[e] * X_SCALE); }
                        *(u32x4*)(h2 + o + c2 * 8) = pk8(y4[0], y4[1]); *(u32x2*)((unsigned char*)xn3 + o + c2 * 8) = (u32x2){w8_[0], w8_[1]}; } }
            }
#pragma unroll
            for (int q = 0; q < 4; ++q) { const float s_ = wave_sum(ssq[q]); if (lane == 0) ssq2[t0 + q] = s_; }
            PSTAMP(5);
        }
#undef PE_FENCE
#undef PE_TIE16
    }
}

#define XB_TMO      128
#define XB_XCNT(j)  (256  + 64 * (j))
#define XB_XSUB(j)  (1280 + 64 * (j))
#define XB_XGEN(j)  (2304 + 64 * (j))
#define XB_TOP      3328
#define XB_TOPGEN   3392
#define XCD_BAR_WORDS 3456
#define XB_SPIN_CAP (1u << 18)

__device__ __forceinline__ unsigned xb_ld(unsigned* p)              { return __hip_atomic_load(p, __ATOMIC_RELAXED, __HIP_MEMORY_SCOPE_AGENT); }
__device__ __forceinline__ unsigned xb_add(unsigned* p, unsigned v) { return __hip_atomic_fetch_add(p, v, __ATOMIC_RELAXED, __HIP_MEMORY_SCOPE_AGENT); }
__device__ __forceinline__ unsigned xb_xcc_id() { return (unsigned)__builtin_amdgcn_s_getreg((3 << 11) | 20) & 0xFu; }
#define XB_SPIN(cond, bar) do { unsigned _sp = 0; while (cond) { __builtin_amdgcn_s_sleep(1); \
    if ((++_sp & 255u) == 0u) { if (xb_ld(&(bar)[XB_TMO])) break; if (_sp > XB_SPIN_CAP) { atomicAdd(&(bar)[XB_TMO], 1u); break; } } } } while (0)

struct XcdBarrier {
    unsigned* bar; unsigned x;
    volatile __attribute__((address_space(3))) unsigned* st;
};

__device__ __forceinline__ XcdBarrier xcd_barrier_post(unsigned* bar, volatile __attribute__((address_space(3))) unsigned* st) {
    XcdBarrier b; b.bar = bar; b.x = xb_xcc_id(); b.st = st;
    if (threadIdx.x == 0) (void)xb_add(&bar[XB_XCNT(b.x)], 1u);
    return b;
}
__device__ __forceinline__ void xcd_barrier_complete(unsigned* bar, unsigned x, unsigned& nloc, unsigned& nx) {
    const unsigned G = gridDim.x * gridDim.y * gridDim.z;
    unsigned sum, cnt, mine, sp = 0u;
    for (;;) {
        sum = 0u; cnt = 0u; mine = 0u;
#pragma unroll
        for (unsigned j = 0; j < 16; ++j) { const unsigned c = xb_ld(&bar[XB_XCNT(j)]); sum += c; cnt += (c > 0u) ? 1u : 0u; mine = (j == x) ? c : mine; }
        if (sum == G) break;
        __builtin_amdgcn_s_sleep(1);
        if ((++sp & 255u) == 0u) { if (xb_ld(&bar[XB_TMO])) break; if (sp > XB_SPIN_CAP) { atomicAdd(&bar[XB_TMO], 1u); break; } }
    }
    nloc = mine > 0u ? mine : 1u; nx = cnt > 0u ? cnt : 1u;
}

__device__ __forceinline__ void xcd_barrier(const XcdBarrier& b) {
    asm volatile("s_waitcnt vmcnt(0)" ::: "memory");
    __syncthreads();
    if (threadIdx.x == 0) {
        unsigned* bar = b.bar;
        __builtin_amdgcn_s_waitcnt(0);
        unsigned nloc = b.st[0], nx = b.st[1];
        if (nloc == 0u) { xcd_barrier_complete(bar, b.x, nloc, nx); b.st[0] = nloc; b.st[1] = nx; }
        const unsigned old = xb_add(&bar[XB_XSUB(b.x)], 1u);
        const unsigned gen = old / nloc;
        if (old + 1u == (gen + 1u) * nloc) {
            __builtin_amdgcn_fence(__ATOMIC_RELEASE, "agent");
            asm volatile("s_waitcnt vmcnt(0)" ::: "memory");
            const unsigned og = xb_add(&bar[XB_TOP], 1u);
            const unsigned tg = og / nx;
            if (og + 1u == (tg + 1u) * nx) xb_add(&bar[XB_TOPGEN], 1u);
            else XB_SPIN(xb_ld(&bar[XB_TOPGEN]) == tg, bar);
            __builtin_amdgcn_fence(__ATOMIC_ACQUIRE, "agent");
            xb_add(&bar[XB_XGEN(b.x)], 1u);
            asm volatile("s_waitcnt vmcnt(0)" ::: "memory");
        } else {
            XB_SPIN(xb_ld(&bar[XB_XGEN(b.x)]) == gen, bar);
            __builtin_amdgcn_fence(__ATOMIC_ACQUIRE, "agent");
            asm volatile("s_waitcnt vmcnt(0)" ::: "memory");
        }
    }
    __syncthreads();
}


__global__ void __launch_bounds__(NTHREADS, 2) fwd_kernel(Params P) {
    extern __shared__ __attribute__((aligned(16))) unsigned char lds_raw[];
    float* lds = (float*)lds_raw;
    cg::grid_group grid = cg::this_grid();
    const int G = gridDim.x, bx = blockIdx.x;
    const int gthreads = G * NTHREADS, gwaves = G * 8;
#define PHASE_IDS() int tid = threadIdx.x; asm volatile("" : "+v"(tid)); const int lane = tid & 63, wid = tid >> 6, gtid = bx * NTHREADS + tid, gwave = bx * 8 + wid; (void)lane; (void)wid; (void)gtid; (void)gwave
typedef const float* const __attribute__((address_space(4)))* KARG;
#define PH_PTRS() \
    KARG INP = (KARG)__builtin_amdgcn_kernarg_segment_ptr(); asm volatile("" : "+s"(INP)); \
    unsigned char* ws = (unsigned char*)INP[29]; float* outp = (float*)INP[28]; \
    float* small = (float*)(ws + WS_SMALL); \
    float* rope = (float*)(ws + WS_ROPE); \
    bf16_t* wt_in = (bf16_t*)(ws + WS_WIN); bf16_t* wt_uq = (bf16_t*)(ws + WS_WUQ); bf16_t* wt_ukv = (bf16_t*)(ws + WS_WUKV); \
    bf16_t* wt_ao = (bf16_t*)(ws + WS_WAO); bf16_t* wt_ro = (bf16_t*)(ws + WS_WRO); bf16_t* wt_out = (bf16_t*)(ws + WS_WOUT); \
    bf16_t* wt_pq = (bf16_t*)(ws + WS_WPQ); bf16_t* wt_pg = (bf16_t*)(ws + WS_WPG); bf16_t* wt_pp = (bf16_t*)(ws + WS_WPP); \
    bf16_t* wt_g = (bf16_t*)(ws + WS_WG); bf16_t* wt_sk = (bf16_t*)(ws + WS_WSK); bf16_t* pb = (bf16_t*)(ws + WS_PB); \
    bf16_t* tu = (bf16_t*)(ws + WS_TU); bf16_t* tvt = (bf16_t*)(ws + WS_TV); \
    bf16_t* xb = (bf16_t*)(ws + WS_A0); bf16_t* xc = (bf16_t*)(ws + WS_A0); float* agg = (float*)(ws + WS_A0); bf16_t* h1b = (bf16_t*)(ws + WS_A0); \
    bf16_t* Yb = (bf16_t*)(ws + WS_A2); bf16_t* wq_plain = (bf16_t*)(ws + WS_A2); bf16_t* h2b = (bf16_t*)(ws + WS_A2); \
    bf16_t* gy = (bf16_t*)(ws + WS_A3); float* scores = (float*)(ws + WS_A3); \
    unsigned char* o8 = ws + WS_TV + 32 * MiB; bf16_t* gat = (bf16_t*)(ws + WS_A4); bf16_t* grn = (bf16_t*)(ws + WS_A5); bf16_t* ppb = (bf16_t*)(ws + WS_TU + 32 * MiB); \
    bf16_t* qn = (bf16_t*)(ws + WS_A6); bf16_t* kn = (bf16_t*)(ws + WS_A7); bf16_t* mixa = (bf16_t*)(ws + WS_A7); bf16_t* xn3 = (bf16_t*)(ws + WS_A7); \
    bf16_t* vv = (bf16_t*)(ws + WS_A8); bf16_t* mix = (bf16_t*)(ws + WS_A8); \
    bf16_t* qp = (bf16_t*)(ws + WS_A9); bf16_t* kpe = (bf16_t*)(ws + WS_KPE); \
    bf16_t* cq = (bf16_t*)outp; bf16_t* ckv = (bf16_t*)((unsigned char*)outp + 12 * MiB); bf16_t* xr = (bf16_t*)((unsigned char*)outp + 20 * MiB); \
    bf16_t* la = (bf16_t*)outp; bf16_t* gx = (bf16_t*)((unsigned char*)outp + 32 * MiB); \
    float* hres = outp;
#define INP_WS_STAMP (((unsigned char* const __attribute__((address_space(4)))*)__builtin_amdgcn_kernarg_segment_ptr())[29] + WS_SMALL + 400 * 1024)
    const int lo = P.ph_lo, hi = P.ph_hi;
    volatile __attribute__((address_space(3))) unsigned* misc_ = (volatile __attribute__((address_space(3))) unsigned*)((__attribute__((address_space(3))) unsigned char*)lds_raw + MISC_OFF);
    if (threadIdx.x < 2) misc_[threadIdx.x] = 0u;
    __syncthreads();
    XcdBarrier xbar; xbar.bar = nullptr; xbar.x = 0; xbar.st = nullptr;
    if (hi - lo > 1) xbar = xcd_barrier_post((unsigned*)(P.ws + WS_BAR), misc_);
#ifndef PHMASK
#define PHMASK 0xFFFF
#endif
#define IN(k) (((PHMASK >> (k)) & 1) && lo <= (k) && (k) < hi)
#define SYNC_AFTER(k) do { STAMP(2 * (k)); if (IN(k) && IN((k) + 1)) xcd_barrier(xbar); STAMP(2 * (k) + 1); } while (0)

#ifndef STAMP_DIV
#define STAMP_DIV 100.f
#endif
#ifndef SIMPLE_ATTN
#define SIMPLE_ATTN 0
#endif
#ifndef SIMPLE_GEMM
#define SIMPLE_GEMM 0
#endif
#define GEMM8(g, E) gemm_mfma8<decltype(E), true, true>((LAS unsigned char*)lds_raw, g, E)
#define GEMM(g, E) do { if (SIMPLE_GEMM) gemm_simple(lds, g, E); else gemm_mfma<decltype(E), true, true>((LAS unsigned char*)lds_raw, g, E); } while (0)
#ifdef STAMP_SEL
    if (blockIdx.x == STAMP_BLK && threadIdx.x == 0) { unsigned long long* st_ = (unsigned long long*)(INP_WS_STAMP); st_[0] = __builtin_amdgcn_s_memrealtime(); }
#define STAMP(k) do { if (blockIdx.x == STAMP_BLK && threadIdx.x == 0) { unsigned long long* st_ = (unsigned long long*)(INP_WS_STAMP); st_[(k) + 1] = __builtin_amdgcn_s_memrealtime(); } } while (0)
#else
#define STAMP(k) do {} while (0)
#endif
    if (IN(0)) { PH_PTRS();
        PHASE_IDS();
        int ib = 0;
        transpose_items<MapWin, true>(lds, INP[I_W_IN], DM, 9536, NIN_PAD, wt_in, INP[I_ATTN_NORM], WIN_SCALE, MapWin(), ib, gwave, gwaves);
        transpose_items(lds, INP[I_W_UQ], QL, 3072, 3072, wt_uq, INP[I_Q_NORM], QSCALE, MapWuq(), ib, gwave, gwaves);
        transpose_items(lds, INP[I_W_UKV], KVL, 4096, 4096, wt_ukv, INP[I_KV_NORM], 1.f, MapIdent(), ib, gwave, gwaves);
        transpose_items<MapIdent, true>(lds, INP[I_W_ATTN_O], DM, DM, DM, wt_ao, nullptr, WIN_SCALE, MapIdent(), ib, gwave, gwaves);
        transpose_items<MapIdent, true>(lds, INP[I_W_RNN_O], DM, DM, DM, wt_ro, nullptr, WIN_SCALE, MapIdent(), ib, gwave, gwaves);
        transpose_items<MapIdent, true>(lds, INP[I_W_OUT], DM, DM, DM, wt_out, nullptr, WIN_SCALE, MapIdent(), ib, gwave, gwaves);
        { const float* wq = INP[I_W_PEER_Q]; const float* gn = INP[I_FFN_NORM];
          for (int i = gtid; i < DM * DM / 8; i += gthreads) { const size_t o = (size_t)i * 8; const float g = gn[o / DM];
              const f32x4 a = *(const f32x4*)(wq + o) * g, b4 = *(const f32x4*)(wq + o + 4) * g; u32x4 w; w.x = pk2(a[0], a[1]); w.y = pk2(a[2], a[3]); w.z = pk2(b4[0], b4[1]); w.w = pk2(b4[2], b4[3]);
              *(u32x4*)(wq_plain + o) = w; } }
        transpose_items<MapIdent, true>(lds, INP[I_W_PLE_GATE], DM, DM, DM, wt_pg, INP[I_PLE_NORM], WIN_SCALE, MapIdent(), ib, gwave, gwaves);
        transpose_items(lds, INP[I_W_PLE_PROJ], PLE, DM, DM, wt_pp, nullptr, 1.f, MapIdent(), ib, gwave, gwaves);
        for (int b = 0; b < NBLK; ++b) {
            transpose_items(lds, INP[I_W_RG_A] + (size_t)b * BD * BD, BD, BD, BD, wt_g + (size_t)b * 256 * BD, nullptr, 1.f, MapIdent(), ib, gwave, gwaves);
            transpose_items(lds, INP[I_W_RG_X] + (size_t)b * BD * BD, BD, BD, BD, wt_g + (size_t)b * 256 * BD + 128 * BD, nullptr, 1.f, MapIdent(), ib, gwave, gwaves);
        }
        for (int i = gtid; i < PH * 256 * 256; i += gthreads) { const int h = i >> 16, n = (i >> 8) & 255, k = i & 255, c = n >> 7;
            float v = 0.f; if ((k >> 7) == c) v = INP[I_SUBKEYS][(((size_t)h * 2 + c) * NK + (n & 127)) * 128 + (k & 127)];
            wt_sk[i] = (bf16_t)f2bf(v); }
        { const float* pu = INP[I_PEER_U]; const float* pv = INP[I_PEER_V]; const float* gn = INP[I_FFN_NORM]; unsigned char* tu8 = (unsigned char*)tu; unsigned char* tv8 = (unsigned char*)tvt;
          const size_t n16 = (size_t)NK * NK * DM / 16;
          for (size_t i = gtid; i < n16; i += gthreads) { const size_t o = i * 16; const int d = (int)(o & (DM - 1));
              u32x4 wu, wv;
#pragma unroll
              for (int q = 0; q < 4; ++q) { const f32x4 a = *(const f32x4*)(pu + o + q * 4) * *(const f32x4*)(gn + d + q * 4) * TU_SCALE, bq = *(const f32x4*)(pv + o + q * 4) * TV_SCALE;
                  wu[q] = q8pack(a); wv[q] = q8pack(bq); }
              *(u32x4*)(tu8 + o) = wu; *(u32x4*)(tv8 + o) = wv; } }
        for (int i = gtid; i < S * PLE / 4; i += gthreads) { const f32x4 v = *(const f32x4*)(INP[I_P] + (size_t)i * 4); *(u32x2*)(pb + (size_t)i * 4) = pk4(v); }
        for (int t = gwave; t < S; t += gwaves) { const float* xrw = INP[I_X] + (size_t)t * DM; float s = 0.f;
#pragma unroll
            for (int j = 0; j < 8; ++j) { const f32x4 v = *(const f32x4*)(xrw + j * 256 + lane * 4); s += sumsq4(v); unsigned w1 = 0;
                w1 = __builtin_amdgcn_cvt_pk_fp8_f32(v[0] * X_SCALE, v[1] * X_SCALE, w1, false); w1 = __builtin_amdgcn_cvt_pk_fp8_f32(v[2] * X_SCALE, v[3] * X_SCALE, w1, true);
                *(unsigned*)((unsigned char*)xb + (size_t)t * DM + j * 256 + lane * 4) = w1; }
            s = wave_sum(s); if (lane == 0) small[SM_SSQ0 + t] = s; }
        for (int i = gtid; i < S * 32; i += gthreads) { const int t = i >> 5, j = i & 31; const float inv = exp2f(-(float)j * 0.41524101186092029f); const float ang = (float)t * inv;
            float rev = ang * 0.15915494309189535f; rev -= rintf(rev);
            rope[2 * i] = __builtin_amdgcn_cosf(rev); rope[2 * i + 1] = __builtin_amdgcn_sinf(rev); }
        for (int i = gtid; i < 4 * 2 * S; i += gthreads) small[SM_SSQQ + i] = 0.f;
        for (int i = gtid; i < DM; i += gthreads) { const float lam = INP[I_LAMBDA][i]; small[SM_N8SP + i] = -8.f * log1pf(__expf(-lam)); }
    }
    SYNC_AFTER(0);
    if (IN(1)) { PH_PTRS();
        GemmDesc g{xb, DM, 0, wt_in, DM, 0, S / 256, NIN_PAD / 256, 1, DM};
        static_assert(WS_A4 - WS_A3 == 32 * MiB && WS_A5 - WS_A4 == 32 * MiB && SM_SSQKV - SM_SSQQ == 16384, "EpiIn layout");
        EpiIn E{small + SM_SSQ0, rope, INP[I_B_GATE], cq, kpe, xr, gy, (u64*)(small + SM_SSQQ), 1.f / (WIN_SCALE * X_SCALE)};
        gemm_mfma8<decltype(E), true, true>((LAS unsigned char*)lds_raw, g, E);
        if (G == 256 && bx >= 192) { GemmDesc g2{wt_sk, 256, 256 * 256, wq_plain, DM, 256, 1, 8, PH, 256, 64, bx - 192}; EpiWf E2{wt_pq}; GEMM(g2, E2); }
    }
    SYNC_AFTER(1);
    if (IN(2)) { PH_PTRS();
        PHASE_IDS();
        { GemmDesc g{cq, QL, 0, wt_uq, QL, 0, S / 256, 12, 1, QL}; EpiQ E{(const u64*)(small + SM_SSQQ), rope, qn, qp}; GEMM(g, E); }
        if (G == 256 && bx >= 128) { GemmDesc g{pb, PLE, 0, wt_pp, PLE, 0, S / 256, 8, 1, PLE, 128, bx - 128}; EpiPlain E{ppb}; GEMM(g, E); }
        { GemmDesc g{ckv, KVL, 0, wt_ukv, KVL, 0, S / 256, 16, 1, KVL}; EpiKV E{(const u64*)(small + SM_SSQKV), kn, vv}; GEMM(g, E); }
        if (G != 256) { GemmDesc g{wt_sk, 256, 256 * 256, wq_plain, DM, 256, 1, 8, PH, 256}; EpiWf E{wt_pq}; GEMM(g, E); }
        const float* cw = INP[I_CONV_W]; const float* cb = INP[I_CONV_B];
        for (int i = gtid; i < (S / 32) * (DM / 8); i += gthreads) { const int run = i / (DM / 8), c = (i % (DM / 8)) * 8, t0 = run * 32;
            float w_[4][8], b_[8];
#pragma unroll
            for (int k = 0; k < 4; ++k) { const f32x4 a = *(const f32x4*)(cw + k * DM + c), d = *(const f32x4*)(cw + k * DM + c + 4); w_[k][0] = a[0]; w_[k][1] = a[1]; w_[k][2] = a[2]; w_[k][3] = a[3]; w_[k][4] = d[0]; w_[k][5] = d[1]; w_[k][6] = d[2]; w_[k][7] = d[3]; }
            { const f32x4 a = *(const f32x4*)(cb + c), d = *(const f32x4*)(cb + c + 4); b_[0] = a[0]; b_[1] = a[1]; b_[2] = a[2]; b_[3] = a[3]; b_[4] = d[0]; b_[5] = d[1]; b_[6] = d[2]; b_[7] = d[3]; }
            float x0[8], x1[8], x2[8];
#pragma unroll
            for (int j = 0; j < 8; ++j) { x0[j] = 0.f; x1[j] = 0.f; x2[j] = 0.f; }
            if (t0 > 0) { const u32x4 r0 = *(const u32x4*)(xr + (size_t)(t0 - 3) * DM + c), r1 = *(const u32x4*)(xr + (size_t)(t0 - 2) * DM + c), r2 = *(const u32x4*)(xr + (size_t)(t0 - 1) * DM + c);
#pragma unroll
                for (int j = 0; j < 4; ++j) { x0[2 * j] = bflo(r0[j]); x0[2 * j + 1] = bfhi(r0[j]); x1[2 * j] = bflo(r1[j]); x1[2 * j + 1] = bfhi(r1[j]); x2[2 * j] = bflo(r2[j]); x2[2 * j + 1] = bfhi(r2[j]); } }
#pragma unroll 1
            for (int tt = 0; tt < 32; tt += 8) { u32x4 rw[8];
#pragma unroll
                for (int q = 0; q < 8; ++q) rw[q] = *(const u32x4*)(xr + (size_t)(t0 + tt + q) * DM + c);
#pragma unroll
                for (int q = 0; q < 8; ++q) { float x3[8]; u32x4 o;
#pragma unroll
                    for (int j = 0; j < 4; ++j) { x3[2 * j] = bflo(rw[q][j]); x3[2 * j + 1] = bfhi(rw[q][j]); }
#pragma unroll
                    for (int j = 0; j < 4; ++j) { const float y0 = b_[2 * j] + w_[0][2 * j] * x0[2 * j] + w_[1][2 * j] * x1[2 * j] + w_[2][2 * j] * x2[2 * j] + w_[3][2 * j] * x3[2 * j];
                        const float y1 = b_[2 * j + 1] + w_[0][2 * j + 1] * x0[2 * j + 1] + w_[1][2 * j + 1] * x1[2 * j + 1] + w_[2][2 * j + 1] * x2[2 * j + 1] + w_[3][2 * j + 1] * x3[2 * j + 1]; o[j] = pk2(y0, y1); }
                    *(u32x4*)(xc + (size_t)(t0 + tt + q) * DM + c) = o;
#pragma unroll
                    for (int j = 0; j < 8; ++j) { x0[j] = x1[j]; x1[j] = x2[j]; x2[j] = x3[j]; } } } }
    }
    SYNC_AFTER(2);
    if (IN(3)) { PH_PTRS();
        if (SIMPLE_ATTN) attn_simple(lds, qn, qp, kn, kpe, vv, qn); else attn_mfma((char*)lds_raw, qn, qp, kn, kpe, vv, (bf16_t*)o8);
#ifndef SKIP_GATES
        GemmDesc g{xc, DM, BD, wt_g, BD, 256 * BD, S / 256, 1, NBLK, BD};
        EpiGates E{INP[I_B_RG_A], INP[I_B_RG_X], small + SM_N8SP, xc, la, gx};
        GEMM(g, E);
#endif
    }
    SYNC_AFTER(3);
    if (IN(4)) { PH_PTRS();
        PHASE_IDS();
        for (int i = gtid; i < 64 * (DM / 2); i += gthreads) { const int ch = i / (DM / 2), c = (i % (DM / 2)) * 2;
            float A0 = 1.f, B0 = 0.f, A1 = 1.f, B1 = 0.f;
#pragma unroll 1
            for (int t16 = 0; t16 < 128; t16 += 16) { unsigned lw[16], gw[16];
#pragma unroll
                for (int q = 0; q < 16; ++q) { const size_t o = (size_t)(ch * 128 + t16 + q) * DM + c; lw[q] = *(const unsigned*)(la + o); gw[q] = *(const unsigned*)(gx + o); }
#pragma unroll
                for (int q = 0; q < 16; ++q) { const float a0 = __builtin_amdgcn_exp2f(bflo(lw[q])), a1 = __builtin_amdgcn_exp2f(bfhi(lw[q]));
                    A0 *= a0; B0 = a0 * B0 + bflo(gw[q]); A1 *= a1; B1 = a1 * B1 + bfhi(gw[q]); } }
            *(f32x4*)(agg + ((size_t)ch * DM + c) * 2) = (f32x4){A0, B0, A1, B1}; }
    }
    SYNC_AFTER(4);
    if (IN(5)) { PH_PTRS();
        PHASE_IDS();
        for (int i = gtid; i < 64 * (DM / 2); i += gthreads) { const int ch = i / (DM / 2), c = (i % (DM / 2)) * 2;
            float h0 = 0.f, h1v = 0.f;
#pragma unroll 1
            for (int c16 = 0; c16 < ch; c16 += 16) { f32x4 ab[16];
#pragma unroll
                for (int q = 0; q < 16; ++q) ab[q] = (c16 + q < ch) ? *(const f32x4*)(agg + ((size_t)(c16 + q) * DM + c) * 2) : (f32x4){1.f, 0.f, 1.f, 0.f};
#pragma unroll
                for (int q = 0; q < 16; ++q) { h0 = ab[q][0] * h0 + ab[q][1]; h1v = ab[q][2] * h1v + ab[q][3]; } }
#pragma unroll 1
            for (int t16 = 0; t16 < 128; t16 += 16) { unsigned lw[16], gw[16], yw[16];
#pragma unroll
                for (int q = 0; q < 16; ++q) { const size_t o = (size_t)(ch * 128 + t16 + q) * DM + c; lw[q] = *(const unsigned*)(la + o); gw[q] = *(const unsigned*)(gx + o); yw[q] = *(const unsigned*)(gy + o); }
#pragma unroll
                for (int q = 0; q < 16; ++q) { const float a0 = __builtin_amdgcn_exp2f(bflo(lw[q])), a1 = __builtin_amdgcn_exp2f(bfhi(lw[q]));
                    h0 = a0 * h0 + bflo(gw[q]); h1v = a1 * h1v + bfhi(gw[q]);
                    *(unsigned short*)((unsigned char*)Yb + (size_t)(ch * 128 + t16 + q) * DM + c) = (unsigned short)(__builtin_amdgcn_cvt_pk_fp8_f32(h0 * bflo(yw[q]) * Y_SCALE, h1v * bfhi(yw[q]) * Y_SCALE, 0u, false) & 0xffffu); } } }
    }
    SYNC_AFTER(5);
    if (IN(6)) { PH_PTRS();
        { GemmDesc g{(const bf16_t*)o8, DM, 0, wt_ao, DM, 0, S / 256, 8, 1, DM}; EpiMixA E{gat, mixa}; GEMM8(g, E); }
        asm volatile("s_waitcnt vmcnt(0)" ::: "memory"); __syncthreads();
        { GemmDesc g{Yb, DM, 0, wt_ro, DM, 0, S / 256, 8, 1, DM}; EpiMix E{grn, mixa, (unsigned char*)mix}; GEMM8(g, E); }
    }
    SYNC_AFTER(6);
    if (IN(7)) { PH_PTRS();
        { GemmDesc g{mix, DM, 0, wt_out, DM, 0, S / 256, 8, 1, DM}; EpiOut E{INP[I_X], h1b, (u64*)(small + SM_SSQ1)}; GEMM8(g, E); }
        if (G != 256) { GemmDesc g{pb, PLE, 0, wt_pp, PLE, 0, S / 256, 8, 1, PLE}; EpiPlain E{ppb}; GEMM(g, E); }
    }
    SYNC_AFTER(7);
    if (IN(8)) { PH_PTRS(); GemmDesc g{h1b, DM, 0, wt_pq, DM, 0, S / 256, 8, 1, DM}; EpiScores E{scores, (const u64*)(small + SM_SSQ1)}; GEMM(g, E); }
    SYNC_AFTER(8);

    if (IN(10)) { PH_PTRS(); peer_phase2((void*)(INP_WS_STAMP), (char*)lds_raw, scores, h1b, (const u64*)(small + SM_SSQ1), (const unsigned char*)tu, (const unsigned char*)tvt, h2b, xn3, small + SM_SSQ2); }
    SYNC_AFTER(10);
#ifdef STAMP_SEL
    const bool fuse_final = false;
#else
    const bool fuse_final = (G == 256);
#endif
    if (IN(11)) { PH_PTRS(); GemmDesc g{xn3, DM, 0, wt_pg, DM, 0, S / 256, 8, 1, DM};
        if (fuse_final) { EpiPleFinal E{ppb, h2b, hres, (u64*)(small + SM_SSQ3), small + SM_SSQ2, INP[I_FINAL_NORM], (unsigned*)(ws + WS_BAR) + XCD_BAR_WORDS}; gemm_mfma8<decltype(E), true, true>((LAS unsigned char*)lds_raw, g, E); }
        else { EpiPle E{ppb, h2b, hres, (u64*)(small + SM_SSQ3), small + SM_SSQ2}; gemm_mfma8<decltype(E), true, true>((LAS unsigned char*)lds_raw, g, E); } }
    if (!fuse_final) { SYNC_AFTER(11); }
    if (IN(12) && !fuse_final) { PH_PTRS();
        PHASE_IDS();
        const float* fn = INP[I_FINAL_NORM];
        for (int i = gtid; i < S * DM / 4; i += gthreads) { const int t = i / (DM / 4), c = (i % (DM / 4)) * 4;
            const float rs = rsqrtf(ssq_get((const u64*)(small + SM_SSQ3), t) * (1.f / DM) + EPS);
            const f32x4 v = *(const f32x4*)(hres + (size_t)i * 4), g4 = *(const f32x4*)(fn + c);
            f32x4 ov = v * rs * g4;
#ifdef STAMP_SEL
            if (i == STAMP_BLK * NTHREADS) { const unsigned long long* st_ = (const unsigned long long*)(INP_WS_STAMP); { const float tus_ = (float)(st_[STAMP_B] - st_[STAMP_A]) * 0.01f; ov[0] += exp2f(rintf(STAMP_Q * log2f(fmaxf(tus_, 1.f))) * (1.f / STAMP_Q)) * (1.f / STAMP_DIV); } }
#endif
            *(f32x4*)(hres + (size_t)i * 4) = ov; }
    }
}

constexpr int NPHASES = 13;
#ifndef MK_N_LAUNCHES
#define MK_N_LAUNCHES 1
#endif

extern "C" void kernel_launch(void* const* d_in, const int* in_sizes, int n_in, void* d_out, int out_size, void* d_ws, size_t ws_size, hipStream_t stream) {
    static int grid = 0;
    if (grid == 0) {
        if (n_in != 28 || out_size != S * DM || ws_size < WS_END) { fprintf(stderr, "kernel_launch: unexpected shapes (n_in %d out %d ws %zu)\n", n_in, out_size, ws_size); grid = -1; return; }
        int dev = 0, cus = 0, per_cu = 0;
        (void)hipGetDevice(&dev);
        (void)hipDeviceGetAttribute(&cus, hipDeviceAttributeMultiprocessorCount, dev);
        if (hipFuncSetAttribute((const void*)fwd_kernel, hipFuncAttributeMaxDynamicSharedMemorySize, LDS_BYTES) != hipSuccess) { fprintf(stderr, "kernel_launch: hipFuncSetAttribute failed\n"); grid = -1; return; }
        if (hipOccupancyMaxActiveBlocksPerMultiprocessor(&per_cu, (const void*)fwd_kernel, NTHREADS, LDS_BYTES) != hipSuccess || per_cu < 1) { fprintf(stderr, "kernel_launch: occupancy query failed (%d)\n", per_cu); (void)hipGetLastError(); per_cu = 1; }
        if (per_cu > 1) per_cu = 1;
        grid = cus * per_cu;
        if (grid <= 0) grid = 256;
    }
    if (grid < 0) return;
    if (hipMemsetAsync((char*)d_ws + WS_BAR, 0, XCD_BAR_WORDS * 4 + 32 * 256, stream) != hipSuccess) { fprintf(stderr, "kernel_launch: hipMemsetAsync failed\n"); return; }
    Params p{};
    for (int i = 0; i < 28; ++i) p.in[i] = (const float*)d_in[i];
    p.out = (float*)d_out; p.ws = (unsigned char*)d_ws;
    if (MK_N_LAUNCHES == 1) {
        p.ph_lo = 0; p.ph_hi = NPHASES;
        void* args[] = {&p};
        hipError_t e = hipLaunchCooperativeKernel((const void*)fwd_kernel, dim3(grid), dim3(NTHREADS), args, LDS_BYTES, stream);
        if (e != hipSuccess) fprintf(stderr, "cooperative launch failed: %s (grid %d)\n", hipGetErrorString(e), grid);
    } else {
        for (int k = 0; k < NPHASES; ++k) { p.ph_lo = k; p.ph_hi = k + 1; hipLaunchKernelGGL(fwd_kernel, dim3(grid), dim3(NTHREADS), LDS_BYTES, stream, p); }
    }
}
```

```cpp
#include <hip/hip_runtime.h>
#include <hip/hip_cooperative_groups.h>
#include <cstdio>
#include <cstdint>
namespace cg = cooperative_groups;

#define STAMP_A 0
#define STAMP_BLK 0
#define ROT_EXP 0
#define UREP 1
#define EXP_MASK 0x3FFF
#define STAMP_B 2
#ifndef STAMP_Q
#define STAMP_Q 4.f
#endif
#define DEV __device__ __forceinline__
typedef unsigned short bf16_t;
typedef float f32x4 __attribute__((ext_vector_type(4)));
typedef float f32x2 __attribute__((ext_vector_type(2)));
typedef unsigned u32x2 __attribute__((ext_vector_type(2)));
typedef unsigned u32x4 __attribute__((ext_vector_type(4)));

constexpr int S = 8192, DM = 2048, PLE = 256;
constexpr int NH = 16, DN = 128, DR = 64, DV = 128;
constexpr int QL = 768, KVL = 512;
constexpr int NBLK = 16, BD = 128;
constexpr int PH = 8, NK = 128, TOPK = 16;
constexpr int NIN_PAD = 9728;
constexpr float EPS = 1e-6f;
constexpr float QSCALE = 0.07216878364870322f * 1.4426950408889634f;
constexpr int NTHREADS = 512;
constexpr float WIN_SCALE = 64.f, X_SCALE = 16.f, O_SCALE = 32.f, Y_SCALE = 16.f, MIX_SCALE = 32.f;
constexpr float TU_SCALE = 1024.f, TV_SCALE = 64.f, H_SCALE = 16.f;
#ifndef DBG_PEER
#define DBG_PEER 1
#endif
constexpr int LDS_BYTES = 147456;

constexpr size_t MiB = 1u << 20;
constexpr size_t WS_WIN = 0, WS_WUQ = 38 * MiB, WS_WUKV = WS_WUQ + 9 * MiB / 2, WS_WAO = WS_WUKV + 4 * MiB, WS_WRO = WS_WAO + 8 * MiB,
                 WS_WOUT = WS_WRO + 8 * MiB, WS_WPQ = WS_WOUT + 8 * MiB, WS_WPG = WS_WPQ + 8 * MiB, WS_WPP = WS_WPG + 8 * MiB,
                 WS_WG = WS_WPP + 1 * MiB, WS_WSK = WS_WG + 1 * MiB, WS_ROPE = WS_WSK + 1 * MiB, WS_PB = WS_ROPE + 2 * MiB, WS_SMALL = WS_PB + 4 * MiB;
static_assert(WS_SMALL == 95 * MiB + MiB / 2, "ws map");
constexpr size_t WS_A0 = 96 * MiB;
constexpr size_t WS_A2 = 128 * MiB;
constexpr size_t WS_A3 = 160 * MiB;
constexpr size_t WS_A4 = 192 * MiB;
constexpr size_t WS_A5 = 224 * MiB;
constexpr size_t WS_A6 = 256 * MiB;
constexpr size_t WS_A7 = 288 * MiB;
constexpr size_t WS_A8 = 320 * MiB;
constexpr size_t WS_A9 = 352 * MiB;
constexpr size_t WS_KPE = 368 * MiB;
constexpr size_t WS_TU = 384 * MiB, WS_TV = 448 * MiB, WS_END = 512 * MiB;
constexpr size_t WS_BAR = WS_SMALL + 352 * 1024;
constexpr int MISC_OFF = LDS_BYTES - 64;
constexpr int SM_SSQ0 = 0, SM_SSQQ = 8192, SM_SSQKV = 24576, SM_SSQ1 = 40960, SM_SSQ3 = 57344, SM_N8SP = 73728, SM_SSQ2 = 75776;
typedef unsigned long long u64;

DEV unsigned f2bf(float f) { unsigned u = __float_as_uint(f); return (u + 0x7fffu + ((u >> 16) & 1u)) >> 16; }
DEV unsigned pk2(float lo, float hi) { return f2bf(lo) | (f2bf(hi) << 16); }
DEV float bflo(unsigned w) { return __uint_as_float(w << 16); }
DEV float bfhi(unsigned w) { return __uint_as_float(w & 0xffff0000u); }
DEV u32x2 pk4(f32x4 v) { u32x2 r; r.x = pk2(v[0], v[1]); r.y = pk2(v[2], v[3]); return r; }
DEV f32x4 unpk4(u32x2 w) { return (f32x4){bflo(w.x), bfhi(w.x), bflo(w.y), bfhi(w.y)}; }
DEV u32x4 pk8(f32x4 a, f32x4 b) { u32x4 r; r.x = pk2(a[0], a[1]); r.y = pk2(a[2], a[3]); r.z = pk2(b[0], b[1]); r.w = pk2(b[2], b[3]); return r; }
DEV f32x4 unpk4lo(u32x4 w) { return (f32x4){bflo(w.x), bfhi(w.x), bflo(w.y), bfhi(w.y)}; }
DEV f32x4 unpk4hi(u32x4 w) { return (f32x4){bflo(w.z), bfhi(w.z), bflo(w.w), bfhi(w.w)}; }
DEV int perm_p(int R) { return (R & ~0x1C) | ((R & 0x0C) << 1) | ((R & 0x10) >> 2); }
DEV unsigned q8(float x) { return (unsigned)(int)fminf(fmaxf(rintf(x), -127.f), 127.f) & 0xffu; }
DEV unsigned q8pack(f32x4 v) { return q8(v[0]) | (q8(v[1]) << 8) | (q8(v[2]) << 16) | (q8(v[3]) << 24); }
DEV unsigned f8pack(f32x4 v) { unsigned w = 0; w = __builtin_amdgcn_cvt_pk_fp8_f32(v[0], v[1], w, false); w = __builtin_amdgcn_cvt_pk_fp8_f32(v[2], v[3], w, true); return w; }
DEV float sigmoidf_(float x) { return 1.f / (1.f + __expf(-x)); }
DEV float gelu_tanh(float x) { const float y = 0.7978845608028654f * (x + 0.044715f * x * x * x); const float t = 1.f - 2.f / (1.f + __expf(2.f * y)); return 0.5f * x * (1.f + t); }
DEV float wave_sum(float v) {
#pragma unroll
    for (int o = 1; o < 64; o <<= 1) v += __shfl_xor(v, o);
    return v;
}

struct Params { const float* in[28]; float* out; unsigned char* ws; int ph_lo, ph_hi; };
enum { I_X = 0, I_P, I_ATTN_NORM, I_W_IN, I_B_GATE, I_Q_NORM, I_W_UQ, I_KV_NORM, I_W_UKV, I_W_ATTN_O, I_CONV_W, I_CONV_B, I_W_RG_A, I_B_RG_A, I_W_RG_X,
       I_B_RG_X, I_LAMBDA, I_W_RNN_O, I_W_OUT, I_FFN_NORM, I_W_PEER_Q, I_SUBKEYS, I_PEER_U, I_PEER_V, I_PLE_NORM, I_W_PLE_GATE, I_W_PLE_PROJ, I_FINAL_NORM };

struct MapIdent { DEV int operator()(int n) const { return n; } };
struct MapWin { DEV int operator()(int n) const {
    if (n < 1280) return n;
    if (n < 1344) { const int j = n - 1280; return 1280 + 16 * (j >> 5) + 4 * ((j >> 3) & 3) + (j & 3) + 32 * ((j >> 2) & 1); }
    if (n < 1536) return -1;
    return n - 192; } };
struct MapWuq { DEV int operator()(int n) const {
    if (n < 2048) { const int h = n >> 7, d = n & 127; return h * 192 + d; }
    const int r = n - 2048, h = r >> 6, j = r & 63;
    return h * 192 + 128 + 16 * (j >> 5) + 4 * ((j >> 3) & 3) + (j & 3) + 32 * ((j >> 2) & 1); } };

template <class MAP, bool FP8 = false>
DEV void transpose_items(float* lds, const float* W, int K, int N, int Nd, bf16_t* WT, const float* gain, float scale, MAP map, int& item_base, int gw, int ngw) {
    const int lane = threadIdx.x & 63, wid = threadIdx.x >> 6;
    const int nkt = K / 64, nnt = Nd / 64, nitems = nkt * nnt;
    float* T = lds + wid * (64 * 65);
    int first = (gw - item_base) % ngw; if (first < 0) first += ngw;
    for (int it = first; it < nitems; it += ngw) {
        const int kt = it % nkt, nt = it / nkt, k0 = kt * 64, n0 = nt * 64;
        const int c4 = (lane & 15) * 4, src = map(n0 + c4), kq = lane >> 4;
        f32x4 v[16];
#pragma unroll
        for (int i = 0; i < 16; ++i) { v[i] = (f32x4){0.f, 0.f, 0.f, 0.f}; if (src >= 0) v[i] = *(const f32x4*)(W + (size_t)(k0 + i * 4 + kq) * N + src); }
#pragma unroll
        for (int i = 0; i < 16; ++i) { const int kk = i * 4 + kq; const float g = (gain ? gain[k0 + kk] : 1.f) * scale;
            T[kk * 65 + c4 + 0] = v[i][0] * g; T[kk * 65 + c4 + 1] = v[i][1] * g; T[kk * 65 + c4 + 2] = v[i][2] * g; T[kk * 65 + c4 + 3] = v[i][3] * g; }
        asm volatile("s_waitcnt lgkmcnt(0)" ::: "memory");
        const int kc = (lane & 7) * 8;
#pragma unroll
        for (int i = 0; i < 8; ++i) { const int n = (lane >> 3) + 8 * i; u32x4 o;
            o.x = pk2(T[(kc + 0) * 65 + n], T[(kc + 1) * 65 + n]); o.y = pk2(T[(kc + 2) * 65 + n], T[(kc + 3) * 65 + n]);
            o.z = pk2(T[(kc + 4) * 65 + n], T[(kc + 5) * 65 + n]); o.w = pk2(T[(kc + 6) * 65 + n], T[(kc + 7) * 65 + n]);
            if constexpr (FP8) { u32x2 o8; unsigned w1 = 0, w2 = 0;
                w1 = __builtin_amdgcn_cvt_pk_fp8_f32(T[(kc + 0) * 65 + n], T[(kc + 1) * 65 + n], w1, false); w1 = __builtin_amdgcn_cvt_pk_fp8_f32(T[(kc + 2) * 65 + n], T[(kc + 3) * 65 + n], w1, true);
                w2 = __builtin_amdgcn_cvt_pk_fp8_f32(T[(kc + 4) * 65 + n], T[(kc + 5) * 65 + n], w2, false); w2 = __builtin_amdgcn_cvt_pk_fp8_f32(T[(kc + 6) * 65 + n], T[(kc + 7) * 65 + n], w2, true);
                o8.x = w1; o8.y = w2; *(u32x2*)((unsigned char*)WT + (size_t)(n0 + n) * K + k0 + kc) = o8; }
            else *(u32x4*)(WT + (size_t)(n0 + n) * K + k0 + kc) = o; }
        asm volatile("s_waitcnt lgkmcnt(0)" ::: "memory");
    }
    item_base += nitems;
}

struct Unit { int pm, pn, b; };
struct GemmDesc { const bf16_t* A; int lda; long a_bs; const bf16_t* Bt; int ldb; long b_bs; int nM, nN, nB, K; int vG, vc; };
template <class Epi>
DEV void gemm_simple(float* lds, const GemmDesc g, const Epi& E) {
    const int tid = threadIdx.x, lane = tid & 63, wid = tid >> 6, wr = wid >> 2, wc = wid & 3, fr = lane & 15, fq = lane >> 4;
    float* As = lds; float* Bs = lds + 256 * 20;
    const int total = g.nM * g.nN * g.nB;
    for (int u = blockIdx.x; u < total; u += gridDim.x) {
        Unit un; un.pm = u % g.nM; un.pn = (u / g.nM) % g.nN; un.b = u / (g.nM * g.nN);
        const bf16_t* Ab = g.A + (size_t)un.b * g.a_bs + (size_t)un.pm * 256 * g.lda;
        const bf16_t* Bb = g.Bt + (size_t)un.b * g.b_bs + (size_t)un.pn * 256 * g.ldb;
        f32x4 acc[2][2][4][2];
#pragma unroll
        for (int a = 0; a < 2; ++a)
#pragma unroll
            for (int b = 0; b < 2; ++b)
#pragma unroll
                for (int m = 0; m < 4; ++m)
#pragma unroll
                    for (int n = 0; n < 2; ++n) acc[a][b][m][n] = (f32x4){0.f, 0.f, 0.f, 0.f};
        for (int k0 = 0; k0 < g.K; k0 += 16) {
            __syncthreads();
            { const int r = tid >> 1, kk = (tid & 1) * 8;
              const u32x4 a = *(const u32x4*)(Ab + (size_t)r * g.lda + k0 + kk);
              const u32x4 b = *(const u32x4*)(Bb + (size_t)(Epi::PM ? perm_p(r) : r) * g.ldb + k0 + kk);
              float* ap = As + r * 20 + kk; float* bp = Bs + r * 20 + kk;
              *(f32x4*)ap = (f32x4){bflo(a.x), bfhi(a.x), bflo(a.y), bfhi(a.y)}; *(f32x4*)(ap + 4) = (f32x4){bflo(a.z), bfhi(a.z), bflo(a.w), bfhi(a.w)};
              *(f32x4*)bp = (f32x4){bflo(b.x), bfhi(b.x), bflo(b.y), bfhi(b.y)}; *(f32x4*)(bp + 4) = (f32x4){bflo(b.z), bfhi(b.z), bflo(b.w), bfhi(b.w)}; }
            __syncthreads();
#pragma unroll 1
            for (int k4 = 0; k4 < 16; k4 += 4) {
#pragma unroll
                for (int ai = 0; ai < 2; ++ai) {
                    f32x4 av[4];
#pragma unroll
                    for (int m = 0; m < 4; ++m) av[m] = *(const f32x4*)(As + (ai * 128 + wr * 64 + m * 16 + fr) * 20 + k4);
#pragma unroll
                    for (int bj = 0; bj < 2; ++bj)
#pragma unroll
                        for (int n = 0; n < 2; ++n)
#pragma unroll
                            for (int i = 0; i < 4; ++i) {
                                const f32x4 b = *(const f32x4*)(Bs + (bj * 128 + wc * 32 + n * 16 + fq * 4 + i) * 20 + k4);
#pragma unroll
                                for (int m = 0; m < 4; ++m) { const f32x4 a = av[m]; float c = acc[ai][bj][m][n][i];
                                    c = fmaf(a[0], b[0], c); c = fmaf(a[1], b[1], c); c = fmaf(a[2], b[2], c); c = fmaf(a[3], b[3], c); acc[ai][bj][m][n][i] = c; }
                                asm volatile("" ::: "memory");
                            }
                }
            }
        }
        { int fr2 = fr, fq2 = fq, wr2 = wr, wc2 = wc; asm volatile("" : "+v"(fr2), "+v"(fq2), "+v"(wr2), "+v"(wc2));
          E(acc, un, wr2, wc2, fr2, fq2); }
    }
}

#define LAS __attribute__((address_space(3)))
typedef short bf16x8 __attribute__((ext_vector_type(8)));
constexpr int BM = 256, BK = 64, HALF = 128, HTB = HALF * BK * 2, STAGE_BYTES = 8 * HTB;
DEV int lds_byte(int r, int c) { const int st = (r >> 4) * 2 + (c >> 5), rr = r & 15, cc = c & 31, ob = rr * 64 + cc * 2; return st * 1024 + (ob ^ (((ob >> 9) & 1) << 5)); }
DEV void stage_rc(int b, int& R, int& C) { const int st = b / 1024, sb = b % 1024, swz = sb ^ (((sb >> 9) & 1) << 5); R = (st >> 1) * 16 + swz / 64; C = (st & 1) * 32 + (swz % 64) / 2; }
struct UnitOrder { int nM, nN, total, G, c;
    DEV bool next(int i, Unit& u) const { const int L = i * G + c; if (L >= total) return false; u.pm = L % nM; u.pn = (L / nM) % nN; u.b = L / (nM * nN); return true; } };
template <class Epi, bool ALIGN_EPI, bool SP2>
__device__ __forceinline__ void gemm_mfma(LAS unsigned char* lds, const GemmDesc g, const Epi& E) {
    const UnitOrder S{g.nM, g.nN, g.nM * g.nN * g.nB, g.vG ? g.vG : (int)gridDim.x, g.vG ? g.vc : (int)blockIdx.x};
    const int tid = threadIdx.x, wid = __builtin_amdgcn_readfirstlane(tid >> 6), lane = tid & 63, wr = wid >> 2, wc = wid & 3, fr = lane & 15, fq = lane >> 4;
    int K = g.K; asm volatile("" : "+s"(K));
    const int nt = K / BK;
    unsigned voffA[2], voffB[2];
#pragma unroll
    for (int i = 0; i < 2; ++i) { int R, C; stage_rc(tid * 16 + i * 8192, R, C); voffA[i] = (unsigned)(R * g.lda + C) * 2u; voffB[i] = (unsigned)((Epi::PM ? perm_p(R) : R) * g.ldb + C) * 2u; }
    const size_t kstep = (size_t)(BK * 2);
    const size_t hstepA = (size_t)HALF * g.lda * 2, hstepB = (size_t)HALF * g.ldb * 2;
    const unsigned ldsw = (unsigned)wid * 1024u;
    const int aoff = lds_byte(wr * 64 + fr, fq * 8), boff = lds_byte(wc * 32 + fr, fq * 8);
#define PG8_SA(b, h) (((b) * 2 + (h)) * HTB)
#define PG8_SB(b, h) ((4 + (b) * 2 + (h)) * HTB)
#define PG8_STAGE(bufoff, gbase, voff) do { _Pragma("unroll") for (int _i = 0; _i < 2; ++_i) \
        __builtin_amdgcn_global_load_lds((const unsigned*)((const char*)(gbase) + (voff)[_i]), (LAS unsigned*)(lds + (bufoff) + ldsw + _i * 8192), 16, 0, 0); } while (0)
#define PG8_LDA(dst, b, h) do { _Pragma("unroll") for (int m = 0; m < 4; ++m) _Pragma("unroll") for (int k = 0; k < 2; ++k) dst[m][k] = *(const LAS bf16x8*)(lds + PG8_SA(b, h) + aoff + m * 2048 + k * 1024); } while (0)
#define PG8_LDB(dst, b, h) do { _Pragma("unroll") for (int n = 0; n < 2; ++n) _Pragma("unroll") for (int k = 0; k < 2; ++k) dst[n][k] = *(const LAS bf16x8*)(lds + PG8_SB(b, h) + boff + n * 2048 + k * 1024); } while (0)
#define PG8_MMA(ai, bj, At, Bt) do { __builtin_amdgcn_s_setprio(1); _Pragma("unroll") for (int m = 0; m < 4; ++m) _Pragma("unroll") for (int n = 0; n < 2; ++n) _Pragma("unroll") for (int k = 0; k < 2; ++k) \
        acc[ai][bj][m][n] = __builtin_amdgcn_mfma_f32_16x16x32_bf16(Bt[n][k], At[m][k], acc[ai][bj][m][n], 0, 0, 0); __builtin_amdgcn_s_setprio(0); } while (0)
#define PG8_WAIT_V(n) asm volatile("s_waitcnt vmcnt(" #n ")" ::: "memory")
#define PG8_WAIT_L(n) asm volatile("s_waitcnt lgkmcnt(" #n ")" ::: "memory")
#define PG8_BAR __builtin_amdgcn_s_barrier()
#define PG8_SCHED __builtin_amdgcn_sched_barrier(0)
    Unit cur, nxt; int ui = 0;
    if (!S.next(0, cur)) return;
    f32x4 acc[2][2][4][2];
#pragma unroll
    for (int a = 0; a < 2; ++a)
#pragma unroll
        for (int b = 0; b < 2; ++b)
#pragma unroll
            for (int m = 0; m < 4; ++m)
#pragma unroll
                for (int n = 0; n < 2; ++n) acc[a][b][m][n] = (f32x4){0.f, 0.f, 0.f, 0.f};
    bf16x8 At[4][2], B0[2][2], B1[2][2];
    const char* cA = (const char*)(g.A + (size_t)cur.b * g.a_bs) + (size_t)cur.pm * 2 * hstepA; const char* cB = (const char*)(g.Bt + (size_t)cur.b * g.b_bs) + (size_t)cur.pn * 2 * hstepB;
    if constexpr (SP2) {
        PG8_STAGE(PG8_SB(0, 0), cB, voffB); PG8_STAGE(PG8_SB(0, 1), cB + hstepB, voffB); PG8_STAGE(PG8_SA(0, 0), cA, voffA); PG8_STAGE(PG8_SA(0, 1), cA + hstepA, voffA);
        if (wr == 1) PG8_BAR;
        PG8_WAIT_V(2); PG8_BAR;
        PG8_STAGE(PG8_SB(1, 0), cB + kstep, voffB); PG8_STAGE(PG8_SA(1, 0), cA + kstep, voffA); PG8_STAGE(PG8_SB(1, 1), cB + hstepB + kstep, voffB);
        PG8_WAIT_V(6); PG8_BAR;
    } else {
        PG8_STAGE(PG8_SB(0, 0), cB, voffB); PG8_STAGE(PG8_SA(0, 0), cA, voffA); PG8_STAGE(PG8_SB(0, 1), cB + hstepB, voffB); PG8_STAGE(PG8_SA(0, 1), cA + hstepA, voffA);
        if (wr == 1) PG8_BAR;
        PG8_WAIT_V(4); PG8_BAR;
        PG8_STAGE(PG8_SB(1, 0), cB + kstep, voffB); PG8_STAGE(PG8_SA(1, 0), cA + kstep, voffA); PG8_STAGE(PG8_SB(1, 1), cB + hstepB + kstep, voffB);
        PG8_WAIT_V(6); PG8_BAR;
    }
    for (;;) {
        const bool has_next = S.next(ui + 1, nxt);
        const char* nA = has_next ? (const char*)(g.A + (size_t)nxt.b * g.a_bs) + (size_t)nxt.pm * 2 * hstepA : cA; const char* nB = has_next ? (const char*)(g.Bt + (size_t)nxt.b * g.b_bs) + (size_t)nxt.pn * 2 * hstepB : cB;
        for (int t = 0; t < nt; t += 2) {
            const bool last = (t == nt - 2);
            const char* a1 = cA + (size_t)(t + 1) * kstep;
            const char* a2 = last ? nA : cA + (size_t)(t + 2) * kstep; const char* b2 = last ? nB : cB + (size_t)(t + 2) * kstep;
            const char* a3 = a2 + kstep; const char* b3 = b2 + kstep;
            if constexpr (SP2) {
            PG8_LDB(B0, 0, 0); PG8_LDB(B1, 0, 1); PG8_SCHED; PG8_LDA(At, 0, 0); PG8_STAGE(PG8_SA(1, 1), a1 + hstepA, voffA);
            PG8_WAIT_V(8); PG8_WAIT_L(0); PG8_BAR; PG8_MMA(0, 0, At, B0); PG8_MMA(0, 1, At, B1); PG8_BAR; PG8_SCHED;
            PG8_LDA(At, 0, 1); PG8_STAGE(PG8_SB(0, 0), b2, voffB); PG8_STAGE(PG8_SB(0, 1), b2 + hstepB, voffB); PG8_STAGE(PG8_SA(0, 0), a2, voffA);
            PG8_WAIT_V(8); PG8_WAIT_L(0); PG8_BAR; PG8_MMA(1, 0, At, B0); PG8_MMA(1, 1, At, B1); PG8_BAR; PG8_SCHED;
            PG8_LDB(B0, 1, 0); PG8_LDB(B1, 1, 1); PG8_SCHED; PG8_LDA(At, 1, 0); PG8_STAGE(PG8_SA(0, 1), a2 + hstepA, voffA);
            PG8_WAIT_V(8); PG8_WAIT_L(0); PG8_BAR; PG8_MMA(0, 0, At, B0); PG8_MMA(0, 1, At, B1); PG8_BAR; PG8_SCHED;
            PG8_LDA(At, 1, 1); PG8_STAGE(PG8_SB(1, 0), b3, voffB); PG8_STAGE(PG8_SB(1, 1), b3 + hstepB, voffB); PG8_STAGE(PG8_SA(1, 0), a3, voffA);
            PG8_WAIT_V(8); PG8_WAIT_L(0); PG8_BAR; PG8_MMA(1, 0, At, B0); PG8_MMA(1, 1, At, B1); PG8_BAR; PG8_SCHED;
            } else {
            PG8_LDB(B0, 0, 0); PG8_SCHED; PG8_LDA(At, 0, 0); PG8_STAGE(PG8_SA(1, 1), a1 + hstepA, voffA);
            PG8_WAIT_L(8); PG8_BAR; PG8_WAIT_L(0); PG8_MMA(0, 0, At, B0); PG8_BAR; PG8_SCHED;
            PG8_LDB(B1, 0, 1); PG8_STAGE(PG8_SB(0, 0), b2, voffB);
            PG8_BAR; PG8_WAIT_L(0); PG8_MMA(0, 1, At, B1); PG8_BAR;
            PG8_LDA(At, 0, 1); PG8_STAGE(PG8_SA(0, 0), a2, voffA);
            PG8_BAR; PG8_WAIT_L(0); PG8_MMA(1, 0, At, B0); PG8_BAR; PG8_SCHED;
            PG8_STAGE(PG8_SB(0, 1), b2 + hstepB, voffB);
            PG8_WAIT_V(6); PG8_BAR; PG8_MMA(1, 1, At, B1); PG8_BAR;
            PG8_LDB(B0, 1, 0); PG8_SCHED; PG8_LDA(At, 1, 0); PG8_STAGE(PG8_SA(0, 1), a2 + hstepA, voffA);
            PG8_WAIT_L(8); PG8_BAR; PG8_WAIT_L(0); PG8_MMA(0, 0, At, B0); PG8_BAR; PG8_SCHED;
            PG8_LDB(B1, 1, 1); PG8_STAGE(PG8_SB(1, 0), b3, voffB);
            PG8_BAR; PG8_WAIT_L(0); PG8_MMA(0, 1, At, B1); PG8_BAR;
            PG8_LDA(At, 1, 1); PG8_STAGE(PG8_SA(1, 0), a3, voffA);
            PG8_BAR; PG8_WAIT_L(0); PG8_MMA(1, 0, At, B0); PG8_BAR; PG8_SCHED;
            PG8_STAGE(PG8_SB(1, 1), b3 + hstepB, voffB);
            PG8_WAIT_V(6); PG8_BAR; PG8_MMA(1, 1, At, B1); PG8_BAR;
            }
        }
        if constexpr (ALIGN_EPI) { if (wr == 0) PG8_BAR; }
        { int fr2 = fr, fq2 = fq, wr2 = wr, wc2 = wc; asm volatile("" : "+v"(fr2), "+v"(fq2), "+v"(wr2), "+v"(wc2)); E(acc, cur, wr2, wc2, fr2, fq2); }
        if (!has_next) break;
#pragma unroll
        for (int a = 0; a < 2; ++a)
#pragma unroll
            for (int b = 0; b < 2; ++b)
#pragma unroll
                for (int m = 0; m < 4; ++m)
#pragma unroll
                    for (int n = 0; n < 2; ++n) acc[a][b][m][n] = (f32x4){0.f, 0.f, 0.f, 0.f};
        cur = nxt; cA = nA; cB = nB; ++ui;
        if constexpr (ALIGN_EPI) { if (wr == 1) PG8_BAR; }
    }
    PG8_WAIT_V(0);
    if constexpr (!ALIGN_EPI) { if (wr == 0) PG8_BAR; }
    PG8_BAR;
#undef PG8_SA
#undef PG8_SB
#undef PG8_STAGE
#undef PG8_LDA
#undef PG8_LDB
#undef PG8_MMA
#undef PG8_WAIT_V
#undef PG8_WAIT_L
#undef PG8_BAR
#undef PG8_SCHED
}

typedef int i32x4_t __attribute__((ext_vector_type(4)));
typedef int i32x8_t __attribute__((ext_vector_type(8)));
#ifdef STAMP_SEL
#ifndef GST_UNIT
#define GST_UNIT 1
#endif
#ifndef GST_NN
#define GST_NN 38
#endif
#define GSTAMP(k) do { if (g.nN == GST_NN && blockIdx.x == STAMP_BLK && threadIdx.x == 0 && ui == GST_UNIT) ((unsigned long long*)(((unsigned char* const __attribute__((address_space(4)))*)__builtin_amdgcn_kernarg_segment_ptr())[29] + WS_SMALL + 400 * 1024))[40 + (k)] = __builtin_amdgcn_s_memrealtime(); } while (0)
#else
#define GSTAMP(k) do {} while (0)
#endif
template <class Epi, bool ALIGN_EPI, bool SP2>
__device__ __forceinline__ void gemm_mfma8(LAS unsigned char* lds, const GemmDesc g, const Epi& E) {
    const UnitOrder S{g.nM, g.nN, g.nM * g.nN * g.nB, g.vG ? g.vG : (int)gridDim.x, g.vG ? g.vc : (int)blockIdx.x};
    const int tid = threadIdx.x, wid = __builtin_amdgcn_readfirstlane(tid >> 6), lane = tid & 63, wr = wid >> 2, wc = wid & 3, fr = lane & 15, fq = lane >> 4;
    int K = g.K; asm volatile("" : "+s"(K));
    const int nt = K / 128;
    unsigned voffA[2], voffB[2];
#pragma unroll
    for (int i = 0; i < 2; ++i) { int R, C; stage_rc(tid * 16 + i * 8192, R, C); voffA[i] = (unsigned)(R * g.lda + C * 2); voffB[i] = (unsigned)((Epi::PM ? perm_p(R) : R) * g.ldb + C * 2); }
    const size_t kstep = (size_t)(BK * 2);
    const size_t hstepA = (size_t)HALF * g.lda, hstepB = (size_t)HALF * g.ldb;
    const unsigned ldsw = (unsigned)wid * 1024u;
    const int aoff = lds_byte(wr * 64 + fr, fq * 8), boff = lds_byte(wc * 32 + fr, fq * 8);
#define PG8_SA(b, h) (((b) * 2 + (h)) * HTB)
#define PG8_SB(b, h) ((4 + (b) * 2 + (h)) * HTB)
#define PG8_STAGE(bufoff, gbase, voff) do { _Pragma("unroll") for (int _i = 0; _i < 2; ++_i) \
        __builtin_amdgcn_global_load_lds((const unsigned*)((const char*)(gbase) + (voff)[_i]), (LAS unsigned*)(lds + (bufoff) + ldsw + _i * 8192), 16, 0, 0); } while (0)
#define PG8_LDA(dst, b, h) do { _Pragma("unroll") for (int m = 0; m < 4; ++m) { dst[m].lo = *(const LAS i32x4_t*)(lds + PG8_SA(b, h) + aoff + m * 2048); dst[m].hi = *(const LAS i32x4_t*)(lds + PG8_SA(b, h) + aoff + m * 2048 + 1024); } } while (0)
#define PG8_LDB(dst, b, h) do { _Pragma("unroll") for (int n = 0; n < 2; ++n) { dst[n].lo = *(const LAS i32x4_t*)(lds + PG8_SB(b, h) + boff + n * 2048); dst[n].hi = *(const LAS i32x4_t*)(lds + PG8_SB(b, h) + boff + n * 2048 + 1024); } } while (0)
#define PG8_MMA(ai, bj, At, Bt) do { __builtin_amdgcn_s_setprio(1); _Pragma("unroll") for (int m = 0; m < 4; ++m) _Pragma("unroll") for (int n = 0; n < 2; ++n) \
        asm volatile("v_mfma_scale_f32_16x16x128_f8f6f4 %0, %1, %2, %0, %3, %3 op_sel_hi:[0,0,0]" : "+v"(acc[ai][bj][m][n]) : "v"(Bt[n]), "v"(At[m]), "v"(mxs)); __builtin_amdgcn_s_setprio(0); } while (0)
#define PG8_CAT(x) __builtin_shufflevector(__builtin_bit_cast(i32x4_t, x[0]), __builtin_bit_cast(i32x4_t, x[1]), 0, 1, 2, 3, 4, 5, 6, 7)
#define PG8_WAIT_V(n) asm volatile("s_waitcnt vmcnt(" #n ")" ::: "memory")
#define PG8_WAIT_L(n) asm volatile("s_waitcnt lgkmcnt(" #n ")" ::: "memory")
#define PG8_BAR __builtin_amdgcn_s_barrier()
#define PG8_SCHED __builtin_amdgcn_sched_barrier(0)
    const int mxs = 0x7F7F7F7F;
    Unit cur, nxt; int ui = 0;
    if (!S.next(0, cur)) return;
    f32x4 acc[2][2][4][2];
#pragma unroll
    for (int a = 0; a < 2; ++a)
#pragma unroll
        for (int b = 0; b < 2; ++b)
#pragma unroll
            for (int m = 0; m < 4; ++m)
#pragma unroll
                for (int n = 0; n < 2; ++n) acc[a][b][m][n] = (f32x4){0.f, 0.f, 0.f, 0.f};
    i32x8_t At[4], B0[2], B1[2];
    const char* cA = ((const char*)g.A + (size_t)cur.b * g.a_bs) + (size_t)cur.pm * 2 * hstepA; const char* cB = ((const char*)g.Bt + (size_t)cur.b * g.b_bs) + (size_t)cur.pn * 2 * hstepB;
    if constexpr (SP2) {
        PG8_STAGE(PG8_SB(0, 0), cB, voffB); PG8_STAGE(PG8_SB(0, 1), cB + hstepB, voffB); PG8_STAGE(PG8_SA(0, 0), cA, voffA); PG8_STAGE(PG8_SA(0, 1), cA + hstepA, voffA);
        if (wr == 1) PG8_BAR;
        PG8_WAIT_V(2); PG8_BAR;
        PG8_STAGE(PG8_SB(1, 0), cB + kstep, voffB); PG8_STAGE(PG8_SA(1, 0), cA + kstep, voffA); PG8_STAGE(PG8_SB(1, 1), cB + hstepB + kstep, voffB);
        PG8_WAIT_V(6); PG8_BAR;
    } else {
        PG8_STAGE(PG8_SB(0, 0), cB, voffB); PG8_STAGE(PG8_SA(0, 0), cA, voffA); PG8_STAGE(PG8_SB(0, 1), cB + hstepB, voffB); PG8_STAGE(PG8_SA(0, 1), cA + hstepA, voffA);
        if (wr == 1) PG8_BAR;
        PG8_WAIT_V(4); PG8_BAR;
        PG8_STAGE(PG8_SB(1, 0), cB + kstep, voffB); PG8_STAGE(PG8_SA(1, 0), cA + kstep, voffA); PG8_STAGE(PG8_SB(1, 1), cB + hstepB + kstep, voffB);
        PG8_WAIT_V(6); PG8_BAR;
    }
    for (;;) {
        const bool has_next = S.next(ui + 1, nxt);
        const char* nA = has_next ? ((const char*)g.A + (size_t)nxt.b * g.a_bs) + (size_t)nxt.pm * 2 * hstepA : cA; const char* nB = has_next ? ((const char*)g.Bt + (size_t)nxt.b * g.b_bs) + (size_t)nxt.pn * 2 * hstepB : cB;
        GSTAMP(0);
        for (int t = 0; t < nt; t += 2) {
            const bool last = (t == nt - 2);
            const char* a1 = cA + (size_t)(t + 1) * kstep;
            const char* a2 = last ? nA : cA + (size_t)(t + 2) * kstep; const char* b2 = last ? nB : cB + (size_t)(t + 2) * kstep;
            const char* a3 = a2 + kstep; const char* b3 = b2 + kstep;
            if constexpr (SP2) {
            PG8_LDB(B0, 0, 0); PG8_LDB(B1, 0, 1); PG8_SCHED; PG8_LDA(At, 0, 0); PG8_STAGE(PG8_SA(1, 1), a1 + hstepA, voffA);
            PG8_WAIT_V(8); PG8_WAIT_L(0); PG8_BAR; PG8_MMA(0, 0, At, B0); PG8_MMA(0, 1, At, B1); PG8_BAR; PG8_SCHED;
            PG8_LDA(At, 0, 1); PG8_STAGE(PG8_SB(0, 0), b2, voffB); PG8_STAGE(PG8_SB(0, 1), b2 + hstepB, voffB); PG8_STAGE(PG8_SA(0, 0), a2, voffA);
            PG8_WAIT_V(8); PG8_WAIT_L(0); PG8_BAR; PG8_MMA(1, 0, At, B0); PG8_MMA(1, 1, At, B1); PG8_BAR; PG8_SCHED;
            PG8_LDB(B0, 1, 0); PG8_LDB(B1, 1, 1); PG8_SCHED; PG8_LDA(At, 1, 0); PG8_STAGE(PG8_SA(0, 1), a2 + hstepA, voffA);
            PG8_WAIT_V(8); PG8_WAIT_L(0); PG8_BAR; PG8_MMA(0, 0, At, B0); PG8_MMA(0, 1, At, B1); PG8_BAR; PG8_SCHED;
            PG8_LDA(At, 1, 1); PG8_STAGE(PG8_SB(1, 0), b3, voffB); PG8_STAGE(PG8_SB(1, 1), b3 + hstepB, voffB); PG8_STAGE(PG8_SA(1, 0), a3, voffA);
            PG8_WAIT_V(8); PG8_WAIT_L(0); PG8_BAR; PG8_MMA(1, 0, At, B0); PG8_MMA(1, 1, At, B1); PG8_BAR; PG8_SCHED;
            } else {
            PG8_LDB(B0, 0, 0); PG8_SCHED; PG8_LDA(At, 0, 0); PG8_STAGE(PG8_SA(1, 1), a1 + hstepA, voffA);
            PG8_WAIT_L(8); PG8_BAR; PG8_WAIT_L(0); PG8_MMA(0, 0, At, B0); PG8_BAR; PG8_SCHED;
            PG8_LDB(B1, 0, 1); PG8_STAGE(PG8_SB(0, 0), b2, voffB);
            PG8_BAR; PG8_WAIT_L(0); PG8_MMA(0, 1, At, B1); PG8_BAR;
            PG8_LDA(At, 0, 1); PG8_STAGE(PG8_SA(0, 0), a2, voffA);
            PG8_BAR; PG8_WAIT_L(0); PG8_MMA(1, 0, At, B0); PG8_BAR; PG8_SCHED;
            PG8_STAGE(PG8_SB(0, 1), b2 + hstepB, voffB);
            PG8_WAIT_V(6); PG8_BAR; PG8_MMA(1, 1, At, B1); PG8_BAR;
            PG8_LDB(B0, 1, 0); PG8_SCHED; PG8_LDA(At, 1, 0); PG8_STAGE(PG8_SA(0, 1), a2 + hstepA, voffA);
            PG8_WAIT_L(8); PG8_BAR; PG8_WAIT_L(0); PG8_MMA(0, 0, At, B0); PG8_BAR; PG8_SCHED;
            PG8_LDB(B1, 1, 1); PG8_STAGE(PG8_SB(1, 0), b3, voffB);
            PG8_BAR; PG8_WAIT_L(0); PG8_MMA(0, 1, At, B1); PG8_BAR;
            PG8_LDA(At, 1, 1); PG8_STAGE(PG8_SA(1, 0), a3, voffA);
            PG8_BAR; PG8_WAIT_L(0); PG8_MMA(1, 0, At, B0); PG8_BAR; PG8_SCHED;
            PG8_STAGE(PG8_SB(1, 1), b3 + hstepB, voffB);
            PG8_WAIT_V(6); PG8_BAR; PG8_MMA(1, 1, At, B1); PG8_BAR;
            }
        }
        GSTAMP(1);
        if constexpr (ALIGN_EPI) { if (wr == 0) PG8_BAR; }
        asm volatile("s_nop 15\n\ts_nop 7" ::: "memory");
        { int fr2 = fr, fq2 = fq, wr2 = wr, wc2 = wc; asm volatile("" : "+v"(fr2), "+v"(fq2), "+v"(wr2), "+v"(wc2)); E(acc, cur, wr2, wc2, fr2, fq2); }
        GSTAMP(2);
        if (!has_next) break;
#pragma unroll
        for (int a = 0; a < 2; ++a)
#pragma unroll
            for (int b = 0; b < 2; ++b)
#pragma unroll
                for (int m = 0; m < 4; ++m)
#pragma unroll
                    for (int n = 0; n < 2; ++n) acc[a][b][m][n] = (f32x4){0.f, 0.f, 0.f, 0.f};
        cur = nxt; cA = nA; cB = nB; ++ui;
        if constexpr (ALIGN_EPI) { if (wr == 1) PG8_BAR; }
    }
    PG8_WAIT_V(0);
    if constexpr (!ALIGN_EPI) { if (wr == 0) PG8_BAR; }
    PG8_BAR;
#undef PG8_SA
#undef PG8_SB
#undef PG8_STAGE
#undef PG8_LDA
#undef PG8_LDB
#undef PG8_MMA
#undef PG8_WAIT_V
#undef PG8_WAIT_L
#undef PG8_BAR
#undef PG8_SCHED
}


#define EPI_ARGS const f32x4 (&acc)[2][2][4][2], const Unit& u, int wr, int wc, int fr, int fq
#define ROW_OF(ai, m) (u.pm * 256 + (ai) * 128 + wr * 64 + (m) * 16 + fr)
#define COL_OF(bj, n) (u.pn * 256 + (bj) * 128 + wc * 32 + (n) * 16 + fq * 4)
#define FOR_AI_M _Pragma("unroll") for (int ai = 0; ai < 2; ++ai) _Pragma("unroll") for (int m = 0; m < 4; ++m)
#define FOR_BJ_N _Pragma("unroll") for (int bj = 0; bj < 2; ++bj) _Pragma("unroll") for (int n = 0; n < 2; ++n)
#define FOR_BJ _Pragma("unroll") for (int bj = 0; bj < 2; ++bj)
#define COLP(bj) (u.pn * 256 + (bj) * 128 + wc * 32 + fq * 8)

DEV float sumsq4(f32x4 v) { return (v[0] * v[0] + v[1] * v[1]) + (v[2] * v[2] + v[3] * v[3]); }
DEV void row_atomic(u64* dst, int row, float s, int fq) { s += __shfl_xor(s, 16); s += __shfl_xor(s, 32); if (fq == 0) atomicAdd(dst + row, (u64)(s * 4294967296.f)); }
DEV float ssq_get(const u64* p, int row) { return (float)p[row] * 2.3283064365386963e-10f; }

#define ACM f32x4 (&acm)[2][2][4][2] = const_cast<f32x4 (&)[2][2][4][2]>(acc)
#define FOR_AI _Pragma("unroll") for (int ai = 0; ai < 2; ++ai)
#define FOR_M _Pragma("unroll") for (int m = 0; m < 4; ++m)
#define FOR_AI_MH _Pragma("unroll") for (int ai = 0; ai < 2; ++ai) _Pragma("unroll") for (int mh = 0; mh < 4; mh += 2)
#define FOR_M2 _Pragma("unroll") for (int m = mh; m < mh + 2; ++m)
#define FENCE __builtin_amdgcn_sched_barrier(0)
#define PIN(x) asm volatile("" : "+v"(x))
#define GLD(T, base, boff) (*(const T*)((const char*)(base) + (boff)))
#define GST(T, base, boff) (*(T*)((char*)(base) + (boff)))
#define ROWB(ai, m) ((unsigned)(ROW_OF(ai, m) * DM))
struct EpiIn { static constexpr int PM = 1;
    const float* ssq0; const float* rope; const float* b_gate;
    bf16_t *cq, *kpe, *xr, *gy; u64 *ssqq; float oscale;
    DEV void operator()(EPI_ARGS) const {
        const int pn = u.pn;
        float rs[2][4];
        FOR_AI_M rs[ai][m] = ssq0[ROW_OF(ai, m)];
        FOR_AI_M rs[ai][m] = rsqrtf(rs[ai][m] * (1.f / DM) + EPS) * oscale;
        if (pn < 5) {
            FENCE;
            FOR_AI_M { const int row = ROW_OF(ai, m); float s = 0.f;
                const size_t ro = pn < 3 ? (size_t)row * QL : (size_t)6 * 1024 * 1024 + (size_t)row * KVL - 768;
                FOR_BJ { const f32x4 v0 = acc[ai][bj][m][0] * rs[ai][m], v1 = acc[ai][bj][m][1] * rs[ai][m]; s += sumsq4(v0) + sumsq4(v1); *(u32x4*)(cq + ro + COLP(bj)) = pk8(v0, v1); }
                row_atomic(ssqq + (pn < 3 ? 0 : 8192), row, s, fq); FENCE; }
        } else if (pn == 5) {
            if (wc < 2) {
                f32x2 cc_[4], cn_[4];
#pragma unroll
                for (int i = 0; i < 4; ++i) cc_[i] = GLD(f32x2, rope, (unsigned)((ROW_OF(0, 0) * 32 + 16 * wc + 4 * fq + i) * 8));
#pragma unroll
                for (int k = 0; k < 8; ++k) { const int ai = k >> 2, m = k & 3;
                    if (k < 7) {
#pragma unroll
                        for (int i = 0; i < 4; ++i) cn_[i] = GLD(f32x2, rope, (unsigned)((ROW_OF((k + 1) >> 2, (k + 1) & 3) * 32 + 16 * wc + 4 * fq + i) * 8)); }
                    FENCE;
                    { const int row = ROW_OF(ai, m); const f32x4 x1 = acc[ai][0][m][0] * rs[ai][m], x2 = acc[ai][0][m][1] * rs[ai][m]; f32x4 o1, o2;
#pragma unroll
                      for (int i = 0; i < 4; ++i) { o1[i] = x1[i] * cc_[i].x - x2[i] * cc_[i].y; o2[i] = x2[i] * cc_[i].x + x1[i] * cc_[i].y; }
                      *(u32x4*)(kpe + (size_t)row * 64 + 32 * wc + 8 * fq) = pk8(o1, o2); }
                    FENCE;
#pragma unroll
                    for (int i = 0; i < 4; ++i) cc_[i] = cn_[i]; } }
        } else {
            const int seg = (pn - 6) >> 3;
            bf16_t* dst = seg == 0 ? xr : gy + (size_t)(seg - 1) * (16 * 1024 * 1024);
            const int colb = (pn - 6 - 8 * seg) * 256 + wc * 32 + fq * 8;
            f32x4 bb[2][2];
            FOR_BJ_N bb[bj][n] = (f32x4){0.f, 0.f, 0.f, 0.f};
            if (seg >= 2) { FOR_BJ_N bb[bj][n] = *(const f32x4*)(b_gate + (seg - 2) * DM + colb + bj * 128 + 4 * n); }
            FENCE;
            FOR_AI_M { const int row = ROW_OF(ai, m);
                FOR_BJ { const int col = colb + bj * 128; f32x4 v[2];
#pragma unroll
                    for (int n = 0; n < 2; ++n) { v[n] = acc[ai][bj][m][n] * rs[ai][m];
                        if (seg == 1) { v[n][0] = gelu_tanh(v[n][0]); v[n][1] = gelu_tanh(v[n][1]); v[n][2] = gelu_tanh(v[n][2]); v[n][3] = gelu_tanh(v[n][3]); }
                        if (seg >= 2) { v[n][0] = sigmoidf_(v[n][0] + bb[bj][n][0]); v[n][1] = sigmoidf_(v[n][1] + bb[bj][n][1]); v[n][2] = sigmoidf_(v[n][2] + bb[bj][n][2]); v[n][3] = sigmoidf_(v[n][3] + bb[bj][n][3]); } }
                    *(u32x4*)(dst + (size_t)row * DM + col) = pk8(v[0], v[1]); }
                FENCE; }
        }
    }
};
struct EpiQ { static constexpr int PM = 1;
    const u64* ssqq; const float* rope; bf16_t *qn, *qp;
    DEV void operator()(EPI_ARGS) const {
        float rs[2][4];
        FOR_AI_M rs[ai][m] = ssq_get(ssqq, ROW_OF(ai, m));
        FOR_AI_M rs[ai][m] = rsqrtf(rs[ai][m] * (1.f / QL) + EPS);
        if (u.pn < 8) {
            FENCE;
            FOR_AI_M { const int row = ROW_OF(ai, m);
                FOR_BJ { *(u32x4*)(qn + (size_t)row * DM + COLP(bj)) = pk8(acc[ai][bj][m][0] * rs[ai][m], acc[ai][bj][m][1] * rs[ai][m]); } FENCE; }
        } else {
            const int g = wc & 1;
            f32x2 cc_[4], cn_[4];
#pragma unroll
            for (int i = 0; i < 4; ++i) cc_[i] = GLD(f32x2, rope, (unsigned)((ROW_OF(0, 0) * 32 + 16 * g + 4 * fq + i) * 8));
#pragma unroll
            for (int k = 0; k < 8; ++k) { const int ai = k >> 2, m = k & 3;
                if (k < 7) {
#pragma unroll
                    for (int i = 0; i < 4; ++i) cn_[i] = GLD(f32x2, rope, (unsigned)((ROW_OF((k + 1) >> 2, (k + 1) & 3) * 32 + 16 * g + 4 * fq + i) * 8)); }
                FENCE;
                { const int row = ROW_OF(ai, m);
#pragma unroll
                  for (int bj = 0; bj < 2; ++bj) { const f32x4 x1 = acc[ai][bj][m][0] * rs[ai][m], x2 = acc[ai][bj][m][1] * rs[ai][m]; f32x4 o1, o2;
#pragma unroll
                      for (int i = 0; i < 4; ++i) { o1[i] = x1[i] * cc_[i].x - x2[i] * cc_[i].y; o2[i] = x2[i] * cc_[i].x + x1[i] * cc_[i].y; }
                      const int col = (u.pn - 8) * 256 + bj * 128 + wc * 32 + fq * 8; *(u32x4*)(qp + (size_t)row * 1024 + col) = pk8(o1, o2); } }
                FENCE;
#pragma unroll
                for (int i = 0; i < 4; ++i) cc_[i] = cn_[i]; }
        }
    }
};
struct EpiKV { static constexpr int PM = 1;
    const u64* ssqkv; bf16_t *kn, *vv;
    DEV void operator()(EPI_ARGS) const {
        float rs[2][4];
        FOR_AI_M rs[ai][m] = ssq_get(ssqkv, ROW_OF(ai, m));
        FOR_AI_M rs[ai][m] = rsqrtf(rs[ai][m] * (1.f / KVL) + EPS);
        FENCE;
        FOR_AI_M {
            const int row = ROW_OF(ai, m);
            FOR_BJ { bf16_t* dst = bj == 0 ? kn : vv; *(u32x4*)(dst + (size_t)row * DM + u.pn * 128 + wc * 32 + fq * 8) = pk8(acc[ai][bj][m][0] * rs[ai][m], acc[ai][bj][m][1] * rs[ai][m]); }
        }
    }
};
struct EpiGates { static constexpr int PM = 1;
    const float *b_a, *b_x, *n8sp; const bf16_t* xc; bf16_t *la, *gx;
    DEV void operator()(EPI_ARGS) const {
        const int c0 = u.b * 128 + wc * 32 + fq * 8;
        f32x4 ba[2], bx[2], sp[2]; u32x4 xraw[2][4];
#pragma unroll
        for (int n = 0; n < 2; ++n) { ba[n] = *(const f32x4*)(b_a + c0 + 4 * n); bx[n] = *(const f32x4*)(b_x + c0 + 4 * n); sp[n] = *(const f32x4*)(n8sp + c0 + 4 * n); }
        FOR_AI_M xraw[ai][m] = *(const u32x4*)(xc + (size_t)ROW_OF(ai, m) * DM + c0);
        FENCE;
        FOR_AI_M {
            const int row = ROW_OF(ai, m);
            f32x4 lv[2], gv[2];
#pragma unroll
            for (int n = 0; n < 2; ++n) {
                const f32x4 xv = n == 0 ? unpk4lo(xraw[ai][m]) : unpk4hi(xraw[ai][m]);
                f32x4 l, g;
#pragma unroll
                for (int i = 0; i < 4; ++i) { const float r = sigmoidf_(acc[ai][0][m][n][i] + ba[n][i]), ig = sigmoidf_(acc[ai][1][m][n][i] + bx[n][i]); const float lg = sp[n][i] * r, x2 = 2.f * lg;
                    const float em1 = (x2 > -0.02f) ? x2 * (1.f + x2 * (0.5f + x2 * (1.f / 6.f))) : (__expf(x2) - 1.f);
                    l[i] = lg * 1.4426950408889634f; g[i] = (row == 0 ? 1.f : sqrtf(fmaxf(-em1, 0.f))) * (ig * xv[i]); }
                lv[n] = l; gv[n] = g; }
            *(u32x4*)(la + (size_t)row * DM + c0) = pk8(lv[0], lv[1]); *(u32x4*)(gx + (size_t)row * DM + c0) = pk8(gv[0], gv[1]);
        }
    }
};
struct EpiMixA { static constexpr int PM = 1; const bf16_t* ga; bf16_t* mixa;
    DEV void operator()(EPI_ARGS) const { ACM; const unsigned cb = (unsigned)(u.pn * 256 + wc * 32 + fq * 8);
        FOR_AI_MH { u32x4 gv[4][2];
            FOR_M2 { const unsigned bo = (ROWB(ai, m) + cb) * 2u; FOR_BJ gv[m][bj] = GLD(u32x4, ga, bo + bj * 256); }
            FOR_M2 FOR_BJ { acm[ai][bj][m][0] = acc[ai][bj][m][0] * (1.f / (O_SCALE * WIN_SCALE)) * unpk4lo(gv[m][bj]); acm[ai][bj][m][1] = acc[ai][bj][m][1] * (1.f / (O_SCALE * WIN_SCALE)) * unpk4hi(gv[m][bj]); PIN(acm[ai][bj][m][0]); PIN(acm[ai][bj][m][1]); }
            FENCE; }
        FOR_AI_M { const unsigned bo = (ROWB(ai, m) + cb) * 2u; FOR_BJ { GST(u32x4, mixa, bo + bj * 256) = pk8(acm[ai][bj][m][0], acm[ai][bj][m][1]); } } } };
struct EpiMix { static constexpr int PM = 1; const bf16_t* gr; const bf16_t* mixa; unsigned char* mix;
    DEV void operator()(EPI_ARGS) const { ACM; const unsigned cb = (unsigned)(u.pn * 256 + wc * 32 + fq * 8);
        FOR_AI_MH { u32x4 ma[4][2], gv[4][2];
            FOR_M2 { const unsigned bo = (ROWB(ai, m) + cb) * 2u; FOR_BJ { ma[m][bj] = GLD(u32x4, mixa, bo + bj * 256); gv[m][bj] = GLD(u32x4, gr, bo + bj * 256); } }
            FOR_M2 FOR_BJ { acm[ai][bj][m][0] = (unpk4lo(ma[m][bj]) + acc[ai][bj][m][0] * (1.f / (Y_SCALE * WIN_SCALE)) * unpk4lo(gv[m][bj])) * MIX_SCALE;
                            acm[ai][bj][m][1] = (unpk4hi(ma[m][bj]) + acc[ai][bj][m][1] * (1.f / (Y_SCALE * WIN_SCALE)) * unpk4hi(gv[m][bj])) * MIX_SCALE; PIN(acm[ai][bj][m][0]); PIN(acm[ai][bj][m][1]); }
            FENCE; }
        FOR_AI_M { const unsigned bo = ROWB(ai, m) + cb; FOR_BJ { GST(u32x2, mix, bo + bj * 128) = (u32x2){f8pack(acm[ai][bj][m][0]), f8pack(acm[ai][bj][m][1])}; } } } };
struct EpiOut { static constexpr int PM = 1; const float* x; bf16_t* h1b; u64* ssq1;
    DEV void operator()(EPI_ARGS) const { const unsigned cb = (unsigned)(u.pn * 256 + wc * 32 + fq * 8);
        f32x4 xc_[2][2], xn_[2][2];
        { const unsigned bo = (ROWB(0, 0) + cb) * 4u; FOR_BJ { xc_[bj][0] = GLD(f32x4, x, bo + bj * 512); xc_[bj][1] = GLD(f32x4, x, bo + bj * 512 + 16); } }
#pragma unroll
        for (int k = 0; k < 8; ++k) { const int ai = k >> 2, m = k & 3;
            if (k < 7) { const unsigned bo = (ROWB((k + 1) >> 2, (k + 1) & 3) + cb) * 4u; FOR_BJ { xn_[bj][0] = GLD(f32x4, x, bo + bj * 512); xn_[bj][1] = GLD(f32x4, x, bo + bj * 512 + 16); } }
            FENCE;
            { const int row = ROW_OF(ai, m); float s = 0.f; const unsigned bo = (ROWB(ai, m) + cb) * 2u;
              FOR_BJ { const f32x4 v0 = xc_[bj][0] + acc[ai][bj][m][0] * (1.f / (MIX_SCALE * WIN_SCALE)), v1 = xc_[bj][1] + acc[ai][bj][m][1] * (1.f / (MIX_SCALE * WIN_SCALE));
                  s += sumsq4(v0) + sumsq4(v1); GST(u32x4, h1b, bo + bj * 256) = pk8(v0, v1); }
              row_atomic(ssq1, row, s, fq); }
            FENCE;
            FOR_BJ { xc_[bj][0] = xn_[bj][0]; xc_[bj][1] = xn_[bj][1]; } } } };
struct EpiPeerQ { static constexpr int PM = 0; const u64* ssq1; bf16_t* q;
    DEV void operator()(EPI_ARGS) const { FOR_AI_M { const int row = ROW_OF(ai, m); const float rs = rsqrtf(ssq_get(ssq1, row) * (1.f / DM) + EPS);
        FOR_BJ_N { *(u32x2*)(q + (size_t)row * DM + COL_OF(bj, n)) = pk4(acc[ai][bj][m][n] * rs); } } } };
struct EpiPlain { static constexpr int PM = 1; bf16_t* o;
    DEV void operator()(EPI_ARGS) const { FOR_AI_M { const int row = ROW_OF(ai, m); FOR_BJ { *(u32x4*)(o + (size_t)row * DM + COLP(bj)) = pk8(acc[ai][bj][m][0], acc[ai][bj][m][1]); } } } };
struct EpiScores { static constexpr int PM = 0; float* sc; const u64* ssq1;
    DEV void operator()(EPI_ARGS) const {
        float rs[2][4];
        FOR_AI_M rs[ai][m] = ssq_get(ssq1, ROW_OF(ai, m));
        FOR_AI_M rs[ai][m] = rsqrtf(rs[ai][m] * (1.f / DM) + EPS);
        FENCE;
        FOR_AI_M { const int row = ROW_OF(ai, m);
        const unsigned i0 = (unsigned)((((row >> 5) * 16 + u.pn * 2) * 128 + wc * 32 + fq * 4) * 32 + (row & 31));
#pragma unroll
        for (int bj = 0; bj < 2; ++bj)
#pragma unroll
            for (int n = 0; n < 2; ++n) { const f32x4 v = acc[ai][bj][m][n] * rs[ai][m]; const unsigned i1 = i0 + bj * 4096 + n * 512; sc[i1] = v[0]; sc[i1 + 32] = v[1]; sc[i1 + 64] = v[2]; sc[i1 + 96] = v[3]; }
        FENCE; } } };
struct EpiWf { static constexpr int PM = 1; bf16_t* o;
    DEV void operator()(EPI_ARGS) const { FOR_AI_M { const int row = u.b * 256 + ai * 128 + wr * 64 + m * 16 + fr; FOR_BJ { *(u32x4*)(o + (size_t)row * DM + COLP(bj)) = pk8(acc[ai][bj][m][0], acc[ai][bj][m][1]); } } } };
struct EpiPle { static constexpr int PM = 0; const bf16_t* pp; const bf16_t* h; float* hout; u64* ssq3; const float* ssq2;
    DEV void operator()(EPI_ARGS) const {
        const unsigned cb = (unsigned)(u.pn * 256 + wc * 32 + fq * 4);
        float rs2[2][4];
        FOR_AI_M rs2[ai][m] = ssq2[ROW_OF(ai, m)];
        FOR_AI_M rs2[ai][m] = rsqrtf(rs2[ai][m] * (1.f / DM) + EPS) * (1.f / (WIN_SCALE * X_SCALE));
        u32x2 pc_[2][2], hc_[2][2], pn_[2][2], hn_[2][2];
        { const unsigned bo = (ROWB(0, 0) + cb) * 2u; FOR_BJ_N { pc_[bj][n] = GLD(u32x2, pp, bo + bj * 256 + n * 32); hc_[bj][n] = GLD(u32x2, h, bo + bj * 256 + n * 32); } }
#pragma unroll
        for (int k = 0; k < 8; ++k) { const int ai = k >> 2, m = k & 3;
            if (k < 7) { const unsigned bo = (ROWB((k + 1) >> 2, (k + 1) & 3) + cb) * 2u; FOR_BJ_N { pn_[bj][n] = GLD(u32x2, pp, bo + bj * 256 + n * 32); hn_[bj][n] = GLD(u32x2, h, bo + bj * 256 + n * 32); } }
            FENCE;
            { const int row = ROW_OF(ai, m); float s = 0.f; const unsigned bo = (ROWB(ai, m) + cb) * 4u;
              FOR_BJ_N { const f32x4 a = acc[ai][bj][m][n] * rs2[ai][m], p4 = unpk4(pc_[bj][n]); f32x4 v = unpk4(hc_[bj][n]);
                  v[0] += sigmoidf_(a[0]) * p4[0]; v[1] += sigmoidf_(a[1]) * p4[1]; v[2] += sigmoidf_(a[2]) * p4[2]; v[3] += sigmoidf_(a[3]) * p4[3]; s += sumsq4(v);
                  GST(f32x4, hout, bo + bj * 512 + n * 64) = v; }
              row_atomic(ssq3, row, s, fq); }
            FENCE;
            FOR_BJ_N { pc_[bj][n] = pn_[bj][n]; hc_[bj][n] = hn_[bj][n]; } } } };
struct EpiPleFinal { static constexpr int PM = 0; const bf16_t* pp; const bf16_t* h; float* out; u64* ssq3; const float* ssq2; const float* fn; unsigned* pcnt;
    DEV void operator()(EPI_ARGS) const { ACM;
        const unsigned cb = (unsigned)(u.pn * 256 + wc * 32 + fq * 4);
        float rs2[2][4];
        FOR_AI_M rs2[ai][m] = ssq2[ROW_OF(ai, m)];
        FOR_AI_M rs2[ai][m] = rsqrtf(rs2[ai][m] * (1.f / DM) + EPS) * (1.f / (WIN_SCALE * X_SCALE));
        u32x2 pc_[2][2], hc_[2][2], pn_[2][2], hn_[2][2];
        { const unsigned bo = (ROWB(0, 0) + cb) * 2u; FOR_BJ_N { pc_[bj][n] = GLD(u32x2, pp, bo + bj * 256 + n * 32); hc_[bj][n] = GLD(u32x2, h, bo + bj * 256 + n * 32); } }
#pragma unroll
        for (int k = 0; k < 8; ++k) { const int ai = k >> 2, m = k & 3;
            if (k < 7) { const unsigned bo = (ROWB((k + 1) >> 2, (k + 1) & 3) + cb) * 2u; FOR_BJ_N { pn_[bj][n] = GLD(u32x2, pp, bo + bj * 256 + n * 32); hn_[bj][n] = GLD(u32x2, h, bo + bj * 256 + n * 32); } }
            FENCE;
            { const int row = ROW_OF(ai, m); float s = 0.f;
              FOR_BJ_N { const f32x4 a = acm[ai][bj][m][n] * rs2[ai][m], p4 = unpk4(pc_[bj][n]); f32x4 v = unpk4(hc_[bj][n]);
                  v[0] += sigmoidf_(a[0]) * p4[0]; v[1] += sigmoidf_(a[1]) * p4[1]; v[2] += sigmoidf_(a[2]) * p4[2]; v[3] += sigmoidf_(a[3]) * p4[3]; s += sumsq4(v);
                  acm[ai][bj][m][n] = v; }
              row_atomic(ssq3, row, s, fq); }
            FENCE;
            FOR_BJ_N { pc_[bj][n] = pn_[bj][n]; hc_[bj][n] = hn_[bj][n]; } }
        asm volatile("s_waitcnt vmcnt(0)" ::: "memory");
        __syncthreads();
        if (threadIdx.x == 0) {
            unsigned* c_ = pcnt + 64 * u.pm;
            __hip_atomic_fetch_add(c_, 1u, __ATOMIC_RELAXED, __HIP_MEMORY_SCOPE_AGENT);
            unsigned sp_ = 0;
            while (__hip_atomic_load(c_, __ATOMIC_RELAXED, __HIP_MEMORY_SCOPE_AGENT) < 8u) { __builtin_amdgcn_s_sleep(1); if (++sp_ > (1u << 20)) break; }
            __builtin_amdgcn_fence(__ATOMIC_ACQUIRE, "agent");
            asm volatile("s_waitcnt vmcnt(0)" ::: "memory");
        }
        __syncthreads();
        float rs[2][4]; f32x4 fnv[2][2];
        FOR_BJ_N fnv[bj][n] = *(const f32x4*)(fn + COL_OF(bj, n));
        FOR_AI_M rs[ai][m] = (float)__hip_atomic_load(ssq3 + ROW_OF(ai, m), __ATOMIC_RELAXED, __HIP_MEMORY_SCOPE_AGENT);
        FOR_AI_M rs[ai][m] = rsqrtf(rs[ai][m] * 2.3283064365386963e-10f * (1.f / DM) + EPS);
        FENCE;
        FOR_AI_M { const unsigned bo = (ROWB(ai, m) + cb) * 4u;
            FOR_BJ_N { GST(f32x4, out, bo + bj * 512 + n * 64) = acm[ai][bj][m][n] * rs[ai][m] * fnv[bj][n]; } FENCE; }
    }
};

DEV void attn_simple(float* lds, const bf16_t* qn, const bf16_t* qp, const bf16_t* kn, const bf16_t* kpe, const bf16_t* vv, bf16_t* o_out) {
    const int tid = threadIdx.x, sub = tid & 7, rloc = tid >> 3;
    float* Ks = lds;
    float* Vs = lds + 32 * 196;
    const int nunits = NH * (S / 64);
    for (int ui = blockIdx.x; ui < nunits; ui += gridDim.x) {
        const int h = ui & 15, qb = (S / 64 - 1) - (ui >> 4);
        const int t = qb * 64 + rloc;
        float q[24];
        { const u32x4 a = *(const u32x4*)(qn + (size_t)t * DM + h * 128 + sub * 16), b = *(const u32x4*)(qn + (size_t)t * DM + h * 128 + sub * 16 + 8);
          const u32x4 c = *(const u32x4*)(qp + (size_t)t * 1024 + h * 64 + sub * 8);
          q[0] = bflo(a.x); q[1] = bfhi(a.x); q[2] = bflo(a.y); q[3] = bfhi(a.y); q[4] = bflo(a.z); q[5] = bfhi(a.z); q[6] = bflo(a.w); q[7] = bfhi(a.w);
          q[8] = bflo(b.x); q[9] = bfhi(b.x); q[10] = bflo(b.y); q[11] = bfhi(b.y); q[12] = bflo(b.z); q[13] = bfhi(b.z); q[14] = bflo(b.w); q[15] = bfhi(b.w);
          q[16] = bflo(c.x); q[17] = bfhi(c.x); q[18] = bflo(c.y); q[19] = bfhi(c.y); q[20] = bflo(c.z); q[21] = bfhi(c.z); q[22] = bflo(c.w); q[23] = bfhi(c.w); }
        float o[16];
#pragma unroll
        for (int i = 0; i < 16; ++i) o[i] = 0.f;
        float mrun = -1e30f, l = 0.f;
        const int ntiles = 2 * qb + 2;
        for (int kt = 0; kt < ntiles; ++kt) {
            __syncthreads();
            {
                const int key = tid >> 4, c8 = (tid & 15) * 8; const size_t tk = (size_t)(kt * 32 + key);
                const u32x4 a = *(const u32x4*)(kn + tk * DM + h * 128 + c8), b = *(const u32x4*)(vv + tk * DM + h * 128 + c8);
                float* kd = Ks + key * 196 + c8; float* vd = Vs + key * 132 + c8;
                *(f32x4*)kd = (f32x4){bflo(a.x), bfhi(a.x), bflo(a.y), bfhi(a.y)}; *(f32x4*)(kd + 4) = (f32x4){bflo(a.z), bfhi(a.z), bflo(a.w), bfhi(a.w)};
                *(f32x4*)vd = (f32x4){bflo(b.x), bfhi(b.x), bflo(b.y), bfhi(b.y)}; *(f32x4*)(vd + 4) = (f32x4){bflo(b.z), bfhi(b.z), bflo(b.w), bfhi(b.w)};
                if (tid < 256) { const int key2 = tid >> 3, d8 = (tid & 7) * 8; const u32x4 c = *(const u32x4*)(kpe + (size_t)(kt * 32 + key2) * 64 + d8);
                    float* pd = Ks + key2 * 196 + 128 + d8;
                    *(f32x4*)pd = (f32x4){bflo(c.x), bfhi(c.x), bflo(c.y), bfhi(c.y)}; *(f32x4*)(pd + 4) = (f32x4){bflo(c.z), bfhi(c.z), bflo(c.w), bfhi(c.w)}; }
            }
            __syncthreads();
#pragma unroll 1
            for (int j0 = 0; j0 < 32; j0 += 8) {
                float sc[8]; float tmax = -1e30f;
#pragma unroll
                for (int jj = 0; jj < 8; ++jj) {
                    const float* kr = Ks + (j0 + jj) * 196;
                    float p = 0.f;
#pragma unroll
                    for (int d4 = 0; d4 < 4; ++d4) { const f32x4 kv = *(const f32x4*)(kr + sub * 16 + d4 * 4); p += (q[d4 * 4] * kv[0] + q[d4 * 4 + 1] * kv[1]) + (q[d4 * 4 + 2] * kv[2] + q[d4 * 4 + 3] * kv[3]); }
#pragma unroll
                    for (int d4 = 0; d4 < 2; ++d4) { const f32x4 kv = *(const f32x4*)(kr + 128 + sub * 8 + d4 * 4); p += (q[16 + d4 * 4] * kv[0] + q[17 + d4 * 4] * kv[1]) + (q[18 + d4 * 4] * kv[2] + q[19 + d4 * 4] * kv[3]); }
                    p += __shfl_xor(p, 1); p += __shfl_xor(p, 2); p += __shfl_xor(p, 4);
                    if (kt * 32 + j0 + jj > t) p = -__builtin_inff();
                    sc[jj] = p; tmax = fmaxf(tmax, p);
                }
                const float mn = fmaxf(mrun, tmax), alpha = exp2f(mrun - mn); mrun = mn;
                l *= alpha;
#pragma unroll
                for (int i = 0; i < 16; ++i) o[i] *= alpha;
#pragma unroll
                for (int jj = 0; jj < 8; ++jj) {
                    const float p = exp2f(sc[jj] - mn); l += p;
                    const float* vr = Vs + (j0 + jj) * 132 + sub * 16;
#pragma unroll
                    for (int d4 = 0; d4 < 4; ++d4) { const f32x4 v4 = *(const f32x4*)(vr + d4 * 4); o[d4 * 4] += p * v4[0]; o[d4 * 4 + 1] += p * v4[1]; o[d4 * 4 + 2] += p * v4[2]; o[d4 * 4 + 3] += p * v4[3]; }
                }
            }
        }
        const float il = 1.f / l;
        u32x4 w0, w1;
        w0.x = pk2(o[0] * il, o[1] * il); w0.y = pk2(o[2] * il, o[3] * il); w0.z = pk2(o[4] * il, o[5] * il); w0.w = pk2(o[6] * il, o[7] * il);
        w1.x = pk2(o[8] * il, o[9] * il); w1.y = pk2(o[10] * il, o[11] * il); w1.z = pk2(o[12] * il, o[13] * il); w1.w = pk2(o[14] * il, o[15] * il);
        *(u32x4*)(o_out + (size_t)t * DM + h * 128 + sub * 16) = w0; *(u32x4*)(o_out + (size_t)t * DM + h * 128 + sub * 16 + 8) = w1;
    }
}


typedef short s16x4 __attribute__((ext_vector_type(4)));
typedef float f32x16 __attribute__((ext_vector_type(16)));
constexpr int AT_SHM_V = 64 * 128 * 2, AT_SHM_K = 64 * 128 * 2, AT_SHM_P = 64 * 64 * 2;
constexpr int AT_V = 0, AT_K = 2 * AT_SHM_V, AT_P = AT_K + 2 * AT_SHM_K, AT_WS = AT_P + 2 * AT_SHM_P, AT_LDS = AT_WS + 8 * 64 * 4;
#define KSWZ(row, colB) ((row) * 256 + ((colB) ^ (((row) & 7) << 4)))
#define PSWZ(row, ch) ((row) * 128 + ((((ch) ^ (((row) >> 1) & 7))) << 4))
#define SBAR() __builtin_amdgcn_sched_barrier(0)
DEV int v_st(int k, int c) { const int kk = (k & ~0xC) | ((k & 4) << 1) | ((k & 8) >> 1); return ((kk >> 3) * 4 + (c >> 5)) * 512 + ((kk & 7) * 32 + (c & 31)) * 2; }
DEV int v_rd_base(int lane) { return ((lane & 3) << 3) | (((lane >> 2) & 3) << 6) | (((lane >> 4) & 1) << 5) | (((lane >> 5) & 1) << 8); }
constexpr int v_rd_off(int d0, int ks, int half) { return d0 * 512 + ks * 4096 + half * 2048; }
DEV int crow(int r, int hi) { return (r & 3) + 8 * (r >> 2) + 4 * hi; }
DEV unsigned cvtpk(float lo, float hi) { unsigned r; asm volatile("v_cvt_pk_bf16_f32 %0, %1, %2" : "=v"(r) : "v"(lo), "v"(hi)); return r; }
DEV void at_mask(f32x16& p0, f32x16& p1, int dq) {
    const float NEG = -__builtin_inff();
#pragma unroll
    for (int r = 0; r < 16; ++r) { const int c = (r & 3) + 8 * (r >> 2); if (dq - c < 0) p0[r] = NEG; if (dq - c - 32 < 0) p1[r] = NEG; }
}
constexpr float AT_THR = 11.5f;
DEV void at_partialSM(f32x16& p0, f32x16& p1, float& m_reg, float& alpha) {
    float pmax = p0[0];
#pragma unroll
    for (int r = 1; r < 16; ++r) pmax = fmaxf(pmax, p0[r]);
#pragma unroll
    for (int r = 0; r < 16; ++r) pmax = fmaxf(pmax, p1[r]);
    { auto rr = __builtin_amdgcn_permlane32_swap(__float_as_uint(pmax), __float_as_uint(pmax), false, false); pmax = fmaxf(__uint_as_float(rr[0]), __uint_as_float(rr[1])); }
    float mn;
    if (__builtin_expect(__all((pmax - m_reg) <= AT_THR), 1)) { mn = m_reg; alpha = 1.f; }
    else { mn = fmaxf(m_reg, pmax); alpha = __builtin_amdgcn_exp2f(m_reg - mn); m_reg = mn; }
#pragma unroll
    for (int r = 0; r < 16; ++r) { p0[r] = __builtin_amdgcn_exp2f(p0[r] - mn); p1[r] = __builtin_amdgcn_exp2f(p1[r] - mn); }
}
DEV void at_finishSM(const f32x16& p0, const f32x16& p1, float alpha, float& l_reg, bf16x8& pa0, bf16x8& pa1, bf16x8& pa2, bf16x8& pa3) {
    float ps = 0;
#pragma unroll
    for (int r = 0; r < 16; ++r) ps += p0[r];
#pragma unroll
    for (int r = 0; r < 16; ++r) ps += p1[r];
    { auto rr = __builtin_amdgcn_permlane32_swap(__float_as_uint(ps), __float_as_uint(ps), false, false); ps = __uint_as_float(rr[0]) + __uint_as_float(rr[1]); }
    l_reg = l_reg * alpha + ps;
#define PK4(P, B_, OUT) do { unsigned a0 = cvtpk(P[B_+0], P[B_+1]), a1 = cvtpk(P[B_+2], P[B_+3]); unsigned b0 = cvtpk(P[B_+4], P[B_+5]), b1 = cvtpk(P[B_+6], P[B_+7]); \
        auto r0 = __builtin_amdgcn_permlane32_swap(a0, b0, false, false); auto r1 = __builtin_amdgcn_permlane32_swap(a1, b1, false, false); \
        u32x4 w = {r0[0], r1[0], r0[1], r1[1]}; OUT = *reinterpret_cast<bf16x8*>(&w); } while (0)
    PK4(p0, 0, pa0); PK4(p0, 8, pa1); PK4(p1, 0, pa2); PK4(p1, 8, pa3);
#undef PK4
}
template <int KB>
DEV void at_qkt(f32x16& p0, f32x16& p1, const char* lds, int r32, int hi, const bf16x8* qr) {
    p0 = f32x16{}; p1 = f32x16{};
#pragma unroll
    for (int g = 0; g < 2; ++g) {
        bf16x8 b0[4], b1[4];
#pragma unroll
        for (int dd = 0; dd < 4; ++dd) { const char* a = lds + AT_K + KB * AT_SHM_K + KSWZ(r32, (dd * 16 + hi * 8) * 2) + g * 128;
            b0[dd] = *reinterpret_cast<const bf16x8*>(a); b1[dd] = *reinterpret_cast<const bf16x8*>(a + 32 * 256); }
#pragma unroll
        for (int dd = 0; dd < 4; ++dd) { p0 = __builtin_amdgcn_mfma_f32_32x32x16_bf16(b0[dd], qr[g * 4 + dd], p0, 0, 0, 0); p1 = __builtin_amdgcn_mfma_f32_32x32x16_bf16(b1[dd], qr[g * 4 + dd], p1, 0, 0, 0); }
        SBAR();
    }
    {
        bf16x8 b0[4], b1[4];
#pragma unroll
        for (int d0 = 0; d0 < 4; ++d0) { const char* a = lds + AT_P + KB * AT_SHM_P + PSWZ(r32, 2 * d0 + hi);
            b0[d0] = *reinterpret_cast<const bf16x8*>(a); b1[d0] = *reinterpret_cast<const bf16x8*>(a + 32 * 128); }
#pragma unroll
        for (int d0 = 0; d0 < 4; ++d0) { p0 = __builtin_amdgcn_mfma_f32_32x32x16_bf16(b0[d0], qr[8 + d0], p0, 0, 0, 0); p1 = __builtin_amdgcn_mfma_f32_32x32x16_bf16(b1[d0], qr[8 + d0], p1, 0, 0, 0); }
        SBAR();
    }
}
template <int VB>
DEV void at_pv(f32x16* o, int vb0, bf16x8 pa0, bf16x8 pa1, bf16x8 pa2, bf16x8 pa3) {
#define TRRD(dst, off) asm volatile("ds_read_b64_tr_b16 %0, %1 offset:%2" : "=&v"(dst) : "v"(vb0), "i"(off) : "memory")
#define PV_D0(d0) do { s16x4 l0, l1, l2, l3, h0, h1, h2, h3; constexpr int b_ = AT_V + VB * AT_SHM_V + v_rd_off(d0, 0, 0); \
        TRRD(l0, b_); TRRD(h0, b_ + 2048); TRRD(l1, b_ + 4096); TRRD(h1, b_ + 6144); TRRD(l2, b_ + 8192); TRRD(h2, b_ + 10240); TRRD(l3, b_ + 12288); TRRD(h3, b_ + 14336); \
        asm volatile("s_waitcnt lgkmcnt(0)" ::: "memory"); SBAR(); \
        o[d0] = __builtin_amdgcn_mfma_f32_32x32x16_bf16(pa0, (bf16x8){l0[0], l0[1], l0[2], l0[3], h0[0], h0[1], h0[2], h0[3]}, o[d0], 0, 0, 0); \
        o[d0] = __builtin_amdgcn_mfma_f32_32x32x16_bf16(pa1, (bf16x8){l1[0], l1[1], l1[2], l1[3], h1[0], h1[1], h1[2], h1[3]}, o[d0], 0, 0, 0); \
        o[d0] = __builtin_amdgcn_mfma_f32_32x32x16_bf16(pa2, (bf16x8){l2[0], l2[1], l2[2], l2[3], h2[0], h2[1], h2[2], h2[3]}, o[d0], 0, 0, 0); \
        o[d0] = __builtin_amdgcn_mfma_f32_32x32x16_bf16(pa3, (bf16x8){l3[0], l3[1], l3[2], l3[3], h3[0], h3[1], h3[2], h3[3]}, o[d0], 0, 0, 0); } while (0)
    PV_D0(0); PV_D0(1); PV_D0(2); PV_D0(3);
#undef PV_D0
#undef TRRD
}
DEV void attn_unit(char* lds, int h, int qb, const bf16_t* qn, const bf16_t* qp, const bf16_t* kn, const bf16_t* kpe, const bf16_t* vv, bf16_t* o_out) {
    const int tid = threadIdx.x, wid = __builtin_amdgcn_readfirstlane(tid >> 6), lane = tid & 63, r32 = lane & 31, hi = lane >> 5;
    const int q0 = qb * 256, qlo = q0 + wid * 32, NT = 4 * (qb + 1);
    float* ws = (float*)(lds + AT_WS) + wid * 64; float* li_l = ws; float* al_l = ws + 32;
    unsigned kof[2], vof[2], pof;
#pragma unroll
    for (int i = 0; i < 2; ++i) { const int off = (wid * 2 + i) * 1024 + lane * 16;
        { const int row = off >> 8, colB = (off & 255) ^ ((row & 7) << 4); kof[i] = (unsigned)(row * DM + h * 128 + (colB >> 1)); }
        { const int sub = off >> 9, within = off & 511, kk = (sub >> 2) * 8 + (within >> 6), c = (sub & 3) * 32 + ((within & 63) >> 1);
          const int k = (kk & ~0xC) | ((kk & 4) << 1) | ((kk & 8) >> 1); vof[i] = (unsigned)(k * DM + h * 128 + c); } }
    { const int off = wid * 1024 + lane * 16, row = off >> 7, ch = ((off >> 4) & 7) ^ ((row >> 1) & 7); pof = (unsigned)(row * 64 + ch * 8); }
    const int vb0 = (int)(uintptr_t)lds + v_rd_base(lane);
    LAS unsigned char* l3 = (LAS unsigned char*)(uintptr_t)lds;
#define AT_GLDS(gp, lo) __builtin_amdgcn_global_load_lds((const unsigned*)(gp), (LAS unsigned*)(l3 + (lo)), 16, 0, 0)
#define AT_STAGE(t, B) do { const bf16_t* kt_ = kn + (size_t)(t) * 64 * DM; const bf16_t* vt_ = vv + (size_t)(t) * 64 * DM; const bf16_t* pt_ = kpe + (size_t)(t) * 64 * 64; \
        AT_GLDS(kt_ + kof[0], AT_K + (B) * AT_SHM_K + (wid * 2 + 0) * 1024); AT_GLDS(kt_ + kof[1], AT_K + (B) * AT_SHM_K + (wid * 2 + 1) * 1024); \
        AT_GLDS(vt_ + vof[0], AT_V + (B) * AT_SHM_V + (wid * 2 + 0) * 1024); AT_GLDS(vt_ + vof[1], AT_V + (B) * AT_SHM_V + (wid * 2 + 1) * 1024); \
        AT_GLDS(pt_ + pof, AT_P + (B) * AT_SHM_P + wid * 1024); } while (0)
    AT_STAGE(0, 0);
    bf16x8 qr[12];
    { const bf16_t* qrow = qn + (size_t)(qlo + r32) * DM + h * 128 + hi * 8; const bf16_t* prow = qp + (size_t)(qlo + r32) * 1024 + h * 64 + hi * 8;
#pragma unroll
      for (int d0 = 0; d0 < 8; ++d0) qr[d0] = *(const bf16x8*)(qrow + d0 * 16);
#pragma unroll
      for (int d0 = 0; d0 < 4; ++d0) qr[8 + d0] = *(const bf16x8*)(prow + d0 * 16); }
    asm volatile("s_waitcnt vmcnt(0)" ::: "memory");
    __syncthreads();
    float m_reg = -1e30f, l_reg = 0.f; f32x16 o[4] = {};
    const int qm = qlo + r32 - 4 * hi;
#define AT_STEP(t, B) do { \
        if ((t) + 1 < NT) AT_STAGE((t) + 1, (B) ^ 1); \
        f32x16 p0, p1; at_qkt<B>(p0, p1, lds, r32, hi, qr); \
        if ((t) * 64 + 63 > qlo) at_mask(p0, p1, qm - (t) * 64); \
        SBAR(); float alpha; at_partialSM(p0, p1, m_reg, alpha); SBAR(); \
        if (__any(alpha < 1.f)) { if (hi == 0) al_l[r32] = alpha; asm volatile("s_waitcnt lgkmcnt(0)" ::: "memory"); \
            _Pragma("unroll") for (int r = 0; r < 16; ++r) { const float a_ = al_l[crow(r, hi)]; o[0][r] *= a_; o[1][r] *= a_; o[2][r] *= a_; o[3][r] *= a_; if ((r & 3) == 3) SBAR(); } } \
        SBAR(); bf16x8 pa0, pa1, pa2, pa3; at_finishSM(p0, p1, alpha, l_reg, pa0, pa1, pa2, pa3); SBAR(); \
        at_pv<B>(o, vb0, pa0, pa1, pa2, pa3); \
        asm volatile("s_waitcnt vmcnt(0)" ::: "memory"); \
        __syncthreads(); } while (0)
    for (int t = 0; t < NT; t += 2) { AT_STEP(t, 0); AT_STEP(t + 1, 1); }
    if (hi == 0) li_l[r32] = l_reg; asm volatile("s_waitcnt lgkmcnt(0)" ::: "memory");
    float rli[16];
#pragma unroll
    for (int r = 0; r < 16; ++r) rli[r] = __builtin_amdgcn_rcpf(li_l[crow(r, hi)]);
    unsigned char* Ow = (unsigned char*)o_out + (size_t)qlo * DM + h * 128;
#pragma unroll
    for (int r = 0; r < 16; ++r) { const int orow = crow(r, hi);
#pragma unroll
        for (int d0 = 0; d0 < 4; ++d0) { const float v = o[d0][r] * rli[r] * O_SCALE; const float vn = __shfl_xor(v, 1);
            const unsigned w16 = __builtin_amdgcn_cvt_pk_fp8_f32(v, vn, 0u, false) & 0xffffu; const unsigned w16n = (unsigned)__shfl_xor((int)w16, 2);
            if ((r32 & 3) == 0) *(unsigned*)(Ow + (size_t)orow * DM + d0 * 32 + r32) = w16 | (w16n << 16); } }
    __syncthreads();
#undef AT_GLDS
#undef AT_STAGE
#undef AT_STEP
}
DEV void attn_mfma(char* lds, const bf16_t* qn, const bf16_t* qp, const bf16_t* kn, const bf16_t* kpe, const bf16_t* vv, bf16_t* o_out) {
    for (int it = blockIdx.x; it < 256; it += gridDim.x) {
        const int vid = (gridDim.x == 256) ? ((it & 7) * 32 + (it >> 3)) : it;
        const int h = vid >> 4, j = vid & 15;
        attn_unit(lds, h, 31 - j, qn, qp, kn, kpe, vv, o_out);
        attn_unit(lds, h, j, qn, qp, kn, kpe, vv, o_out);
    }
}

DEV void wave_argmax(float& v, int& idx) {
#pragma unroll
    for (int o = 1; o < 64; o <<= 1) { const float ov = __shfl_xor(v, o); const int oi = __shfl_xor(idx, o);
        if (ov > v || (ov == v && oi < idx)) { v = ov; idx = oi; } }
}
DEV void peer_phase(float* lds, const float* sc, const float* h1, const bf16_t* h1b, const u64* ssq1, const bf16_t* tu, const bf16_t* tv, float* h2, bf16_t* xn3) {
    const int tid = threadIdx.x, lane = tid & 63, wid = tid >> 6;
    int* ex = (int*)(lds + wid * 256);
    float* gt = lds + wid * 256 + 128;
    const float NEG = -__builtin_inff();
    for (int t = blockIdx.x * 8 + wid; t < S; t += gridDim.x * 8) {
        for (int h = 0; h < PH; ++h) {
            const float* sp = sc + (size_t)t * DM + h * 256;
            float tvv[2]; int tii[2];
#pragma unroll
            for (int c = 0; c < 2; ++c) {
                float a = sp[c * 128 + lane], b = sp[c * 128 + 64 + lane];
                float keepv = NEG; int keepi = 0;
                for (int r = 0; r < TOPK; ++r) {
                    float v; int idx; if (b > a) { v = b; idx = lane + 64; } else { v = a; idx = lane; }
                    wave_argmax(v, idx);
                    if (idx == lane) a = NEG; if (idx == lane + 64) b = NEG;
                    if (lane == r) { keepv = v; keepi = idx; }
                }
                tvv[c] = keepv; tii[c] = keepi;
            }
            const float a1 = __shfl(tvv[0], lane >> 2);
            float cv[4];
#pragma unroll
            for (int j = 0; j < 4; ++j) cv[j] = a1 + __shfl(tvv[1], (lane & 3) * 4 + j);
            float bs = NEG; int bc = 0;
            for (int r = 0; r < TOPK; ++r) {
                float v = cv[0]; int idx = lane * 4;
#pragma unroll
                for (int j = 1; j < 4; ++j) if (cv[j] > v) { v = cv[j]; idx = lane * 4 + j; }
                wave_argmax(v, idx);
                if ((idx >> 2) == lane) {
#pragma unroll
                    for (int j = 0; j < 4; ++j) if ((idx & 3) == j) cv[j] = NEG;
                }
                if (lane == r) { bs = v; bc = idx; }
            }
            const int i1 = __shfl(tii[0], bc >> 4), i2 = __shfl(tii[1], bc & 15);
            const float mx = __shfl(bs, 0);
            float e = (lane < 16) ? __expf(bs - mx) : 0.f;
            float sum = e;
#pragma unroll
            for (int o = 1; o < 16; o <<= 1) sum += __shfl_xor(sum, o);
            if (lane < 16) { ex[h * 16 + lane] = i1 * NK + i2; gt[h * 16 + lane] = e / sum; }
        }
        asm volatile("s_waitcnt lgkmcnt(0)" ::: "memory");
        const float rs1 = rsqrtf(ssq_get(ssq1, t) * (1.f / DM) + EPS);
        float hv[32];
#pragma unroll
        for (int j = 0; j < 4; ++j) { const u32x4 w = *(const u32x4*)(h1b + (size_t)t * DM + j * 512 + lane * 8);
            hv[j * 8 + 0] = bflo(w.x); hv[j * 8 + 1] = bfhi(w.x); hv[j * 8 + 2] = bflo(w.y); hv[j * 8 + 3] = bfhi(w.y);
            hv[j * 8 + 4] = bflo(w.z); hv[j * 8 + 5] = bfhi(w.z); hv[j * 8 + 6] = bflo(w.w); hv[j * 8 + 7] = bfhi(w.w); }
        float ac[32];
#pragma unroll
        for (int i = 0; i < 32; ++i) ac[i] = 0.f;
        for (int k = 0; k < PH * TOPK * DBG_PEER; ++k) {
            const int e = ex[k]; const float g = gt[k];
            const bf16_t* ur = tu + (size_t)e * DM + lane * 8; const bf16_t* vr = tv + (size_t)e * DM + lane * 8;
            u32x4 uw[4], vw[4];
#pragma unroll
            for (int j = 0; j < 4; ++j) { uw[j] = *(const u32x4*)(ur + j * 512); vw[j] = *(const u32x4*)(vr + j * 512); }
            float d = 0.f;
#pragma unroll
            for (int j = 0; j < 4; ++j) { d += hv[j * 8 + 0] * bflo(uw[j].x) + hv[j * 8 + 1] * bfhi(uw[j].x) + hv[j * 8 + 2] * bflo(uw[j].y) + hv[j * 8 + 3] * bfhi(uw[j].y)
                                             + hv[j * 8 + 4] * bflo(uw[j].z) + hv[j * 8 + 5] * bfhi(uw[j].z) + hv[j * 8 + 6] * bflo(uw[j].w) + hv[j * 8 + 7] * bfhi(uw[j].w); }
            d = wave_sum(d);
            const float w = g * gelu_tanh(d * rs1);
#pragma unroll
            for (int j = 0; j < 4; ++j) { ac[j * 8 + 0] += w * bflo(vw[j].x); ac[j * 8 + 1] += w * bfhi(vw[j].x); ac[j * 8 + 2] += w * bflo(vw[j].y); ac[j * 8 + 3] += w * bfhi(vw[j].y);
                                          ac[j * 8 + 4] += w * bflo(vw[j].z); ac[j * 8 + 5] += w * bfhi(vw[j].z); ac[j * 8 + 6] += w * bflo(vw[j].w); ac[j * 8 + 7] += w * bfhi(vw[j].w); }
        }
        float ss = 0.f;
#pragma unroll
        for (int j = 0; j < 4; ++j) { const size_t o = (size_t)t * DM + j * 512 + lane * 8;
            const f32x4 x0 = *(const f32x4*)(h1 + o), x1 = *(const f32x4*)(h1 + o + 4);
#pragma unroll
            for (int i = 0; i < 4; ++i) { ac[j * 8 + i] += x0[i]; ac[j * 8 + 4 + i] += x1[i]; }
#pragma unroll
            for (int i = 0; i < 8; ++i) ss += ac[j * 8 + i] * ac[j * 8 + i]; }
        ss = wave_sum(ss);
        const float rs2 = rsqrtf(ss * (1.f / DM) + EPS);
#pragma unroll
        for (int j = 0; j < 4; ++j) { const size_t o = (size_t)t * DM + j * 512 + lane * 8;
            *(f32x4*)(h2 + o) = (f32x4){ac[j * 8], ac[j * 8 + 1], ac[j * 8 + 2], ac[j * 8 + 3]}; *(f32x4*)(h2 + o + 4) = (f32x4){ac[j * 8 + 4], ac[j * 8 + 5], ac[j * 8 + 6], ac[j * 8 + 7]};
            u32x4 w; w.x = pk2(ac[j * 8] * rs2, ac[j * 8 + 1] * rs2); w.y = pk2(ac[j * 8 + 2] * rs2, ac[j * 8 + 3] * rs2); w.z = pk2(ac[j * 8 + 4] * rs2, ac[j * 8 + 5] * rs2); w.w = pk2(ac[j * 8 + 6] * rs2, ac[j * 8 + 7] * rs2);
            *(u32x4*)(xn3 + o) = w; }
    }
}


#define BUBBLE16(v, x) _Pragma("unroll") for (int j_ = 0; j_ < 16; ++j_) { const float hi_ = fmaxf(v[j_], x); x = fminf(v[j_], x); v[j_] = hi_; }
constexpr int PL_KEYS = 0, PL_WL = 0, PL_WTS = 16384, PL_SX = 32768, PL_SG = 49152, PL_TOT = 65536, PL_MB = 65536, PL_OFF = 67584, PL_H8 = 69888, PL_EX = 69888, PL_GT = 86272, PL_CNT = 102656, H8_STRIDE = 2112;
DEV f32x2 fp8x2(unsigned w, bool hi) { return hi ? __builtin_amdgcn_cvt_pk_f32_fp8(w, true) : __builtin_amdgcn_cvt_pk_f32_fp8(w, false); }
DEV float dot16_fp8(const float* h, u32x4 r) {
    float d = 0.f;
#pragma unroll
    for (int q = 0; q < 4; ++q) { const f32x2 lo = __builtin_amdgcn_cvt_pk_f32_fp8(r[q], false), hi2 = __builtin_amdgcn_cvt_pk_f32_fp8(r[q], true);
        d = fmaf(h[q * 4 + 0], lo.x, d); d = fmaf(h[q * 4 + 1], lo.y, d); d = fmaf(h[q * 4 + 2], hi2.x, d); d = fmaf(h[q * 4 + 3], hi2.y, d); }
    return d;
}
DEV void axpy16_fp8(float* acc, float w, u32x4 r) {
#pragma unroll
    for (int q = 0; q < 4; ++q) { const f32x2 lo = __builtin_amdgcn_cvt_pk_f32_fp8(r[q], false), hi2 = __builtin_amdgcn_cvt_pk_f32_fp8(r[q], true);
        acc[q * 4 + 0] = fmaf(w, lo.x, acc[q * 4 + 0]); acc[q * 4 + 1] = fmaf(w, lo.y, acc[q * 4 + 1]); acc[q * 4 + 2] = fmaf(w, hi2.x, acc[q * 4 + 2]); acc[q * 4 + 3] = fmaf(w, hi2.y, acc[q * 4 + 3]); }
}
#define PE_FENCE0 do { asm volatile("" ::: "memory"); __builtin_amdgcn_sched_barrier(0); } while (0)
#ifdef STAMP_SEL
#define PSTAMP(k) do { if (blockIdx.x == STAMP_BLK && threadIdx.x == 0) { ((unsigned long long*)stampp)[32 + (k)] = __builtin_amdgcn_s_memrealtime(); } } while (0)
#else
#define PSTAMP(k) do {} while (0)
#endif
DEV void peer_phase2(void* stampp, char* lds, const float* scT, const bf16_t* h1, const u64* ssq1, const unsigned char* tu8, const unsigned char* tv8, bf16_t* h2, bf16_t* xn3, float* ssq2) {
    const int tid = threadIdx.x, lane = tid & 63, wid = __builtin_amdgcn_readfirstlane(tid >> 6);
    unsigned* keys1 = (unsigned*)(lds + PL_KEYS); int* ex = (int*)(lds + PL_EX); float* gt = (float*)(lds + PL_GT); float* wts = (float*)(lds + PL_WTS) + wid * 512; int* wl = (int*)(lds + PL_WL) + wid * 512; unsigned* wpk = (unsigned*)(lds + PL_EX) + wid * 512; int* mbase = (int*)(lds + PL_MB) + wid * 64;
    int* sx = (int*)(lds + PL_SX); float* sg = (float*)(lds + PL_SG); int* cnth = (int*)(lds + PL_CNT); int* tot = (int*)(lds + PL_TOT); int* offs = (int*)(lds + PL_OFF);
    const float NEGINF = -__builtin_inff();
    for (int grp = blockIdx.x; grp < S / 32; grp += gridDim.x) {
        __syncthreads();
        PSTAMP(0);
        {
            const int tl = tid & 31, hc = tid >> 5;
            const float* sp = scT + ((size_t)(grp * 16 + hc) * 128) * 32 + tl;
            float v[16];
#pragma unroll
            for (int j = 0; j < 16; ++j) v[j] = NEGINF;
#pragma unroll 1
            for (int n0 = 0; n0 < 128; n0 += 8) {
                float sv[8];
#pragma unroll
                for (int q = 0; q < 8; ++q) sv[q] = sp[(n0 + q) * 32];
#pragma unroll
                for (int q = 0; q < 8; ++q) { float x = __uint_as_float((__float_as_uint(sv[q]) & 0xFFFFFF80u) | (unsigned)(127 - (n0 + q))); BUBBLE16(v, x); }
            }
#pragma unroll
            for (int j = 0; j < 16; ++j) keys1[(tl * 16 + hc) * 16 + j] = __float_as_uint(v[j]);
        }
        __syncthreads();
        PSTAMP(1);
        if (tid < 256) {
            const int tl = tid & 31, h = tid >> 5;
            const unsigned* ka = keys1 + (tl * 16 + 2 * h) * 16; const unsigned* kb = ka + 16;
            float a[16], b[16];
#pragma unroll
            for (int j = 0; j < 16; ++j) { a[j] = __uint_as_float(ka[j] & 0xFFFFFF80u); b[j] = __uint_as_float(kb[j] & 0xFFFFFF80u); }
            float w[16];
#pragma unroll
            for (int j = 0; j < 16; ++j) w[j] = NEGINF;
            {
                int cid = 0;
#pragma unroll
                for (int i = 0; i < 16; ++i)
#pragma unroll
                    for (int j = 0; j < 16; ++j) if ((i + 1) * (j + 1) <= 16) { float x = __uint_as_float((__float_as_uint(a[i] + b[j]) & 0xFFFFFFC0u) | (unsigned)(63 - cid)); BUBBLE16(w, x); ++cid; }
            }
            const float mx = __uint_as_float(__float_as_uint(w[0]) & 0xFFFFFFC0u);
            float e[16], sum = 0.f;
#pragma unroll
            for (int k = 0; k < 16; ++k) { e[k] = __expf(__uint_as_float(__float_as_uint(w[k]) & 0xFFFFFFC0u) - mx); sum += e[k]; }
            const float inv = 1.f / sum;
#pragma unroll
            for (int k = 0; k < 16; ++k) {
                const int cid = 63 - (int)(__float_as_uint(w[k]) & 63u);
                int i, j;
                if (cid >= 42) { i = 8 + (cid - 42); j = 0; }
                else { i = (cid >= 16) + (cid >= 24) + (cid >= 29) + (cid >= 33) + (cid >= 36) + (cid >= 38) + (cid >= 40);
                       const int st = i == 0 ? 0 : i == 1 ? 16 : i == 2 ? 24 : i == 3 ? 29 : i == 4 ? 33 : i == 5 ? 36 : i == 6 ? 38 : 40; j = cid - st; }
                const int i1 = 127 - (int)(ka[i] & 127u), i2 = 127 - (int)(kb[j] & 127u);
                ex[tl * 128 + h * 16 + k] = i1 * NK + i2; gt[tl * 128 + h * 16 + k] = e[k] * inv;
            }
            int* crow_ = cnth + (tl * 8 + h) * 16;
#pragma unroll
            for (int r = 0; r < 16; ++r) crow_[r] = 0;
            for (int k = 0; k < 16; ++k) { const int r = ex[tl * 128 + h * 16 + k] >> 10; crow_[r] = crow_[r] + 1; }
        }
        __syncthreads();
        {
            const int tl = tid & 31, r = tid >> 5;
            int t_ = 0;
#pragma unroll
            for (int h = 0; h < 8; ++h) t_ += cnth[(tl * 8 + h) * 16 + r];
            tot[tl * 16 + r] = t_;
        }
        __syncthreads();
        {
            const int tl = tid & 31, r = tid >> 5;
            int b_ = 0;
            for (int r2 = 0; r2 < r; ++r2) b_ += tot[tl * 16 + r2];
            offs[tl * 17 + r] = b_; if (r == 15) offs[tl * 17 + 16] = 128;
#pragma unroll
            for (int h = 0; h < 8; ++h) { const int c_ = cnth[(tl * 8 + h) * 16 + r]; cnth[(tl * 8 + h) * 16 + r] = b_; b_ += c_; }
        }
        __syncthreads();
        if (tid < 256) {
            const int tl = tid & 31, h = tid >> 5; int* crow_ = cnth + (tl * 8 + h) * 16;
            for (int k = 0; k < 16; ++k) { const int e_ = ex[tl * 128 + h * 16 + k]; const int r = e_ >> 10; const int p_ = crow_[r]; crow_[r] = p_ + 1; sx[tl * 128 + p_] = e_; sg[tl * 128 + p_] = gt[tl * 128 + h * 16 + k]; }
        }
        __syncthreads();
#define PE_FENCE do { asm volatile("" ::: "memory"); __builtin_amdgcn_sched_barrier(0); } while (0)
#define PE_TIE16(A, o) asm volatile("" : "+v"(A[o + 0]), "+v"(A[o + 1]), "+v"(A[o + 2]), "+v"(A[o + 3]), "+v"(A[o + 4]), "+v"(A[o + 5]), "+v"(A[o + 6]), "+v"(A[o + 7]), "+v"(A[o + 8]), "+v"(A[o + 9]), \
            "+v"(A[o + 10]), "+v"(A[o + 11]), "+v"(A[o + 12]), "+v"(A[o + 13]), "+v"(A[o + 14]), "+v"(A[o + 15]))
        PSTAMP(2);
#define PE_FENCE do { asm volatile("" ::: "memory"); __builtin_amdgcn_sched_barrier(0); } while (0)
        {
            const int tl0 = wid * 4, t0 = grp * 32 + tl0;
            {
                const int q = lane >> 4, r = lane & 15; int b_ = 0;
#pragma unroll
                for (int q2 = 0; q2 < 4; ++q2) { const int o0 = offs[(tl0 + q2) * 17 + r], o1 = offs[(tl0 + q2) * 17 + r + 1]; b_ += o0; if (q2 < q) b_ += o1 - o0; }
                mbase[lane] = b_;
            }
            asm volatile("s_waitcnt lgkmcnt(0)" ::: "memory");
#pragma unroll
            for (int q = 0; q < 4; ++q)
#pragma unroll
                for (int kk = 0; kk < 2; ++kk) { const int k = lane + 64 * kk; const int e_ = sx[(tl0 + q) * 128 + k]; const int r = e_ >> 10;
                    wl[(k - offs[(tl0 + q) * 17 + r]) + mbase[q * 16 + r]] = e_ | (k << 16) | (q << 23); }
            asm volatile("s_waitcnt lgkmcnt(0)" ::: "memory");
            float rsq[4];
#pragma unroll
            for (int q = 0; q < 4; ++q) rsq[q] = rsqrtf(ssq_get(ssq1, t0 + q) * (1.f / DM) + EPS) * (1.f / (TU_SCALE * H_SCALE));
            {
                int hq[4][8];
#pragma unroll
                for (int q = 0; q < 4; ++q)
#pragma unroll
                    for (int c = 0; c < 8; ++c) hq[q][c] = (int)q8pack(unpk4(*(const u32x2*)(h1 + (size_t)(t0 + q) * DM + (c >> 2) * 1024 + lane * 16 + (c & 3) * 4)) * H_SCALE);
                u32x4 rr[16][2]; int ent[16];
#define PE_LOAD1(j, i) do { ent[j] = __builtin_amdgcn_readfirstlane(wl[(i)]); const unsigned char* p_ = tu8 + (size_t)(ent[j] & 0x3FFF) * DM + lane * 16; \
                    rr[j][0] = *(const u32x4*)p_; rr[j][1] = *(const u32x4*)(p_ + 1024); } while (0)
#define PE_DOT(j, dj) do { int s_[4] = {0, 0, 0, 0}; _Pragma("unroll") for (int hf_ = 0; hf_ < 2; ++hf_) _Pragma("unroll") for (int w_ = 0; w_ < 4; ++w_) { const int x_ = (int)rr[j][hf_][w_]; \
                    s_[0] = __builtin_amdgcn_sdot4(x_, hq[0][hf_ * 4 + w_], s_[0], false); s_[1] = __builtin_amdgcn_sdot4(x_, hq[1][hf_ * 4 + w_], s_[1], false); \
                    s_[2] = __builtin_amdgcn_sdot4(x_, hq[2][hf_ * 4 + w_], s_[2], false); s_[3] = __builtin_amdgcn_sdot4(x_, hq[3][hf_ * 4 + w_], s_[3], false); } \
                    const int q_ = (ent[j] >> 23) & 3; d_[dj] = (float)(q_ == 0 ? s_[0] : q_ == 1 ? s_[1] : q_ == 2 ? s_[2] : s_[3]); } while (0)
#define PE_UREDUCE(i0) do { \
                    float r4_[4]; _Pragma("unroll") for (int i_ = 0; i_ < 4; ++i_) { const bool up_ = (lane & 32) != 0; const float keep_ = up_ ? d_[i_ + 4] : d_[i_], send_ = up_ ? d_[i_] : d_[i_ + 4]; r4_[i_] = keep_ + __shfl_xor(send_, 32); } \
                    float r2_[2]; _Pragma("unroll") for (int i_ = 0; i_ < 2; ++i_) { const bool up_ = (lane & 16) != 0; const float keep_ = up_ ? r4_[i_ + 2] : r4_[i_], send_ = up_ ? r4_[i_] : r4_[i_ + 2]; r2_[i_] = keep_ + __shfl_xor(send_, 16); } \
                    float r1_; { const bool up_ = (lane & 8) != 0; const float keep_ = up_ ? r2_[1] : r2_[0], send_ = up_ ? r2_[0] : r2_[1]; r1_ = keep_ + __shfl_xor(send_, 8); } \
                    r1_ += __shfl_xor(r1_, 4); r1_ += __shfl_xor(r1_, 2); r1_ += __shfl_xor(r1_, 1); \
                    const int en_ = wl[(i0) + (lane >> 3)]; const int q_ = (en_ >> 23) & 3, k_ = (en_ >> 16) & 127; \
                    const float rs_ = q_ == 0 ? rsq[0] : q_ == 1 ? rsq[1] : q_ == 2 ? rsq[2] : rsq[3]; \
                    const float wv_ = sg[(tl0 + q_) * 128 + k_] * gelu_tanh(r1_ * rs_); if ((lane & 7) == 0) wts[q_ * 128 + k_] = wv_; } while (0)
#pragma unroll
                for (int j = 0; j < 16; ++j) PE_LOAD1(j, j);
                PE_FENCE;
#pragma unroll 1
                for (int b = 0; b < 31; ++b) {
                    { float d_[8];
#pragma unroll
                      for (int j = 0; j < 8; ++j) { PE_DOT(j, j); PE_FENCE; PE_LOAD1(j, (b + 1) * 16 + j); PE_FENCE; }
                      PE_UREDUCE(b * 16); }
                    { float d_[8];
#pragma unroll
                      for (int j = 8; j < 16; ++j) { PE_DOT(j, j - 8); PE_FENCE; PE_LOAD1(j, (b + 1) * 16 + j); PE_FENCE; }
                      PE_UREDUCE(b * 16 + 8); }
                }
                { float d_[8];
#pragma unroll
                  for (int j = 0; j < 8; ++j) { PE_DOT(j, j); PE_FENCE; }
                  PE_UREDUCE(31 * 16); }
                { float d_[8];
#pragma unroll
                  for (int j = 8; j < 16; ++j) { PE_DOT(j, j - 8); PE_FENCE; }
                  PE_UREDUCE(31 * 16 + 8); }
#undef PE_LOAD1
#undef PE_DOT
#undef PE_UREDUCE
            }
            asm volatile("s_waitcnt lgkmcnt(0)" ::: "memory");
            PSTAMP(3);
            float swq[4];
            {
#pragma unroll
                for (int q = 0; q < 4; ++q) { float m_ = fmaxf(fabsf(wts[q * 128 + lane]), fabsf(wts[q * 128 + 64 + lane]));
#pragma unroll
                    for (int o = 1; o < 64; o <<= 1) m_ = fmaxf(m_, __shfl_xor(m_, o));
                    swq[q] = 127.f / fmaxf(m_, 1e-20f); }
#pragma unroll
                for (int gg = 0; gg < 2; ++gg) { const int gi = lane + 64 * gg; unsigned pk_[4] = {0u, 0u, 0u, 0u};
#pragma unroll
                    for (int j = 0; j < 4; ++j) { const int en_ = wl[gi * 4 + j]; const int q_ = (en_ >> 23) & 3, k_ = (en_ >> 16) & 127; const float w_ = wts[q_ * 128 + k_];
                        const float sw_ = q_ == 0 ? swq[0] : q_ == 1 ? swq[1] : q_ == 2 ? swq[2] : swq[3]; const unsigned qv_ = q8(w_ * sw_) << (8 * j);
                        pk_[0] |= q_ == 0 ? qv_ : 0u; pk_[1] |= q_ == 1 ? qv_ : 0u; pk_[2] |= q_ == 2 ? qv_ : 0u; pk_[3] |= q_ == 3 ? qv_ : 0u; }
                    wpk[gi] = pk_[0]; wpk[128 + gi] = pk_[1]; wpk[256 + gi] = pk_[2]; wpk[384 + gi] = pk_[3]; }
            }
            asm volatile("s_waitcnt lgkmcnt(0)" ::: "memory");
            float ssq[4] = {0.f, 0.f, 0.f, 0.f};
#pragma unroll 1
            for (int hf = 0; hf < 2; ++hf) {
                int ac[4][16];
#pragma unroll
                for (int q = 0; q < 4; ++q)
#pragma unroll
                    for (int i = 0; i < 16; ++i) ac[q][i] = 0;
                u32x4 rv[16];
#define PE_VLOAD(j, i) do { const int e_ = __builtin_amdgcn_readfirstlane(wl[(i)]) & 0x3FFF; rv[j] = *(const u32x4*)(tv8 + (size_t)e_ * DM + hf * 1024 + lane * 16); } while (0)
#define PE_TIEI(A) asm volatile("" : "+v"(A[0]), "+v"(A[1]), "+v"(A[2]), "+v"(A[3]), "+v"(A[4]), "+v"(A[5]), "+v"(A[6]), "+v"(A[7]), "+v"(A[8]), "+v"(A[9]), "+v"(A[10]), "+v"(A[11]), "+v"(A[12]), "+v"(A[13]), "+v"(A[14]), "+v"(A[15]))
#define PE_GROUP4(j0, gi) do { const int w0_ = (int)wpk[(gi)], w1_ = (int)wpk[128 + (gi)], w2_ = (int)wpk[256 + (gi)], w3_ = (int)wpk[384 + (gi)]; \
                    _Pragma("unroll") for (int w_ = 0; w_ < 4; ++w_) { \
                        const unsigned r0_ = rv[j0][w_], r1_ = rv[j0 + 1][w_], r2_ = rv[j0 + 2][w_], r3_ = rv[j0 + 3][w_]; \
                        const unsigned lo01_ = __builtin_amdgcn_perm(r1_, r0_, 0x05010400u), hi01_ = __builtin_amdgcn_perm(r1_, r0_, 0x07030602u); \
                        const unsigned lo23_ = __builtin_amdgcn_perm(r3_, r2_, 0x05010400u), hi23_ = __builtin_amdgcn_perm(r3_, r2_, 0x07030602u); \
                        const int t_[4] = {(int)__builtin_amdgcn_perm(lo23_, lo01_, 0x05040100u), (int)__builtin_amdgcn_perm(lo23_, lo01_, 0x07060302u), \
                                           (int)__builtin_amdgcn_perm(hi23_, hi01_, 0x05040100u), (int)__builtin_amdgcn_perm(hi23_, hi01_, 0x07060302u)}; \
                        _Pragma("unroll") for (int c_ = 0; c_ < 4; ++c_) { const int o_ = w_ * 4 + c_; \
                            ac[0][o_] = __builtin_amdgcn_sdot4(t_[c_], w0_, ac[0][o_], false); ac[1][o_] = __builtin_amdgcn_sdot4(t_[c_], w1_, ac[1][o_], false); \
                            ac[2][o_] = __builtin_amdgcn_sdot4(t_[c_], w2_, ac[2][o_], false); ac[3][o_] = __builtin_amdgcn_sdot4(t_[c_], w3_, ac[3][o_], false); } } \
                    PE_TIEI(ac[0]); PE_TIEI(ac[1]); PE_TIEI(ac[2]); PE_TIEI(ac[3]); } while (0)
#pragma unroll
                for (int j = 0; j < 16; ++j) PE_VLOAD(j, j);
                PE_FENCE;
#pragma unroll 1
                for (int b = 0; b < 31; ++b) {
#pragma unroll
                    for (int g4 = 0; g4 < 4; ++g4) { PE_GROUP4(g4 * 4, b * 4 + g4); PE_FENCE;
#pragma unroll
                        for (int j = g4 * 4; j < g4 * 4 + 4; ++j) PE_VLOAD(j, (b + 1) * 16 + j);
                        PE_FENCE; }
                }
#pragma unroll
                for (int g4 = 0; g4 < 4; ++g4) { PE_GROUP4(g4 * 4, 31 * 4 + g4); PE_FENCE; }
#undef PE_VLOAD
#undef PE_TIEI
#undef PE_GROUP4
#pragma unroll
                for (int q = 0; q < 4; ++q) { const size_t o = (size_t)(t0 + q) * DM + hf * 1024 + lane * 16; const float f_ = 1.f / (swq[q] * TV_SCALE);
#pragma unroll
                    for (int c2 = 0; c2 < 2; ++c2) { const u32x4 xr_ = *(const u32x4*)(h1 + o + c2 * 8); f32x4 y4[2]; unsigned w8_[2];
#pragma unroll
                        for (int e = 0; e < 2; ++e) { const int c = c2 * 2 + e; const f32x4 x4 = e == 0 ? unpk4lo(xr_) : unpk4hi(xr_);
                            y4[e][0] = (float)ac[q][c * 4] * f_ + x4[0]; y4[e][1] = (float)ac[q][c * 4 + 1] * f_ + x4[1]; y4[e][2] = (float)ac[q][c * 4 + 2] * f_ + x4[2]; y4[e][3] = (float)ac[q][c * 4 + 3] * f_ + x4[3];
                            ssq[q] += sumsq4(y4[e]); w8_[e] = f8pack(y4[e] * X_SCALE); }
                        *(u32x4*)(h2 + o + c2 * 8) = pk8(y4[0], y4[1]); *(u32x2*)((unsigned char*)xn3 + o + c2 * 8) = (u32x2){w8_[0], w8_[1]}; } }
            }
#pragma unroll
            for (int q = 0; q < 4; ++q) { const float s_ = wave_sum(ssq[q]); if (lane == 0) ssq2[t0 + q] = s_; }
            PSTAMP(5);
        }
#undef PE_FENCE
#undef PE_TIE16
    }
}

#define XB_TMO      128
#define XB_XCNT(j)  (256  + 64 * (j))
#define XB_XSUB(j)  (1280 + 64 * (j))
#define XB_XGEN(j)  (2304 + 64 * (j))
#define XB_TOP      3328
#define XB_TOPGEN   3392
#define XCD_BAR_WORDS 3456
#define XB_SPIN_CAP (1u << 18)

__device__ __forceinline__ unsigned xb_ld(unsigned* p)              { return __hip_atomic_load(p, __ATOMIC_RELAXED, __HIP_MEMORY_SCOPE_AGENT); }
__device__ __forceinline__ unsigned xb_add(unsigned* p, unsigned v) { return __hip_atomic_fetch_add(p, v, __ATOMIC_RELAXED, __HIP_MEMORY_SCOPE_AGENT); }
__device__ __forceinline__ unsigned xb_xcc_id() { return (unsigned)__builtin_amdgcn_s_getreg((3 << 11) | 20) & 0xFu; }
#define XB_SPIN(cond, bar) do { unsigned _sp = 0; while (cond) { __builtin_amdgcn_s_sleep(1); \
    if ((++_sp & 255u) == 0u) { if (xb_ld(&(bar)[XB_TMO])) break; if (_sp > XB_SPIN_CAP) { atomicAdd(&(bar)[XB_TMO], 1u); break; } } } } while (0)

struct XcdBarrier {
    unsigned* bar; unsigned x;
    volatile __attribute__((address_space(3))) unsigned* st;
};

__device__ __forceinline__ XcdBarrier xcd_barrier_post(unsigned* bar, volatile __attribute__((address_space(3))) unsigned* st) {
    XcdBarrier b; b.bar = bar; b.x = xb_xcc_id(); b.st = st;
    if (threadIdx.x == 0) (void)xb_add(&bar[XB_XCNT(b.x)], 1u);
    return b;
}
__device__ __forceinline__ void xcd_barrier_complete(unsigned* bar, unsigned x, unsigned& nloc, unsigned& nx) {
    const unsigned G = gridDim.x * gridDim.y * gridDim.z;
    unsigned sum, cnt, mine, sp = 0u;
    for (;;) {
        sum = 0u; cnt = 0u; mine = 0u;
#pragma unroll
        for (unsigned j = 0; j < 16; ++j) { const unsigned c = xb_ld(&bar[XB_XCNT(j)]); sum += c; cnt += (c > 0u) ? 1u : 0u; mine = (j == x) ? c : mine; }
        if (sum == G) break;
        __builtin_amdgcn_s_sleep(1);
        if ((++sp & 255u) == 0u) { if (xb_ld(&bar[XB_TMO])) break; if (sp > XB_SPIN_CAP) { atomicAdd(&bar[XB_TMO], 1u); break; } }
    }
    nloc = mine > 0u ? mine : 1u; nx = cnt > 0u ? cnt : 1u;
}

__device__ __forceinline__ void xcd_barrier(const XcdBarrier& b) {
    asm volatile("s_waitcnt vmcnt(0)" ::: "memory");
    __syncthreads();
    if (threadIdx.x == 0) {
        unsigned* bar = b.bar;
        __builtin_amdgcn_s_waitcnt(0);
        unsigned nloc = b.st[0], nx = b.st[1];
        if (nloc == 0u) { xcd_barrier_complete(bar, b.x, nloc, nx); b.st[0] = nloc; b.st[1] = nx; }
        const unsigned old = xb_add(&bar[XB_XSUB(b.x)], 1u);
        const unsigned gen = old / nloc;
        if (old + 1u == (gen + 1u) * nloc) {
            __builtin_amdgcn_fence(__ATOMIC_RELEASE, "agent");
            asm volatile("s_waitcnt vmcnt(0)" ::: "memory");
            const unsigned og = xb_add(&bar[XB_TOP], 1u);
            const unsigned tg = og / nx;
            if (og + 1u == (tg + 1u) * nx) xb_add(&bar[XB_TOPGEN], 1u);
            else XB_SPIN(xb_ld(&bar[XB_TOPGEN]) == tg, bar);
            __builtin_amdgcn_fence(__ATOMIC_ACQUIRE, "agent");
            xb_add(&bar[XB_XGEN(b.x)], 1u);
            asm volatile("s_waitcnt vmcnt(0)" ::: "memory");
        } else {
            XB_SPIN(xb_ld(&bar[XB_XGEN(b.x)]) == gen, bar);
            __builtin_amdgcn_fence(__ATOMIC_ACQUIRE, "agent");
            asm volatile("s_waitcnt vmcnt(0)" ::: "memory");
        }
    }
    __syncthreads();
}


__global__ void __launch_bounds__(NTHREADS, 2) fwd_kernel(Params P) {
    extern __shared__ __attribute__((aligned(16))) unsigned char lds_raw[];
    float* lds = (float*)lds_raw;
    cg::grid_group grid = cg::this_grid();
    const int G = gridDim.x, bx = blockIdx.x;
    const int gthreads = G * NTHREADS, gwaves = G * 8;
#define PHASE_IDS() int tid = threadIdx.x; asm volatile("" : "+v"(tid)); const int lane = tid & 63, wid = tid >> 6, gtid = bx * NTHREADS + tid, gwave = bx * 8 + wid; (void)lane; (void)wid; (void)gtid; (void)gwave
typedef const float* const __attribute__((address_space(4)))* KARG;
#define PH_PTRS() \
    KARG INP = (KARG)__builtin_amdgcn_kernarg_segment_ptr(); asm volatile("" : "+s"(INP)); \
    unsigned char* ws = (unsigned char*)INP[29]; float* outp = (float*)INP[28]; \
    float* small = (float*)(ws + WS_SMALL); \
    float* rope = (float*)(ws + WS_ROPE); \
    bf16_t* wt_in = (bf16_t*)(ws + WS_WIN); bf16_t* wt_uq = (bf16_t*)(ws + WS_WUQ); bf16_t* wt_ukv = (bf16_t*)(ws + WS_WUKV); \
    bf16_t* wt_ao = (bf16_t*)(ws + WS_WAO); bf16_t* wt_ro = (bf16_t*)(ws + WS_WRO); bf16_t* wt_out = (bf16_t*)(ws + WS_WOUT); \
    bf16_t* wt_pq = (bf16_t*)(ws + WS_WPQ); bf16_t* wt_pg = (bf16_t*)(ws + WS_WPG); bf16_t* wt_pp = (bf16_t*)(ws + WS_WPP); \
    bf16_t* wt_g = (bf16_t*)(ws + WS_WG); bf16_t* wt_sk = (bf16_t*)(ws + WS_WSK); bf16_t* pb = (bf16_t*)(ws + WS_PB); \
    bf16_t* tu = (bf16_t*)(ws + WS_TU); bf16_t* tvt = (bf16_t*)(ws + WS_TV); \
    bf16_t* xb = (bf16_t*)(ws + WS_A0); bf16_t* xc = (bf16_t*)(ws + WS_A0); float* agg = (float*)(ws + WS_A0); bf16_t* h1b = (bf16_t*)(ws + WS_A0); \
    bf16_t* Yb = (bf16_t*)(ws + WS_A2); bf16_t* wq_plain = (bf16_t*)(ws + WS_A2); bf16_t* h2b = (bf16_t*)(ws + WS_A2); \
    bf16_t* gy = (bf16_t*)(ws + WS_A3); float* scores = (float*)(ws + WS_A3); \
    unsigned char* o8 = ws + WS_TV + 32 * MiB; bf16_t* gat = (bf16_t*)(ws + WS_A4); bf16_t* grn = (bf16_t*)(ws + WS_A5); bf16_t* ppb = (bf16_t*)(ws + WS_TU + 32 * MiB); \
    bf16_t* qn = (bf16_t*)(ws + WS_A6); bf16_t* kn = (bf16_t*)(ws + WS_A7); bf16_t* mixa = (bf16_t*)(ws + WS_A7); bf16_t* xn3 = (bf16_t*)(ws + WS_A7); \
    bf16_t* vv = (bf16_t*)(ws + WS_A8); bf16_t* mix = (bf16_t*)(ws + WS_A8); \
    bf16_t* qp = (bf16_t*)(ws + WS_A9); bf16_t* kpe = (bf16_t*)(ws + WS_KPE); \
    bf16_t* cq = (bf16_t*)outp; bf16_t* ckv = (bf16_t*)((unsigned char*)outp + 12 * MiB); bf16_t* xr = (bf16_t*)((unsigned char*)outp + 20 * MiB); \
    bf16_t* la = (bf16_t*)outp; bf16_t* gx = (bf16_t*)((unsigned char*)outp + 32 * MiB); \
    float* hres = outp;
#define INP_WS_STAMP (((unsigned char* const __attribute__((address_space(4)))*)__builtin_amdgcn_kernarg_segment_ptr())[29] + WS_SMALL + 400 * 1024)
    const int lo = P.ph_lo, hi = P.ph_hi;
    volatile __attribute__((address_space(3))) unsigned* misc_ = (volatile __attribute__((address_space(3))) unsigned*)((__attribute__((address_space(3))) unsigned char*)lds_raw + MISC_OFF);
    if (threadIdx.x < 2) misc_[threadIdx.x] = 0u;
    __syncthreads();
    XcdBarrier xbar; xbar.bar = nullptr; xbar.x = 0; xbar.st = nullptr;
    if (hi - lo > 1) xbar = xcd_barrier_post((unsigned*)(P.ws + WS_BAR), misc_);
#ifndef PHMASK
#define PHMASK 0xFFFF
#endif
#define IN(k) (((PHMASK >> (k)) & 1) && lo <= (k) && (k) < hi)
#define SYNC_AFTER(k) do { STAMP(2 * (k)); if (IN(k) && IN((k) + 1)) xcd_barrier(xbar); STAMP(2 * (k) + 1); } while (0)

#ifndef STAMP_DIV
#define STAMP_DIV 100.f
#endif
#ifndef SIMPLE_ATTN
#define SIMPLE_ATTN 0
#endif
#ifndef SIMPLE_GEMM
#define SIMPLE_GEMM 0
#endif
#define GEMM8(g, E) gemm_mfma8<decltype(E), true, true>((LAS unsigned char*)lds_raw, g, E)
#define GEMM(g, E) do { if (SIMPLE_GEMM) gemm_simple(lds, g, E); else gemm_mfma<decltype(E), true, true>((LAS unsigned char*)lds_raw, g, E); } while (0)
#ifdef STAMP_SEL
    if (blockIdx.x == STAMP_BLK && threadIdx.x == 0) { unsigned long long* st_ = (unsigned long long*)(INP_WS_STAMP); st_[0] = __builtin_amdgcn_s_memrealtime(); }
#define STAMP(k) do { if (blockIdx.x == STAMP_BLK && threadIdx.x == 0) { unsigned long long* st_ = (unsigned long long*)(INP_WS_STAMP); st_[(k) + 1] = __builtin_amdgcn_s_memrealtime(); } } while (0)
#else
#define STAMP(k) do {} while (0)
#endif
    if (IN(0)) { PH_PTRS();
        PHASE_IDS();
        int ib = 0;
        transpose_items<MapWin, true>(lds, INP[I_W_IN], DM, 9536, NIN_PAD, wt_in, INP[I_ATTN_NORM], WIN_SCALE, MapWin(), ib, gwave, gwaves);
        transpose_items(lds, INP[I_W_UQ], QL, 3072, 3072, wt_uq, INP[I_Q_NORM], QSCALE, MapWuq(), ib, gwave, gwaves);
        transpose_items(lds, INP[I_W_UKV], KVL, 4096, 4096, wt_ukv, INP[I_KV_NORM], 1.f, MapIdent(), ib, gwave, gwaves);
        transpose_items<MapIdent, true>(lds, INP[I_W_ATTN_O], DM, DM, DM, wt_ao, nullptr, WIN_SCALE, MapIdent(), ib, gwave, gwaves);
        transpose_items<MapIdent, true>(lds, INP[I_W_RNN_O], DM, DM, DM, wt_ro, nullptr, WIN_SCALE, MapIdent(), ib, gwave, gwaves);
        transpose_items<MapIdent, true>(lds, INP[I_W_OUT], DM, DM, DM, wt_out, nullptr, WIN_SCALE, MapIdent(), ib, gwave, gwaves);
        { const float* wq = INP[I_W_PEER_Q]; const float* gn = INP[I_FFN_NORM];
          for (int i = gtid; i < DM * DM / 8; i += gthreads) { const size_t o = (size_t)i * 8; const float g = gn[o / DM];
              const f32x4 a = *(const f32x4*)(wq + o) * g, b4 = *(const f32x4*)(wq + o + 4) * g; u32x4 w; w.x = pk2(a[0], a[1]); w.y = pk2(a[2], a[3]); w.z = pk2(b4[0], b4[1]); w.w = pk2(b4[2], b4[3]);
              *(u32x4*)(wq_plain + o) = w; } }
        transpose_items<MapIdent, true>(lds, INP[I_W_PLE_GATE], DM, DM, DM, wt_pg, INP[I_PLE_NORM], WIN_SCALE, MapIdent(), ib, gwave, gwaves);
        transpose_items(lds, INP[I_W_PLE_PROJ], PLE, DM, DM, wt_pp, nullptr, 1.f, MapIdent(), ib, gwave, gwaves);
        for (int b = 0; b < NBLK; ++b) {
            transpose_items(lds, INP[I_W_RG_A] + (size_t)b * BD * BD, BD, BD, BD, wt_g + (size_t)b * 256 * BD, nullptr, 1.f, MapIdent(), ib, gwave, gwaves);
            transpose_items(lds, INP[I_W_RG_X] + (size_t)b * BD * BD, BD, BD, BD, wt_g + (size_t)b * 256 * BD + 128 * BD, nullptr, 1.f, MapIdent(), ib, gwave, gwaves);
        }
        for (int i = gtid; i < PH * 256 * 256; i += gthreads) { const int h = i >> 16, n = (i >> 8) & 255, k = i & 255, c = n >> 7;
            float v = 0.f; if ((k >> 7) == c) v = INP[I_SUBKEYS][(((size_t)h * 2 + c) * NK + (n & 127)) * 128 + (k & 127)];
            wt_sk[i] = (bf16_t)f2bf(v); }
        { const float* pu = INP[I_PEER_U]; const float* pv = INP[I_PEER_V]; const float* gn = INP[I_FFN_NORM]; unsigned char* tu8 = (unsigned char*)tu; unsigned char* tv8 = (unsigned char*)tvt;
          const size_t n16 = (size_t)NK * NK * DM / 16;
          for (size_t i = gtid; i < n16; i += gthreads) { const size_t o = i * 16; const int d = (int)(o & (DM - 1));
              u32x4 wu, wv;
#pragma unroll
              for (int q = 0; q < 4; ++q) { const f32x4 a = *(const f32x4*)(pu + o + q * 4) * *(const f32x4*)(gn + d + q * 4) * TU_SCALE, bq = *(const f32x4*)(pv + o + q * 4) * TV_SCALE;
                  wu[q] = q8pack(a); wv[q] = q8pack(bq); }
              *(u32x4*)(tu8 + o) = wu; *(u32x4*)(tv8 + o) = wv; } }
        for (int i = gtid; i < S * PLE / 4; i += gthreads) { const f32x4 v = *(const f32x4*)(INP[I_P] + (size_t)i * 4); *(u32x2*)(pb + (size_t)i * 4) = pk4(v); }
        for (int t = gwave; t < S; t += gwaves) { const float* xrw = INP[I_X] + (size_t)t * DM; float s = 0.f;
#pragma unroll
            for (int j = 0; j < 8; ++j) { const f32x4 v = *(const f32x4*)(xrw + j * 256 + lane * 4); s += sumsq4(v); unsigned w1 = 0;
                w1 = __builtin_amdgcn_cvt_pk_fp8_f32(v[0] * X_SCALE, v[1] * X_SCALE, w1, false); w1 = __builtin_amdgcn_cvt_pk_fp8_f32(v[2] * X_SCALE, v[3] * X_SCALE, w1, true);
                *(unsigned*)((unsigned char*)xb + (size_t)t * DM + j * 256 + lane * 4) = w1; }
            s = wave_sum(s); if (lane == 0) small[SM_SSQ0 + t] = s; }
        for (int i = gtid; i < S * 32; i += gthreads) { const int t = i >> 5, j = i & 31; const float inv = exp2f(-(float)j * 0.41524101186092029f); const float ang = (float)t * inv;
            float rev = ang * 0.15915494309189535f; rev -= rintf(rev);
            rope[2 * i] = __builtin_amdgcn_cosf(rev); rope[2 * i + 1] = __builtin_amdgcn_sinf(rev); }
        for (int i = gtid; i < 4 * 2 * S; i += gthreads) small[SM_SSQQ + i] = 0.f;
        for (int i = gtid; i < DM; i += gthreads) { const float lam = INP[I_LAMBDA][i]; small[SM_N8SP + i] = -8.f * log1pf(__expf(-lam)); }
    }
    SYNC_AFTER(0);
    if (IN(1)) { PH_PTRS();
        GemmDesc g{xb, DM, 0, wt_in, DM, 0, S / 256, NIN_PAD / 256, 1, DM};
        static_assert(WS_A4 - WS_A3 == 32 * MiB && WS_A5 - WS_A4 == 32 * MiB && SM_SSQKV - SM_SSQQ == 16384, "EpiIn layout");
        EpiIn E{small + SM_SSQ0, rope, INP[I_B_GATE], cq, kpe, xr, gy, (u64*)(small + SM_SSQQ), 1.f / (WIN_SCALE * X_SCALE)};
        gemm_mfma8<decltype(E), true, true>((LAS unsigned char*)lds_raw, g, E);
        if (G == 256 && bx >= 192) { GemmDesc g2{wt_sk, 256, 256 * 256, wq_plain, DM, 256, 1, 8, PH, 256, 64, bx - 192}; EpiWf E2{wt_pq}; GEMM(g2, E2); }
    }
    SYNC_AFTER(1);
    if (IN(2)) { PH_PTRS();
        PHASE_IDS();
        { GemmDesc g{cq, QL, 0, wt_uq, QL, 0, S / 256, 12, 1, QL}; EpiQ E{(const u64*)(small + SM_SSQQ), rope, qn, qp}; GEMM(g, E); }
        if (G == 256 && bx >= 128) { GemmDesc g{pb, PLE, 0, wt_pp, PLE, 0, S / 256, 8, 1, PLE, 128, bx - 128}; EpiPlain E{ppb}; GEMM(g, E); }
        { GemmDesc g{ckv, KVL, 0, wt_ukv, KVL, 0, S / 256, 16, 1, KVL}; EpiKV E{(const u64*)(small + SM_SSQKV), kn, vv}; GEMM(g, E); }
        if (G != 256) { GemmDesc g{wt_sk, 256, 256 * 256, wq_plain, DM, 256, 1, 8, PH, 256}; EpiWf E{wt_pq}; GEMM(g, E); }
        const float* cw = INP[I_CONV_W]; const float* cb = INP[I_CONV_B];
        for (int i = gtid; i < (S / 32) * (DM / 8); i += gthreads) { const int run = i / (DM / 8), c = (i % (DM / 8)) * 8, t0 = run * 32;
            float w_[4][8], b_[8];
#pragma unroll
            for (int k = 0; k < 4; ++k) { const f32x4 a = *(const f32x4*)(cw + k * DM + c), d = *(const f32x4*)(cw + k * DM + c + 4); w_[k][0] = a[0]; w_[k][1] = a[1]; w_[k][2] = a[2]; w_[k][3] = a[3]; w_[k][4] = d[0]; w_[k][5] = d[1]; w_[k][6] = d[2]; w_[k][7] = d[3]; }
            { const f32x4 a = *(const f32x4*)(cb + c), d = *(const f32x4*)(cb + c + 4); b_[0] = a[0]; b_[1] = a[1]; b_[2] = a[2]; b_[3] = a[3]; b_[4] = d[0]; b_[5] = d[1]; b_[6] = d[2]; b_[7] = d[3]; }
            float x0[8], x1[8], x2[8];
#pragma unroll
            for (int j = 0; j < 8; ++j) { x0[j] = 0.f; x1[j] = 0.f; x2[j] = 0.f; }
            if (t0 > 0) { const u32x4 r0 = *(const u32x4*)(xr + (size_t)(t0 - 3) * DM + c), r1 = *(const u32x4*)(xr + (size_t)(t0 - 2) * DM + c), r2 = *(const u32x4*)(xr + (size_t)(t0 - 1) * DM + c);
#pragma unroll
                for (int j = 0; j < 4; ++j) { x0[2 * j] = bflo(r0[j]); x0[2 * j + 1] = bfhi(r0[j]); x1[2 * j] = bflo(r1[j]); x1[2 * j + 1] = bfhi(r1[j]); x2[2 * j] = bflo(r2[j]); x2[2 * j + 1] = bfhi(r2[j]); } }
#pragma unroll 1
            for (int tt = 0; tt < 32; tt += 8) { u32x4 rw[8];
#pragma unroll
                for (int q = 0; q < 8; ++q) rw[q] = *(const u32x4*)(xr + (size_t)(t0 + tt + q) * DM + c);
#pragma unroll
                for (int q = 0; q < 8; ++q) { float x3[8]; u32x4 o;
#pragma unroll
                    for (int j = 0; j < 4; ++j) { x3[2 * j] = bflo(rw[q][j]); x3[2 * j + 1] = bfhi(rw[q][j]); }
#pragma unroll
                    for (int j = 0; j < 4; ++j) { const float y0 = b_[2 * j] + w_[0][2 * j] * x0[2 * j] + w_[1][2 * j] * x1[2 * j] + w_[2][2 * j] * x2[2 * j] + w_[3][2 * j] * x3[2 * j];
                        const float y1 = b_[2 * j + 1] + w_[0][2 * j + 1] * x0[2 * j + 1] + w_[1][2 * j + 1] * x1[2 * j + 1] + w_[2][2 * j + 1] * x2[2 * j + 1] + w_[3][2 * j + 1] * x3[2 * j + 1]; o[j] = pk2(y0, y1); }
                    *(u32x4*)(xc + (size_t)(t0 + tt + q) * DM + c) = o;
#pragma unroll
                    for (int j = 0; j < 8; ++j) { x0[j] = x1[j]; x1[j] = x2[j]; x2[j] = x3[j]; } } } }
    }
    SYNC_AFTER(2);
    if (IN(3)) { PH_PTRS();
        if (SIMPLE_ATTN) attn_simple(lds, qn, qp, kn, kpe, vv, qn); else attn_mfma((char*)lds_raw, qn, qp, kn, kpe, vv, (bf16_t*)o8);
#ifndef SKIP_GATES
        GemmDesc g{xc, DM, BD, wt_g, BD, 256 * BD, S / 256, 1, NBLK, BD};
        EpiGates E{INP[I_B_RG_A], INP[I_B_RG_X], small + SM_N8SP, xc, la, gx};
        GEMM(g, E);
#endif
    }
    SYNC_AFTER(3);
    if (IN(4)) { PH_PTRS();
        PHASE_IDS();
        for (int i = gtid; i < 64 * (DM / 2); i += gthreads) { const int ch = i / (DM / 2), c = (i % (DM / 2)) * 2;
            float A0 = 1.f, B0 = 0.f, A1 = 1.f, B1 = 0.f;
#pragma unroll 1
            for (int t16 = 0; t16 < 128; t16 += 16) { unsigned lw[16], gw[16];
#pragma unroll
                for (int q = 0; q < 16; ++q) { const size_t o = (size_t)(ch * 128 + t16 + q) * DM + c; lw[q] = *(const unsigned*)(la + o); gw[q] = *(const unsigned*)(gx + o); }
#pragma unroll
                for (int q = 0; q < 16; ++q) { const float a0 = __builtin_amdgcn_exp2f(bflo(lw[q])), a1 = __builtin_amdgcn_exp2f(bfhi(lw[q]));
                    A0 *= a0; B0 = a0 * B0 + bflo(gw[q]); A1 *= a1; B1 = a1 * B1 + bfhi(gw[q]); } }
            *(f32x4*)(agg + ((size_t)ch * DM + c) * 2) = (f32x4){A0, B0, A1, B1}; }
    }
    SYNC_AFTER(4);
    if (IN(5)) { PH_PTRS();
        PHASE_IDS();
        for (int i = gtid; i < 64 * (DM / 2); i += gthreads) { const int ch = i / (DM / 2), c = (i % (DM / 2)) * 2;
            float h0 = 0.f, h1v = 0.f;
#pragma unroll 1
            for (int c16 = 0; c16 < ch; c16 += 16) { f32x4 ab[16];
#pragma unroll
                for (int q = 0; q < 16; ++q) ab[q] = (c16 + q < ch) ? *(const f32x4*)(agg + ((size_t)(c16 + q) * DM + c) * 2) : (f32x4){1.f, 0.f, 1.f, 0.f};
#pragma unroll
                for (int q = 0; q < 16; ++q) { h0 = ab[q][0] * h0 + ab[q][1]; h1v = ab[q][2] * h1v + ab[q][3]; } }
#pragma unroll 1
            for (int t16 = 0; t16 < 128; t16 += 16) { unsigned lw[16], gw[16], yw[16];
#pragma unroll
                for (int q = 0; q < 16; ++q) { const size_t o = (size_t)(ch * 128 + t16 + q) * DM + c; lw[q] = *(const unsigned*)(la + o); gw[q] = *(const unsigned*)(gx + o); yw[q] = *(const unsigned*)(gy + o); }
#pragma unroll
                for (int q = 0; q < 16; ++q) { const float a0 = __builtin_amdgcn_exp2f(bflo(lw[q])), a1 = __builtin_amdgcn_exp2f(bfhi(lw[q]));
                    h0 = a0 * h0 + bflo(gw[q]); h1v = a1 * h1v + bfhi(gw[q]);
                    *(unsigned short*)((unsigned char*)Yb + (size_t)(ch * 128 + t16 + q) * DM + c) = (unsigned short)(__builtin_amdgcn_cvt_pk_fp8_f32(h0 * bflo(yw[q]) * Y_SCALE, h1v * bfhi(yw[q]) * Y_SCALE, 0u, false) & 0xffffu); } } }
    }
    SYNC_AFTER(5);
    if (IN(6)) { PH_PTRS();
        { GemmDesc g{(const bf16_t*)o8, DM, 0, wt_ao, DM, 0, S / 256, 8, 1, DM}; EpiMixA E{gat, mixa}; GEMM8(g, E); }
        asm volatile("s_waitcnt vmcnt(0)" ::: "memory"); __syncthreads();
        { GemmDesc g{Yb, DM, 0, wt_ro, DM, 0, S / 256, 8, 1, DM}; EpiMix E{grn, mixa, (unsigned char*)mix}; GEMM8(g, E); }
    }
    SYNC_AFTER(6);
    if (IN(7)) { PH_PTRS();
        { GemmDesc g{mix, DM, 0, wt_out, DM, 0, S / 256, 8, 1, DM}; EpiOut E{INP[I_X], h1b, (u64*)(small + SM_SSQ1)}; GEMM8(g, E); }
        if (G != 256) { GemmDesc g{pb, PLE, 0, wt_pp, PLE, 0, S / 256, 8, 1, PLE}; EpiPlain E{ppb}; GEMM(g, E); }
    }
    SYNC_AFTER(7);
    if (IN(8)) { PH_PTRS(); GemmDesc g{h1b, DM, 0, wt_pq, DM, 0, S / 256, 8, 1, DM}; EpiScores E{scores, (const u64*)(small + SM_SSQ1)}; GEMM(g, E); }
    SYNC_AFTER(8);

    if (IN(10)) { PH_PTRS(); peer_phase2((void*)(INP_WS_STAMP), (char*)lds_raw, scores, h1b, (const u64*)(small + SM_SSQ1), (const unsigned char*)tu, (const unsigned char*)tvt, h2b, xn3, small + SM_SSQ2); }
    SYNC_AFTER(10);
#ifdef STAMP_SEL
    const bool fuse_final = false;
#else
    const bool fuse_final = (G == 256);
#endif
    if (IN(11)) { PH_PTRS(); GemmDesc g{xn3, DM, 0, wt_pg, DM, 0, S / 256, 8, 1, DM};
        if (fuse_final) { EpiPleFinal E{ppb, h2b, hres, (u64*)(small + SM_SSQ3), small + SM_SSQ2, INP[I_FINAL_NORM], (unsigned*)(ws + WS_BAR) + XCD_BAR_WORDS}; gemm_mfma8<decltype(E), true, true>((LAS unsigned char*)lds_raw, g, E); }
        else { EpiPle E{ppb, h2b, hres, (u64*)(small + SM_SSQ3), small + SM_SSQ2}; gemm_mfma8<decltype(E), true, true>((LAS unsigned char*)lds_raw, g, E); } }
    if (!fuse_final) { SYNC_AFTER(11); }
    if (IN(12) && !fuse_final) { PH_PTRS();
        PHASE_IDS();
        const float* fn = INP[I_FINAL_NORM];
        for (int i = gtid; i < S * DM / 4; i += gthreads) { const int t = i / (DM / 4), c = (i % (DM / 4)) * 4;
            const float rs = rsqrtf(ssq_get((const u64*)(small + SM_SSQ3), t) * (1.f / DM) + EPS);
            const f32x4 v = *(const f32x4*)(hres + (size_t)i * 4), g4 = *(const f32x4*)(fn + c);
            f32x4 ov = v * rs * g4;
#ifdef STAMP_SEL
            if (i == STAMP_BLK * NTHREADS) { const unsigned long long* st_ = (const unsigned long long*)(INP_WS_STAMP); { const float tus_ = (float)(st_[STAMP_B] - st_[STAMP_A]) * 0.01f; ov[0] += exp2f(rintf(STAMP_Q * log2f(fmaxf(tus_, 1.f))) * (1.f / STAMP_Q)) * (1.f / STAMP_DIV); } }
#endif
            *(f32x4*)(hres + (size_t)i * 4) = ov; }
    }
}

constexpr int NPHASES = 13;
#ifndef MK_N_LAUNCHES
#define MK_N_LAUNCHES 1
#endif

extern "C" void kernel_launch(void* const* d_in, const int* in_sizes, int n_in, void* d_out, int out_size, void* d_ws, size_t ws_size, hipStream_t stream) {
    static int grid = 0;
    if (grid == 0) {
        if (n_in != 28 || out_size != S * DM || ws_size < WS_END) { fprintf(stderr, "kernel_launch: unexpected shapes (n_in %d out %d ws %zu)\n", n_in, out_size, ws_size); grid = -1; return; }
        int dev = 0, cus = 0, per_cu = 0;
        (void)hipGetDevice(&dev);
        (void)hipDeviceGetAttribute(&cus, hipDeviceAttributeMultiprocessorCount, dev);
        if (hipFuncSetAttribute((const void*)fwd_kernel, hipFuncAttributeMaxDynamicSharedMemorySize, LDS_BYTES) != hipSuccess) { fprintf(stderr, "kernel_launch: hipFuncSetAttribute failed\n"); grid = -1; return; }
        if (hipOccupancyMaxActiveBlocksPerMultiprocessor(&per_cu, (const void*)fwd_kernel, NTHREADS, LDS_BYTES) != hipSuccess || per_cu < 1) { fprintf(stderr, "kernel_launch: occupancy query failed (%d)\n", per_cu); (void)hipGetLastError(); per_cu = 1; }
        if (per_cu > 1) per_cu = 1;
        grid = cus * per_cu;
        if (grid <= 0) grid = 256;
    }
    if (grid < 0) return;
    if (hipMemsetAsync((char*)d_ws + WS_BAR, 0, XCD_BAR_WORDS * 4 + 32 * 256, stream) != hipSuccess) { fprintf(stderr, "kernel_launch: hipMemsetAsync failed\n"); return; }
    Params p{};
    for (int i = 0; i < 28; ++i) p.in[i] = (const float*)d_in[i];
    p.out = (float*)d_out; p.ws = (unsigned char*)d_ws;
    if (MK_N_LAUNCHES == 1) {
        p.ph_lo = 0; p.ph_hi = NPHASES;
        void* args[] = {&p};
        hipError_t e = hipLaunchCooperativeKernel((const void*)fwd_kernel, dim3(grid), dim3(NTHREADS), args, LDS_BYTES, stream);
        if (e != hipSuccess) fprintf(stderr, "cooperative launch failed: %s (grid %d)\n", hipGetErrorString(e), grid);
    } else {
        for (int k = 0; k < NPHASES; ++k) { p.ph_lo = k; p.ph_hi = k + 1; hipLaunchKernelGGL(fwd_kernel, dim3(grid), dim3(NTHREADS), LDS_BYTES, stream, p); }
    }
}
```

```cpp
#include <hip/hip_runtime.h>
#include <hip/hip_cooperative_groups.h>
#include <cstdio>
#include <cstdint>
namespace cg = cooperative_groups;

#define STAMP_A 0
#define STAMP_BLK 0
#define ROT_EXP 0
#define UREP 1
#define EXP_MASK 0x3FFF
#define STAMP_B 2
#ifndef STAMP_Q
#define STAMP_Q 4.f
#endif
#define DEV __device__ __forceinline__
typedef unsigned short bf16_t;
typedef float f32x4 __attribute__((ext_vector_type(4)));
typedef float f32x2 __attribute__((ext_vector_type(2)));
typedef unsigned u32x2 __attribute__((ext_vector_type(2)));
typedef unsigned u32x4 __attribute__((ext_vector_type(4)));

constexpr int S = 8192, DM = 2048, PLE = 256;
constexpr int NH = 16, DN = 128, DR = 64, DV = 128;
constexpr int QL = 768, KVL = 512;
constexpr int NBLK = 16, BD = 128;
constexpr int PH = 8, NK = 128, TOPK = 16;
constexpr int NIN_PAD = 9728;
constexpr float EPS = 1e-6f;
constexpr float QSCALE = 0.07216878364870322f * 1.4426950408889634f;
constexpr int NTHREADS = 512;
constexpr float WIN_SCALE = 64.f, X_SCALE = 16.f, O_SCALE = 32.f, Y_SCALE = 16.f, MIX_SCALE = 32.f;
constexpr float TU_SCALE = 1024.f, TV_SCALE = 64.f, H_SCALE = 16.f;
#ifndef DBG_PEER
#define DBG_PEER 1
#endif
constexpr int LDS_BYTES = 147456;

constexpr size_t MiB = 1u << 20;
constexpr size_t WS_WIN = 0, WS_WUQ = 38 * MiB, WS_WUKV = WS_WUQ + 9 * MiB / 2, WS_WAO = WS_WUKV + 4 * MiB, WS_WRO = WS_WAO + 8 * MiB,
                 WS_WOUT = WS_WRO + 8 * MiB, WS_WPQ = WS_WOUT + 8 * MiB, WS_WPG = WS_WPQ + 8 * MiB, WS_WPP = WS_WPG + 8 * MiB,
                 WS_WG = WS_WPP + 1 * MiB, WS_WSK = WS_WG + 1 * MiB, WS_ROPE = WS_WSK + 1 * MiB, WS_PB = WS_ROPE + 2 * MiB, WS_SMALL = WS_PB + 4 * MiB;
static_assert(WS_SMALL == 95 * MiB + MiB / 2, "ws map");
constexpr size_t WS_A0 = 96 * MiB;
constexpr size_t WS_A2 = 128 * MiB;
constexpr size_t WS_A3 = 160 * MiB;
constexpr size_t WS_A4 = 192 * MiB;
constexpr size_t WS_A5 = 224 * MiB;
constexpr size_t WS_A6 = 256 * MiB;
constexpr size_t WS_A7 = 288 * MiB;
constexpr size_t WS_A8 = 320 * MiB;
constexpr size_t WS_A9 = 352 * MiB;
constexpr size_t WS_KPE = 368 * MiB;
constexpr size_t WS_TU = 384 * MiB, WS_TV = 448 * MiB, WS_END = 512 * MiB;
constexpr size_t WS_BAR = WS_SMALL + 352 * 1024;
constexpr int MISC_OFF = LDS_BYTES - 64;
constexpr int SM_SSQ0 = 0, SM_SSQQ = 8192, SM_SSQKV = 24576, SM_SSQ1 = 40960, SM_SSQ3 = 57344, SM_N8SP = 73728, SM_SSQ2 = 75776;
typedef unsigned long long u64;

DEV unsigned f2bf(float f) { unsigned u = __float_as_uint(f); return (u + 0x7fffu + ((u >> 16) & 1u)) >> 16; }
DEV unsigned pk2(float lo, float hi) { return f2bf(lo) | (f2bf(hi) << 16); }
DEV float bflo(unsigned w) { return __uint_as_float(w << 16); }
DEV float bfhi(unsigned w) { return __uint_as_float(w & 0xffff0000u); }
DEV u32x2 pk4(f32x4 v) { u32x2 r; r.x = pk2(v[0], v[1]); r.y = pk2(v[2], v[3]); return r; }
DEV f32x4 unpk4(u32x2 w) { return (f32x4){bflo(w.x), bfhi(w.x), bflo(w.y), bfhi(w.y)}; }
DEV u32x4 pk8(f32x4 a, f32x4 b) { u32x4 r; r.x = pk2(a[0], a[1]); r.y = pk2(a[2], a[3]); r.z = pk2(b[0], b[1]); r.w = pk2(b[2], b[3]); return r; }
DEV f32x4 unpk4lo(u32x4 w) { return (f32x4){bflo(w.x), bfhi(w.x), bflo(w.y), bfhi(w.y)}; }
DEV f32x4 unpk4hi(u32x4 w) { return (f32x4){bflo(w.z), bfhi(w.z), bflo(w.w), bfhi(w.w)}; }
DEV int perm_p(int R) { return (R & ~0x1C) | ((R & 0x0C) << 1) | ((R & 0x10) >> 2); }
DEV unsigned q8(float x) { return (unsigned)(int)fminf(fmaxf(rintf(x), -127.f), 127.f) & 0xffu; }
DEV unsigned q8pack(f32x4 v) { return q8(v[0]) | (q8(v[1]) << 8) | (q8(v[2]) << 16) | (q8(v[3]) << 24); }
DEV unsigned f8pack(f32x4 v) { unsigned w = 0; w = __builtin_amdgcn_cvt_pk_fp8_f32(v[0], v[1], w, false); w = __builtin_amdgcn_cvt_pk_fp8_f32(v[2], v[3], w, true); return w; }
DEV float sigmoidf_(float x) { return __builtin_amdgcn_rcpf(1.f + __expf(-x)); }
DEV float gelu_tanh(float x) { const float y = 0.7978845608028654f * (x + 0.044715f * x * x * x); const float t = 1.f - 2.f * __builtin_amdgcn_rcpf(1.f + __expf(2.f * y)); return 0.5f * x * (1.f + t); }
DEV float wave_sum(float v) {
#pragma unroll
    for (int o = 1; o < 64; o <<= 1) v += __shfl_xor(v, o);
    return v;
}

struct Params { const float* in[28]; float* out; unsigned char* ws; int ph_lo, ph_hi; };
enum { I_X = 0, I_P, I_ATTN_NORM, I_W_IN, I_B_GATE, I_Q_NORM, I_W_UQ, I_KV_NORM, I_W_UKV, I_W_ATTN_O, I_CONV_W, I_CONV_B, I_W_RG_A, I_B_RG_A, I_W_RG_X,
       I_B_RG_X, I_LAMBDA, I_W_RNN_O, I_W_OUT, I_FFN_NORM, I_W_PEER_Q, I_SUBKEYS, I_PEER_U, I_PEER_V, I_PLE_NORM, I_W_PLE_GATE, I_W_PLE_PROJ, I_FINAL_NORM };

struct MapIdent { DEV int operator()(int n) const { return n; } };
struct MapWin { DEV int operator()(int n) const {
    if (n < 1280) return n;
    if (n < 1344) { const int j = n - 1280; return 1280 + 16 * (j >> 5) + 4 * ((j >> 3) & 3) + (j & 3) + 32 * ((j >> 2) & 1); }
    if (n < 1536) return -1;
    return n - 192; } };
struct MapWuq { DEV int operator()(int n) const {
    if (n < 2048) { const int h = n >> 7, d = n & 127; return h * 192 + d; }
    const int r = n - 2048, h = r >> 6, j = r & 63;
    return h * 192 + 128 + 16 * (j >> 5) + 4 * ((j >> 3) & 3) + (j & 3) + 32 * ((j >> 2) & 1); } };

template <class MAP, bool FP8 = false>
DEV void transpose_items(float* lds, const float* W, int K, int N, int Nd, bf16_t* WT, const float* gain, float scale, MAP map, int& item_base, int gw, int ngw) {
    const int lane = threadIdx.x & 63, wid = threadIdx.x >> 6;
    const int nkt = K / 64, nnt = Nd / 64, nitems = nkt * nnt;
    float* T = lds + wid * (64 * 65);
    int first = (gw - item_base) % ngw; if (first < 0) first += ngw;
    for (int it = first; it < nitems; it += ngw) {
        const int kt = it % nkt, nt = it / nkt, k0 = kt * 64, n0 = nt * 64;
        const int c4 = (lane & 15) * 4, src = map(n0 + c4), kq = lane >> 4;
        f32x4 v[16];
#pragma unroll
        for (int i = 0; i < 16; ++i) { v[i] = (f32x4){0.f, 0.f, 0.f, 0.f}; if (src >= 0) v[i] = *(const f32x4*)(W + (size_t)(k0 + i * 4 + kq) * N + src); }
#pragma unroll
        for (int i = 0; i < 16; ++i) { const int kk = i * 4 + kq; const float g = (gain ? gain[k0 + kk] : 1.f) * scale;
            T[kk * 65 + c4 + 0] = v[i][0] * g; T[kk * 65 + c4 + 1] = v[i][1] * g; T[kk * 65 + c4 + 2] = v[i][2] * g; T[kk * 65 + c4 + 3] = v[i][3] * g; }
        asm volatile("s_waitcnt lgkmcnt(0)" ::: "memory");
        const int kc = (lane & 7) * 8;
#pragma unroll
        for (int i = 0; i < 8; ++i) { const int n = (lane >> 3) + 8 * i; u32x4 o;
            o.x = pk2(T[(kc + 0) * 65 + n], T[(kc + 1) * 65 + n]); o.y = pk2(T[(kc + 2) * 65 + n], T[(kc + 3) * 65 + n]);
            o.z = pk2(T[(kc + 4) * 65 + n], T[(kc + 5) * 65 + n]); o.w = pk2(T[(kc + 6) * 65 + n], T[(kc + 7) * 65 + n]);
            if constexpr (FP8) { u32x2 o8; unsigned w1 = 0, w2 = 0;
                w1 = __builtin_amdgcn_cvt_pk_fp8_f32(T[(kc + 0) * 65 + n], T[(kc + 1) * 65 + n], w1, false); w1 = __builtin_amdgcn_cvt_pk_fp8_f32(T[(kc + 2) * 65 + n], T[(kc + 3) * 65 + n], w1, true);
                w2 = __builtin_amdgcn_cvt_pk_fp8_f32(T[(kc + 4) * 65 + n], T[(kc + 5) * 65 + n], w2, false); w2 = __builtin_amdgcn_cvt_pk_fp8_f32(T[(kc + 6) * 65 + n], T[(kc + 7) * 65 + n], w2, true);
                o8.x = w1; o8.y = w2; *(u32x2*)((unsigned char*)WT + (size_t)(n0 + n) * K + k0 + kc) = o8; }
            else *(u32x4*)(WT + (size_t)(n0 + n) * K + k0 + kc) = o; }
        asm volatile("s_waitcnt lgkmcnt(0)" ::: "memory");
    }
    item_base += nitems;
}

struct Unit { int pm, pn, b; };
struct GemmDesc { const bf16_t* A; int lda; long a_bs; const bf16_t* Bt; int ldb; long b_bs; int nM, nN, nB, K; int vG, vc; };
template <class Epi>
DEV void gemm_simple(float* lds, const GemmDesc g, const Epi& E) {
    const int tid = threadIdx.x, lane = tid & 63, wid = tid >> 6, wr = wid >> 2, wc = wid & 3, fr = lane & 15, fq = lane >> 4;
    float* As = lds; float* Bs = lds + 256 * 20;
    const int total = g.nM * g.nN * g.nB;
    for (int u = blockIdx.x; u < total; u += gridDim.x) {
        Unit un; un.pm = u % g.nM; un.pn = (u / g.nM) % g.nN; un.b = u / (g.nM * g.nN);
        const bf16_t* Ab = g.A + (size_t)un.b * g.a_bs + (size_t)un.pm * 256 * g.lda;
        const bf16_t* Bb = g.Bt + (size_t)un.b * g.b_bs + (size_t)un.pn * 256 * g.ldb;
        f32x4 acc[2][2][4][2];
#pragma unroll
        for (int a = 0; a < 2; ++a)
#pragma unroll
            for (int b = 0; b < 2; ++b)
#pragma unroll
                for (int m = 0; m < 4; ++m)
#pragma unroll
                    for (int n = 0; n < 2; ++n) acc[a][b][m][n] = (f32x4){0.f, 0.f, 0.f, 0.f};
        for (int k0 = 0; k0 < g.K; k0 += 16) {
            __syncthreads();
            { const int r = tid >> 1, kk = (tid & 1) * 8;
              const u32x4 a = *(const u32x4*)(Ab + (size_t)r * g.lda + k0 + kk);
              const u32x4 b = *(const u32x4*)(Bb + (size_t)(Epi::PM ? perm_p(r) : r) * g.ldb + k0 + kk);
              float* ap = As + r * 20 + kk; float* bp = Bs + r * 20 + kk;
              *(f32x4*)ap = (f32x4){bflo(a.x), bfhi(a.x), bflo(a.y), bfhi(a.y)}; *(f32x4*)(ap + 4) = (f32x4){bflo(a.z), bfhi(a.z), bflo(a.w), bfhi(a.w)};
              *(f32x4*)bp = (f32x4){bflo(b.x), bfhi(b.x), bflo(b.y), bfhi(b.y)}; *(f32x4*)(bp + 4) = (f32x4){bflo(b.z), bfhi(b.z), bflo(b.w), bfhi(b.w)}; }
            __syncthreads();
#pragma unroll 1
            for (int k4 = 0; k4 < 16; k4 += 4) {
#pragma unroll
                for (int ai = 0; ai < 2; ++ai) {
                    f32x4 av[4];
#pragma unroll
                    for (int m = 0; m < 4; ++m) av[m] = *(const f32x4*)(As + (ai * 128 + wr * 64 + m * 16 + fr) * 20 + k4);
#pragma unroll
                    for (int bj = 0; bj < 2; ++bj)
#pragma unroll
                        for (int n = 0; n < 2; ++n)
#pragma unroll
                            for (int i = 0; i < 4; ++i) {
                                const f32x4 b = *(const f32x4*)(Bs + (bj * 128 + wc * 32 + n * 16 + fq * 4 + i) * 20 + k4);
#pragma unroll
                                for (int m = 0; m < 4; ++m) { const f32x4 a = av[m]; float c = acc[ai][bj][m][n][i];
                                    c = fmaf(a[0], b[0], c); c = fmaf(a[1], b[1], c); c = fmaf(a[2], b[2], c); c = fmaf(a[3], b[3], c); acc[ai][bj][m][n][i] = c; }
                                asm volatile("" ::: "memory");
                            }
                }
            }
        }
        { int fr2 = fr, fq2 = fq, wr2 = wr, wc2 = wc; asm volatile("" : "+v"(fr2), "+v"(fq2), "+v"(wr2), "+v"(wc2));
          E(acc, un, wr2, wc2, fr2, fq2); }
    }
}

#define LAS __attribute__((address_space(3)))
typedef short bf16x8 __attribute__((ext_vector_type(8)));
constexpr int BM = 256, BK = 64, HALF = 128, HTB = HALF * BK * 2, STAGE_BYTES = 8 * HTB;
DEV int lds_byte(int r, int c) { const int st = (r >> 4) * 2 + (c >> 5), rr = r & 15, cc = c & 31, ob = rr * 64 + cc * 2; return st * 1024 + (ob ^ (((ob >> 9) & 1) << 5)); }
DEV void stage_rc(int b, int& R, int& C) { const int st = b / 1024, sb = b % 1024, swz = sb ^ (((sb >> 9) & 1) << 5); R = (st >> 1) * 16 + swz / 64; C = (st & 1) * 32 + (swz % 64) / 2; }
struct UnitOrder { int nM, nN, total, G, c;
    DEV bool next(int i, Unit& u) const { const int L = i * G + c; if (L >= total) return false; u.pm = L % nM; u.pn = (L / nM) % nN; u.b = L / (nM * nN); return true; } };
template <class Epi, bool ALIGN_EPI, bool SP2>
__device__ __forceinline__ void gemm_mfma(LAS unsigned char* lds, const GemmDesc g, const Epi& E) {
    const UnitOrder S{g.nM, g.nN, g.nM * g.nN * g.nB, g.vG ? g.vG : (int)gridDim.x, g.vG ? g.vc : (int)blockIdx.x};
    const int tid = threadIdx.x, wid = __builtin_amdgcn_readfirstlane(tid >> 6), lane = tid & 63, wr = wid >> 2, wc = wid & 3, fr = lane & 15, fq = lane >> 4;
    int K = g.K; asm volatile("" : "+s"(K));
    const int nt = K / BK;
    unsigned voffA[2], voffB[2];
#pragma unroll
    for (int i = 0; i < 2; ++i) { int R, C; stage_rc(tid * 16 + i * 8192, R, C); voffA[i] = (unsigned)(R * g.lda + C) * 2u; voffB[i] = (unsigned)((Epi::PM ? perm_p(R) : R) * g.ldb + C) * 2u; }
    const size_t kstep = (size_t)(BK * 2);
    const size_t hstepA = (size_t)HALF * g.lda * 2, hstepB = (size_t)HALF * g.ldb * 2;
    const unsigned ldsw = (unsigned)wid * 1024u;
    const int aoff = lds_byte(wr * 64 + fr, fq * 8), boff = lds_byte(wc * 32 + fr, fq * 8);
#define PG8_SA(b, h) (((b) * 2 + (h)) * HTB)
#define PG8_SB(b, h) ((4 + (b) * 2 + (h)) * HTB)
#define PG8_STAGE(bufoff, gbase, voff) do { _Pragma("unroll") for (int _i = 0; _i < 2; ++_i) \
        __builtin_amdgcn_global_load_lds((const unsigned*)((const char*)(gbase) + (voff)[_i]), (LAS unsigned*)(lds + (bufoff) + ldsw + _i * 8192), 16, 0, 0); } while (0)
#define PG8_LDA(dst, b, h) do { _Pragma("unroll") for (int m = 0; m < 4; ++m) _Pragma("unroll") for (int k = 0; k < 2; ++k) dst[m][k] = *(const LAS bf16x8*)(lds + PG8_SA(b, h) + aoff + m * 2048 + k * 1024); } while (0)
#define PG8_LDB(dst, b, h) do { _Pragma("unroll") for (int n = 0; n < 2; ++n) _Pragma("unroll") for (int k = 0; k < 2; ++k) dst[n][k] = *(const LAS bf16x8*)(lds + PG8_SB(b, h) + boff + n * 2048 + k * 1024); } while (0)
#define PG8_MMA(ai, bj, At, Bt) do { __builtin_amdgcn_s_setprio(1); _Pragma("unroll") for (int m = 0; m < 4; ++m) _Pragma("unroll") for (int n = 0; n < 2; ++n) _Pragma("unroll") for (int k = 0; k < 2; ++k) \
        acc[ai][bj][m][n] = __builtin_amdgcn_mfma_f32_16x16x32_bf16(Bt[n][k], At[m][k], acc[ai][bj][m][n], 0, 0, 0); __builtin_amdgcn_s_setprio(0); } while (0)
#define PG8_WAIT_V(n) asm volatile("s_waitcnt vmcnt(" #n ")" ::: "memory")
#define PG8_WAIT_L(n) asm volatile("s_waitcnt lgkmcnt(" #n ")" ::: "memory")
#define PG8_BAR __builtin_amdgcn_s_barrier()
#define PG8_SCHED __builtin_amdgcn_sched_barrier(0)
    Unit cur, nxt; int ui = 0;
    if (!S.next(0, cur)) return;
    f32x4 acc[2][2][4][2];
#pragma unroll
    for (int a = 0; a < 2; ++a)
#pragma unroll
        for (int b = 0; b < 2; ++b)
#pragma unroll
            for (int m = 0; m < 4; ++m)
#pragma unroll
                for (int n = 0; n < 2; ++n) acc[a][b][m][n] = (f32x4){0.f, 0.f, 0.f, 0.f};
    bf16x8 At[4][2], B0[2][2], B1[2][2];
    const char* cA = (const char*)(g.A + (size_t)cur.b * g.a_bs) + (size_t)cur.pm * 2 * hstepA; const char* cB = (const char*)(g.Bt + (size_t)cur.b * g.b_bs) + (size_t)cur.pn * 2 * hstepB;
    if constexpr (SP2) {
        PG8_STAGE(PG8_SB(0, 0), cB, voffB); PG8_STAGE(PG8_SB(0, 1), cB + hstepB, voffB); PG8_STAGE(PG8_SA(0, 0), cA, voffA); PG8_STAGE(PG8_SA(0, 1), cA + hstepA, voffA);
        if (wr == 1) PG8_BAR;
        PG8_WAIT_V(2); PG8_BAR;
        PG8_STAGE(PG8_SB(1, 0), cB + kstep, voffB); PG8_STAGE(PG8_SA(1, 0), cA + kstep, voffA); PG8_STAGE(PG8_SB(1, 1), cB + hstepB + kstep, voffB);
        PG8_WAIT_V(6); PG8_BAR;
    } else {
        PG8_STAGE(PG8_SB(0, 0), cB, voffB); PG8_STAGE(PG8_SA(0, 0), cA, voffA); PG8_STAGE(PG8_SB(0, 1), cB + hstepB, voffB); PG8_STAGE(PG8_SA(0, 1), cA + hstepA, voffA);
        if (wr == 1) PG8_BAR;
        PG8_WAIT_V(4); PG8_BAR;
        PG8_STAGE(PG8_SB(1, 0), cB + kstep, voffB); PG8_STAGE(PG8_SA(1, 0), cA + kstep, voffA); PG8_STAGE(PG8_SB(1, 1), cB + hstepB + kstep, voffB);
        PG8_WAIT_V(6); PG8_BAR;
    }
    for (;;) {
        const bool has_next = S.next(ui + 1, nxt);
        const char* nA = has_next ? (const char*)(g.A + (size_t)nxt.b * g.a_bs) + (size_t)nxt.pm * 2 * hstepA : cA; const char* nB = has_next ? (const char*)(g.Bt + (size_t)nxt.b * g.b_bs) + (size_t)nxt.pn * 2 * hstepB : cB;
        for (int t = 0; t < nt; t += 2) {
            const bool last = (t == nt - 2);
            const char* a1 = cA + (size_t)(t + 1) * kstep;
            const char* a2 = last ? nA : cA + (size_t)(t + 2) * kstep; const char* b2 = last ? nB : cB + (size_t)(t + 2) * kstep;
            const char* a3 = a2 + kstep; const char* b3 = b2 + kstep;
            if constexpr (SP2) {
            PG8_LDB(B0, 0, 0); PG8_LDB(B1, 0, 1); PG8_SCHED; PG8_LDA(At, 0, 0); PG8_STAGE(PG8_SA(1, 1), a1 + hstepA, voffA);
            PG8_WAIT_V(8); PG8_WAIT_L(0); PG8_BAR; PG8_MMA(0, 0, At, B0); PG8_MMA(0, 1, At, B1); PG8_BAR; PG8_SCHED;
            PG8_LDA(At, 0, 1); PG8_STAGE(PG8_SB(0, 0), b2, voffB); PG8_STAGE(PG8_SB(0, 1), b2 + hstepB, voffB); PG8_STAGE(PG8_SA(0, 0), a2, voffA);
            PG8_WAIT_V(8); PG8_WAIT_L(0); PG8_BAR; PG8_MMA(1, 0, At, B0); PG8_MMA(1, 1, At, B1); PG8_BAR; PG8_SCHED;
            PG8_LDB(B0, 1, 0); PG8_LDB(B1, 1, 1); PG8_SCHED; PG8_LDA(At, 1, 0); PG8_STAGE(PG8_SA(0, 1), a2 + hstepA, voffA);
            PG8_WAIT_V(8); PG8_WAIT_L(0); PG8_BAR; PG8_MMA(0, 0, At, B0); PG8_MMA(0, 1, At, B1); PG8_BAR; PG8_SCHED;
            PG8_LDA(At, 1, 1); PG8_STAGE(PG8_SB(1, 0), b3, voffB); PG8_STAGE(PG8_SB(1, 1), b3 + hstepB, voffB); PG8_STAGE(PG8_SA(1, 0), a3, voffA);
            PG8_WAIT_V(8); PG8_WAIT_L(0); PG8_BAR; PG8_MMA(1, 0, At, B0); PG8_MMA(1, 1, At, B1); PG8_BAR; PG8_SCHED;
            } else {
            PG8_LDB(B0, 0, 0); PG8_SCHED; PG8_LDA(At, 0, 0); PG8_STAGE(PG8_SA(1, 1), a1 + hstepA, voffA);
            PG8_WAIT_L(8); PG8_BAR; PG8_WAIT_L(0); PG8_MMA(0, 0, At, B0); PG8_BAR; PG8_SCHED;
            PG8_LDB(B1, 0, 1); PG8_STAGE(PG8_SB(0, 0), b2, voffB);
            PG8_BAR; PG8_WAIT_L(0); PG8_MMA(0, 1, At, B1); PG8_BAR;
            PG8_LDA(At, 0, 1); PG8_STAGE(PG8_SA(0, 0), a2, voffA);
            PG8_BAR; PG8_WAIT_L(0); PG8_MMA(1, 0, At, B0); PG8_BAR; PG8_SCHED;
            PG8_STAGE(PG8_SB(0, 1), b2 + hstepB, voffB);
            PG8_WAIT_V(6); PG8_BAR; PG8_MMA(1, 1, At, B1); PG8_BAR;
            PG8_LDB(B0, 1, 0); PG8_SCHED; PG8_LDA(At, 1, 0); PG8_STAGE(PG8_SA(0, 1), a2 + hstepA, voffA);
            PG8_WAIT_L(8); PG8_BAR; PG8_WAIT_L(0); PG8_MMA(0, 0, At, B0); PG8_BAR; PG8_SCHED;
            PG8_LDB(B1, 1, 1); PG8_STAGE(PG8_SB(1, 0), b3, voffB);
            PG8_BAR; PG8_WAIT_L(0); PG8_MMA(0, 1, At, B1); PG8_BAR;
            PG8_LDA(At, 1, 1); PG8_STAGE(PG8_SA(1, 0), a3, voffA);
            PG8_BAR; PG8_WAIT_L(0); PG8_MMA(1, 0, At, B0); PG8_BAR; PG8_SCHED;
            PG8_STAGE(PG8_SB(1, 1), b3 + hstepB, voffB);
            PG8_WAIT_V(6); PG8_BAR; PG8_MMA(1, 1, At, B1); PG8_BAR;
            }
        }
        if constexpr (ALIGN_EPI) { if (wr == 0) PG8_BAR; }
        { int fr2 = fr, fq2 = fq, wr2 = wr, wc2 = wc; asm volatile("" : "+v"(fr2), "+v"(fq2), "+v"(wr2), "+v"(wc2)); E(acc, cur, wr2, wc2, fr2, fq2); }
        if (!has_next) break;
#pragma unroll
        for (int a = 0; a < 2; ++a)
#pragma unroll
            for (int b = 0; b < 2; ++b)
#pragma unroll
                for (int m = 0; m < 4; ++m)
#pragma unroll
                    for (int n = 0; n < 2; ++n) acc[a][b][m][n] = (f32x4){0.f, 0.f, 0.f, 0.f};
        cur = nxt; cA = nA; cB = nB; ++ui;
        if constexpr (ALIGN_EPI) { if (wr == 1) PG8_BAR; }
    }
    PG8_WAIT_V(0);
    if constexpr (!ALIGN_EPI) { if (wr == 0) PG8_BAR; }
    PG8_BAR;
#undef PG8_SA
#undef PG8_SB
#undef PG8_STAGE
#undef PG8_LDA
#undef PG8_LDB
#undef PG8_MMA
#undef PG8_WAIT_V
#undef PG8_WAIT_L
#undef PG8_BAR
#undef PG8_SCHED
}

typedef int i32x4_t __attribute__((ext_vector_type(4)));
typedef int i32x8_t __attribute__((ext_vector_type(8)));
#ifdef STAMP_SEL
#ifndef GST_UNIT
#define GST_UNIT 1
#endif
#ifndef GST_NN
#define GST_NN 38
#endif
#define GSTAMP(k) do { if (g.nN == GST_NN && blockIdx.x == STAMP_BLK && threadIdx.x == 0 && ui == GST_UNIT) ((unsigned long long*)(((unsigned char* const __attribute__((address_space(4)))*)__builtin_amdgcn_kernarg_segment_ptr())[29] + WS_SMALL + 400 * 1024))[40 + (k)] = __builtin_amdgcn_s_memrealtime(); } while (0)
#else
#define GSTAMP(k) do {} while (0)
#endif
template <class Epi, bool ALIGN_EPI, bool SP2>
__device__ __forceinline__ void gemm_mfma8(LAS unsigned char* lds, const GemmDesc g, const Epi& E) {
    const UnitOrder S{g.nM, g.nN, g.nM * g.nN * g.nB, g.vG ? g.vG : (int)gridDim.x, g.vG ? g.vc : (int)blockIdx.x};
    const int tid = threadIdx.x, wid = __builtin_amdgcn_readfirstlane(tid >> 6), lane = tid & 63, wr = wid >> 2, wc = wid & 3, fr = lane & 15, fq = lane >> 4;
    int K = g.K; asm volatile("" : "+s"(K));
    const int nt = K / 128;
    unsigned voffA[2], voffB[2];
#pragma unroll
    for (int i = 0; i < 2; ++i) { int R, C; stage_rc(tid * 16 + i * 8192, R, C); voffA[i] = (unsigned)(R * g.lda + C * 2); voffB[i] = (unsigned)((Epi::PM ? perm_p(R) : R) * g.ldb + C * 2); }
    const size_t kstep = (size_t)(BK * 2);
    const size_t hstepA = (size_t)HALF * g.lda, hstepB = (size_t)HALF * g.ldb;
    const unsigned ldsw = (unsigned)wid * 1024u;
    const int aoff = lds_byte(wr * 64 + fr, fq * 8), boff = lds_byte(wc * 32 + fr, fq * 8);
#define PG8_SA(b, h) (((b) * 2 + (h)) * HTB)
#define PG8_SB(b, h) ((4 + (b) * 2 + (h)) * HTB)
#define PG8_STAGE(bufoff, gbase, voff) do { _Pragma("unroll") for (int _i = 0; _i < 2; ++_i) \
        __builtin_amdgcn_global_load_lds((const unsigned*)((const char*)(gbase) + (voff)[_i]), (LAS unsigned*)(lds + (bufoff) + ldsw + _i * 8192), 16, 0, 0); } while (0)
#define PG8_LDA(dst, b, h) do { _Pragma("unroll") for (int m = 0; m < 4; ++m) { dst[m].lo = *(const LAS i32x4_t*)(lds + PG8_SA(b, h) + aoff + m * 2048); dst[m].hi = *(const LAS i32x4_t*)(lds + PG8_SA(b, h) + aoff + m * 2048 + 1024); } } while (0)
#define PG8_LDB(dst, b, h) do { _Pragma("unroll") for (int n = 0; n < 2; ++n) { dst[n].lo = *(const LAS i32x4_t*)(lds + PG8_SB(b, h) + boff + n * 2048); dst[n].hi = *(const LAS i32x4_t*)(lds + PG8_SB(b, h) + boff + n * 2048 + 1024); } } while (0)
#define PG8_MMA(ai, bj, At, Bt) do { __builtin_amdgcn_s_setprio(1); _Pragma("unroll") for (int m = 0; m < 4; ++m) _Pragma("unroll") for (int n = 0; n < 2; ++n) \
        asm volatile("v_mfma_scale_f32_16x16x128_f8f6f4 %0, %1, %2, %0, %3, %3 op_sel_hi:[0,0,0]" : "+v"(acc[ai][bj][m][n]) : "v"(Bt[n]), "v"(At[m]), "v"(mxs)); __builtin_amdgcn_s_setprio(0); } while (0)
#define PG8_CAT(x) __builtin_shufflevector(__builtin_bit_cast(i32x4_t, x[0]), __builtin_bit_cast(i32x4_t, x[1]), 0, 1, 2, 3, 4, 5, 6, 7)
#define PG8_WAIT_V(n) asm volatile("s_waitcnt vmcnt(" #n ")" ::: "memory")
#define PG8_WAIT_L(n) asm volatile("s_waitcnt lgkmcnt(" #n ")" ::: "memory")
#define PG8_BAR __builtin_amdgcn_s_barrier()
#define PG8_SCHED __builtin_amdgcn_sched_barrier(0)
    const int mxs = 0x7F7F7F7F;
    Unit cur, nxt; int ui = 0;
    if (!S.next(0, cur)) return;
    f32x4 acc[2][2][4][2];
#pragma unroll
    for (int a = 0; a < 2; ++a)
#pragma unroll
        for (int b = 0; b < 2; ++b)
#pragma unroll
            for (int m = 0; m < 4; ++m)
#pragma unroll
                for (int n = 0; n < 2; ++n) acc[a][b][m][n] = (f32x4){0.f, 0.f, 0.f, 0.f};
    i32x8_t At[4], B0[2], B1[2];
    const char* cA = ((const char*)g.A + (size_t)cur.b * g.a_bs) + (size_t)cur.pm * 2 * hstepA; const char* cB = ((const char*)g.Bt + (size_t)cur.b * g.b_bs) + (size_t)cur.pn * 2 * hstepB;
    if constexpr (SP2) {
        PG8_STAGE(PG8_SB(0, 0), cB, voffB); PG8_STAGE(PG8_SB(0, 1), cB + hstepB, voffB); PG8_STAGE(PG8_SA(0, 0), cA, voffA); PG8_STAGE(PG8_SA(0, 1), cA + hstepA, voffA);
        if (wr == 1) PG8_BAR;
        PG8_WAIT_V(2); PG8_BAR;
        PG8_STAGE(PG8_SB(1, 0), cB + kstep, voffB); PG8_STAGE(PG8_SA(1, 0), cA + kstep, voffA); PG8_STAGE(PG8_SB(1, 1), cB + hstepB + kstep, voffB);
        PG8_WAIT_V(6); PG8_BAR;
    } else {
        PG8_STAGE(PG8_SB(0, 0), cB, voffB); PG8_STAGE(PG8_SA(0, 0), cA, voffA); PG8_STAGE(PG8_SB(0, 1), cB + hstepB, voffB); PG8_STAGE(PG8_SA(0, 1), cA + hstepA, voffA);
        if (wr == 1) PG8_BAR;
        PG8_WAIT_V(4); PG8_BAR;
        PG8_STAGE(PG8_SB(1, 0), cB + kstep, voffB); PG8_STAGE(PG8_SA(1, 0), cA + kstep, voffA); PG8_STAGE(PG8_SB(1, 1), cB + hstepB + kstep, voffB);
        PG8_WAIT_V(6); PG8_BAR;
    }
    for (;;) {
        const bool has_next = S.next(ui + 1, nxt);
        const char* nA = has_next ? ((const char*)g.A + (size_t)nxt.b * g.a_bs) + (size_t)nxt.pm * 2 * hstepA : cA; const char* nB = has_next ? ((const char*)g.Bt + (size_t)nxt.b * g.b_bs) + (size_t)nxt.pn * 2 * hstepB : cB;
        GSTAMP(0);
        for (int t = 0; t < nt; t += 2) {
            const bool last = (t == nt - 2);
            const char* a1 = cA + (size_t)(t + 1) * kstep;
            const char* a2 = last ? nA : cA + (size_t)(t + 2) * kstep; const char* b2 = last ? nB : cB + (size_t)(t + 2) * kstep;
            const char* a3 = a2 + kstep; const char* b3 = b2 + kstep;
            if constexpr (SP2) {
            PG8_LDB(B0, 0, 0); PG8_LDB(B1, 0, 1); PG8_SCHED; PG8_LDA(At, 0, 0); PG8_STAGE(PG8_SA(1, 1), a1 + hstepA, voffA);
            PG8_WAIT_V(8); PG8_WAIT_L(0); PG8_BAR; PG8_MMA(0, 0, At, B0); PG8_MMA(0, 1, At, B1); PG8_BAR; PG8_SCHED;
            PG8_LDA(At, 0, 1); PG8_STAGE(PG8_SB(0, 0), b2, voffB); PG8_STAGE(PG8_SB(0, 1), b2 + hstepB, voffB); PG8_STAGE(PG8_SA(0, 0), a2, voffA);
            PG8_WAIT_V(8); PG8_WAIT_L(0); PG8_BAR; PG8_MMA(1, 0, At, B0); PG8_MMA(1, 1, At, B1); PG8_BAR; PG8_SCHED;
            PG8_LDB(B0, 1, 0); PG8_LDB(B1, 1, 1); PG8_SCHED; PG8_LDA(At, 1, 0); PG8_STAGE(PG8_SA(0, 1), a2 + hstepA, voffA);
            PG8_WAIT_V(8); PG8_WAIT_L(0); PG8_BAR; PG8_MMA(0, 0, At, B0); PG8_MMA(0, 1, At, B1); PG8_BAR; PG8_SCHED;
            PG8_LDA(At, 1, 1); PG8_STAGE(PG8_SB(1, 0), b3, voffB); PG8_STAGE(PG8_SB(1, 1), b3 + hstepB, voffB); PG8_STAGE(PG8_SA(1, 0), a3, voffA);
            PG8_WAIT_V(8); PG8_WAIT_L(0); PG8_BAR; PG8_MMA(1, 0, At, B0); PG8_MMA(1, 1, At, B1); PG8_BAR; PG8_SCHED;
            } else {
            PG8_LDB(B0, 0, 0); PG8_SCHED; PG8_LDA(At, 0, 0); PG8_STAGE(PG8_SA(1, 1), a1 + hstepA, voffA);
            PG8_WAIT_L(8); PG8_BAR; PG8_WAIT_L(0); PG8_MMA(0, 0, At, B0); PG8_BAR; PG8_SCHED;
            PG8_LDB(B1, 0, 1); PG8_STAGE(PG8_SB(0, 0), b2, voffB);
            PG8_BAR; PG8_WAIT_L(0); PG8_MMA(0, 1, At, B1); PG8_BAR;
            PG8_LDA(At, 0, 1); PG8_STAGE(PG8_SA(0, 0), a2, voffA);
            PG8_BAR; PG8_WAIT_L(0); PG8_MMA(1, 0, At, B0); PG8_BAR; PG8_SCHED;
            PG8_STAGE(PG8_SB(0, 1), b2 + hstepB, voffB);
            PG8_WAIT_V(6); PG8_BAR; PG8_MMA(1, 1, At, B1); PG8_BAR;
            PG8_LDB(B0, 1, 0); PG8_SCHED; PG8_LDA(At, 1, 0); PG8_STAGE(PG8_SA(0, 1), a2 + hstepA, voffA);
            PG8_WAIT_L(8); PG8_BAR; PG8_WAIT_L(0); PG8_MMA(0, 0, At, B0); PG8_BAR; PG8_SCHED;
            PG8_LDB(B1, 1, 1); PG8_STAGE(PG8_SB(1, 0), b3, voffB);
            PG8_BAR; PG8_WAIT_L(0); PG8_MMA(0, 1, At, B1); PG8_BAR;
            PG8_LDA(At, 1, 1); PG8_STAGE(PG8_SA(1, 0), a3, voffA);
            PG8_BAR; PG8_WAIT_L(0); PG8_MMA(1, 0, At, B0); PG8_BAR; PG8_SCHED;
            PG8_STAGE(PG8_SB(1, 1), b3 + hstepB, voffB);
            PG8_WAIT_V(6); PG8_BAR; PG8_MMA(1, 1, At, B1); PG8_BAR;
            }
        }
        GSTAMP(1);
        if constexpr (ALIGN_EPI) { if (wr == 0) PG8_BAR; }
        asm volatile("s_nop 15\n\ts_nop 7" ::: "memory");
        { int fr2 = fr, fq2 = fq, wr2 = wr, wc2 = wc; asm volatile("" : "+v"(fr2), "+v"(fq2), "+v"(wr2), "+v"(wc2)); E(acc, cur, wr2, wc2, fr2, fq2); }
        GSTAMP(2);
        if (!has_next) break;
#pragma unroll
        for (int a = 0; a < 2; ++a)
#pragma unroll
            for (int b = 0; b < 2; ++b)
#pragma unroll
                for (int m = 0; m < 4; ++m)
#pragma unroll
                    for (int n = 0; n < 2; ++n) acc[a][b][m][n] = (f32x4){0.f, 0.f, 0.f, 0.f};
        cur = nxt; cA = nA; cB = nB; ++ui;
        if constexpr (ALIGN_EPI) { if (wr == 1) PG8_BAR; }
    }
    PG8_WAIT_V(0);
    if constexpr (!ALIGN_EPI) { if (wr == 0) PG8_BAR; }
    PG8_BAR;
#undef PG8_SA
#undef PG8_SB
#undef PG8_STAGE
#undef PG8_LDA
#undef PG8_LDB
#undef PG8_MMA
#undef PG8_WAIT_V
#undef PG8_WAIT_L
#undef PG8_BAR
#undef PG8_SCHED
}


#define EPI_ARGS const f32x4 (&acc)[2][2][4][2], const Unit& u, int wr, int wc, int fr, int fq
#define ROW_OF(ai, m) (u.pm * 256 + (ai) * 128 + wr * 64 + (m) * 16 + fr)
#define COL_OF(bj, n) (u.pn * 256 + (bj) * 128 + wc * 32 + (n) * 16 + fq * 4)
#define FOR_AI_M _Pragma("unroll") for (int ai = 0; ai < 2; ++ai) _Pragma("unroll") for (int m = 0; m < 4; ++m)
#define FOR_BJ_N _Pragma("unroll") for (int bj = 0; bj < 2; ++bj) _Pragma("unroll") for (int n = 0; n < 2; ++n)
#define FOR_BJ _Pragma("unroll") for (int bj = 0; bj < 2; ++bj)
#define COLP(bj) (u.pn * 256 + (bj) * 128 + wc * 32 + fq * 8)

DEV float sumsq4(f32x4 v) { return (v[0] * v[0] + v[1] * v[1]) + (v[2] * v[2] + v[3] * v[3]); }
DEV void row_atomic(u64* dst, int row, float s, int fq) { s += __shfl_xor(s, 16); s += __shfl_xor(s, 32); if (fq == 0) atomicAdd(dst + row, (u64)(s * 4294967296.f)); }
DEV float ssq_get(const u64* p, int row) { return (float)p[row] * 2.3283064365386963e-10f; }

#define ACM f32x4 (&acm)[2][2][4][2] = const_cast<f32x4 (&)[2][2][4][2]>(acc)
#define FOR_AI _Pragma("unroll") for (int ai = 0; ai < 2; ++ai)
#define FOR_M _Pragma("unroll") for (int m = 0; m < 4; ++m)
#define FOR_AI_MH _Pragma("unroll") for (int ai = 0; ai < 2; ++ai) _Pragma("unroll") for (int mh = 0; mh < 4; mh += 2)
#define FOR_M2 _Pragma("unroll") for (int m = mh; m < mh + 2; ++m)
#define FENCE __builtin_amdgcn_sched_barrier(0)
#define PIN(x) asm volatile("" : "+v"(x))
#define GLD(T, base, boff) (*(const T*)((const char*)(base) + (boff)))
#define GST(T, base, boff) (*(T*)((char*)(base) + (boff)))
#define ROWB(ai, m) ((unsigned)(ROW_OF(ai, m) * DM))
struct EpiIn { static constexpr int PM = 1;
    const float* ssq0; const float* rope; const float* b_gate;
    bf16_t *cq, *kpe, *xr, *gy; u64 *ssqq; float oscale;
    DEV void operator()(EPI_ARGS) const {
        const int pn = u.pn;
        float rs[2][4];
        FOR_AI_M rs[ai][m] = ssq0[ROW_OF(ai, m)];
        FOR_AI_M rs[ai][m] = rsqrtf(rs[ai][m] * (1.f / DM) + EPS) * oscale;
        if (pn < 5) {
            FENCE;
            FOR_AI_M { const int row = ROW_OF(ai, m); float s = 0.f;
                const size_t ro = pn < 3 ? (size_t)row * QL : (size_t)6 * 1024 * 1024 + (size_t)row * KVL - 768;
                FOR_BJ { const f32x4 v0 = acc[ai][bj][m][0] * rs[ai][m], v1 = acc[ai][bj][m][1] * rs[ai][m]; s += sumsq4(v0) + sumsq4(v1); *(u32x4*)(cq + ro + COLP(bj)) = pk8(v0, v1); }
                row_atomic(ssqq + (pn < 3 ? 0 : 8192), row, s, fq); FENCE; }
        } else if (pn == 5) {
            if (wc < 2) {
                f32x2 cc_[4], cn_[4];
#pragma unroll
                for (int i = 0; i < 4; ++i) cc_[i] = GLD(f32x2, rope, (unsigned)((ROW_OF(0, 0) * 32 + 16 * wc + 4 * fq + i) * 8));
#pragma unroll
                for (int k = 0; k < 8; ++k) { const int ai = k >> 2, m = k & 3;
                    if (k < 7) {
#pragma unroll
                        for (int i = 0; i < 4; ++i) cn_[i] = GLD(f32x2, rope, (unsigned)((ROW_OF((k + 1) >> 2, (k + 1) & 3) * 32 + 16 * wc + 4 * fq + i) * 8)); }
                    FENCE;
                    { const int row = ROW_OF(ai, m); const f32x4 x1 = acc[ai][0][m][0] * rs[ai][m], x2 = acc[ai][0][m][1] * rs[ai][m]; f32x4 o1, o2;
#pragma unroll
                      for (int i = 0; i < 4; ++i) { o1[i] = x1[i] * cc_[i].x - x2[i] * cc_[i].y; o2[i] = x2[i] * cc_[i].x + x1[i] * cc_[i].y; }
                      *(u32x4*)(kpe + (size_t)row * 64 + 32 * wc + 8 * fq) = pk8(o1, o2); }
                    FENCE;
#pragma unroll
                    for (int i = 0; i < 4; ++i) cc_[i] = cn_[i]; } }
        } else {
            const int seg = (pn - 6) >> 3;
            bf16_t* dst = seg == 0 ? xr : gy + (size_t)(seg - 1) * (16 * 1024 * 1024);
            const int colb = (pn - 6 - 8 * seg) * 256 + wc * 32 + fq * 8;
            f32x4 bb[2][2];
            FOR_BJ_N bb[bj][n] = (f32x4){0.f, 0.f, 0.f, 0.f};
            if (seg >= 2) { FOR_BJ_N bb[bj][n] = *(const f32x4*)(b_gate + (seg - 2) * DM + colb + bj * 128 + 4 * n); }
            FENCE;
            FOR_AI_M { const int row = ROW_OF(ai, m);
                FOR_BJ { const int col = colb + bj * 128; f32x4 v[2];
#pragma unroll
                    for (int n = 0; n < 2; ++n) { v[n] = acc[ai][bj][m][n] * rs[ai][m];
                        if (seg == 1) { v[n][0] = gelu_tanh(v[n][0]); v[n][1] = gelu_tanh(v[n][1]); v[n][2] = gelu_tanh(v[n][2]); v[n][3] = gelu_tanh(v[n][3]); }
                        if (seg >= 2) { v[n][0] = sigmoidf_(v[n][0] + bb[bj][n][0]); v[n][1] = sigmoidf_(v[n][1] + bb[bj][n][1]); v[n][2] = sigmoidf_(v[n][2] + bb[bj][n][2]); v[n][3] = sigmoidf_(v[n][3] + bb[bj][n][3]); } }
                    *(u32x4*)(dst + (size_t)row * DM + col) = pk8(v[0], v[1]); }
                FENCE; }
        }
    }
};
struct EpiQ { static constexpr int PM = 1;
    const u64* ssqq; const float* rope; bf16_t *qn, *qp;
    DEV void operator()(EPI_ARGS) const {
        float rs[2][4];
        FOR_AI_M rs[ai][m] = ssq_get(ssqq, ROW_OF(ai, m));
        FOR_AI_M rs[ai][m] = rsqrtf(rs[ai][m] * (1.f / QL) + EPS);
        if (u.pn < 8) {
            FENCE;
            FOR_AI_M { const int row = ROW_OF(ai, m);
                FOR_BJ { *(u32x4*)(qn + (size_t)row * DM + COLP(bj)) = pk8(acc[ai][bj][m][0] * rs[ai][m], acc[ai][bj][m][1] * rs[ai][m]); } FENCE; }
        } else {
            const int g = wc & 1;
            f32x2 cc_[4], cn_[4];
#pragma unroll
            for (int i = 0; i < 4; ++i) cc_[i] = GLD(f32x2, rope, (unsigned)((ROW_OF(0, 0) * 32 + 16 * g + 4 * fq + i) * 8));
#pragma unroll
            for (int k = 0; k < 8; ++k) { const int ai = k >> 2, m = k & 3;
                if (k < 7) {
#pragma unroll
                    for (int i = 0; i < 4; ++i) cn_[i] = GLD(f32x2, rope, (unsigned)((ROW_OF((k + 1) >> 2, (k + 1) & 3) * 32 + 16 * g + 4 * fq + i) * 8)); }
                FENCE;
                { const int row = ROW_OF(ai, m);
#pragma unroll
                  for (int bj = 0; bj < 2; ++bj) { const f32x4 x1 = acc[ai][bj][m][0] * rs[ai][m], x2 = acc[ai][bj][m][1] * rs[ai][m]; f32x4 o1, o2;
#pragma unroll
                      for (int i = 0; i < 4; ++i) { o1[i] = x1[i] * cc_[i].x - x2[i] * cc_[i].y; o2[i] = x2[i] * cc_[i].x + x1[i] * cc_[i].y; }
                      const int col = (u.pn - 8) * 256 + bj * 128 + wc * 32 + fq * 8; *(u32x4*)(qp + (size_t)row * 1024 + col) = pk8(o1, o2); } }
                FENCE;
#pragma unroll
                for (int i = 0; i < 4; ++i) cc_[i] = cn_[i]; }
        }
    }
};
struct EpiKV { static constexpr int PM = 1;
    const u64* ssqkv; bf16_t *kn, *vv;
    DEV void operator()(EPI_ARGS) const {
        float rs[2][4];
        FOR_AI_M rs[ai][m] = ssq_get(ssqkv, ROW_OF(ai, m));
        FOR_AI_M rs[ai][m] = rsqrtf(rs[ai][m] * (1.f / KVL) + EPS);
        FENCE;
        FOR_AI_M {
            const int row = ROW_OF(ai, m);
            FOR_BJ { bf16_t* dst = bj == 0 ? kn : vv; *(u32x4*)(dst + (size_t)row * DM + u.pn * 128 + wc * 32 + fq * 8) = pk8(acc[ai][bj][m][0] * rs[ai][m], acc[ai][bj][m][1] * rs[ai][m]); }
        }
    }
};
struct EpiGates { static constexpr int PM = 1;
    const float *b_a, *b_x, *n8sp; const bf16_t* xc; bf16_t *la, *gx;
    DEV void operator()(EPI_ARGS) const {
        const int c0 = u.b * 128 + wc * 32 + fq * 8;
        f32x4 ba[2], bx[2], sp[2]; u32x4 xraw[2][4];
#pragma unroll
        for (int n = 0; n < 2; ++n) { ba[n] = *(const f32x4*)(b_a + c0 + 4 * n); bx[n] = *(const f32x4*)(b_x + c0 + 4 * n); sp[n] = *(const f32x4*)(n8sp + c0 + 4 * n); }
        FOR_AI_M xraw[ai][m] = *(const u32x4*)(xc + (size_t)ROW_OF(ai, m) * DM + c0);
        FENCE;
        FOR_AI_M {
            const int row = ROW_OF(ai, m);
            f32x4 lv[2], gv[2];
#pragma unroll
            for (int n = 0; n < 2; ++n) {
                const f32x4 xv = n == 0 ? unpk4lo(xraw[ai][m]) : unpk4hi(xraw[ai][m]);
                f32x4 l, g;
#pragma unroll
                for (int i = 0; i < 4; ++i) { const float r = sigmoidf_(acc[ai][0][m][n][i] + ba[n][i]), ig = sigmoidf_(acc[ai][1][m][n][i] + bx[n][i]); const float lg = sp[n][i] * r, x2 = 2.f * lg;
                    const float em1 = (x2 > -0.02f) ? x2 * (1.f + x2 * (0.5f + x2 * (1.f / 6.f))) : (__expf(x2) - 1.f);
                    l[i] = lg * 1.4426950408889634f; g[i] = (row == 0 ? 1.f : __builtin_amdgcn_sqrtf(fmaxf(-em1, 0.f))) * (ig * xv[i]); }
                lv[n] = l; gv[n] = g; }
            *(u32x4*)(la + (size_t)row * DM + c0) = pk8(lv[0], lv[1]); *(u32x4*)(gx + (size_t)row * DM + c0) = pk8(gv[0], gv[1]);
        }
    }
};
struct EpiMixA { static constexpr int PM = 1; const bf16_t* ga; bf16_t* mixa;
    DEV void operator()(EPI_ARGS) const { ACM; const unsigned cb = (unsigned)(u.pn * 256 + wc * 32 + fq * 8);
        FOR_AI_MH { u32x4 gv[4][2];
            FOR_M2 { const unsigned bo = (ROWB(ai, m) + cb) * 2u; FOR_BJ gv[m][bj] = GLD(u32x4, ga, bo + bj * 256); }
            FOR_M2 FOR_BJ { acm[ai][bj][m][0] = acc[ai][bj][m][0] * (1.f / (O_SCALE * WIN_SCALE)) * unpk4lo(gv[m][bj]); acm[ai][bj][m][1] = acc[ai][bj][m][1] * (1.f / (O_SCALE * WIN_SCALE)) * unpk4hi(gv[m][bj]); PIN(acm[ai][bj][m][0]); PIN(acm[ai][bj][m][1]); }
            FENCE; }
        FOR_AI_M { const unsigned bo = (ROWB(ai, m) + cb) * 2u; FOR_BJ { GST(u32x4, mixa, bo + bj * 256) = pk8(acm[ai][bj][m][0], acm[ai][bj][m][1]); } } } };
struct EpiMix { static constexpr int PM = 1; const bf16_t* gr; const bf16_t* mixa; unsigned char* mix;
    DEV void operator()(EPI_ARGS) const { ACM; const unsigned cb = (unsigned)(u.pn * 256 + wc * 32 + fq * 8);
        FOR_AI_MH { u32x4 ma[4][2], gv[4][2];
            FOR_M2 { const unsigned bo = (ROWB(ai, m) + cb) * 2u; FOR_BJ { ma[m][bj] = GLD(u32x4, mixa, bo + bj * 256); gv[m][bj] = GLD(u32x4, gr, bo + bj * 256); } }
            FOR_M2 FOR_BJ { acm[ai][bj][m][0] = (unpk4lo(ma[m][bj]) + acc[ai][bj][m][0] * (1.f / (Y_SCALE * WIN_SCALE)) * unpk4lo(gv[m][bj])) * MIX_SCALE;
                            acm[ai][bj][m][1] = (unpk4hi(ma[m][bj]) + acc[ai][bj][m][1] * (1.f / (Y_SCALE * WIN_SCALE)) * unpk4hi(gv[m][bj])) * MIX_SCALE; PIN(acm[ai][bj][m][0]); PIN(acm[ai][bj][m][1]); }
            FENCE; }
        FOR_AI_M { const unsigned bo = ROWB(ai, m) + cb; FOR_BJ { GST(u32x2, mix, bo + bj * 128) = (u32x2){f8pack(acm[ai][bj][m][0]), f8pack(acm[ai][bj][m][1])}; } } } };
struct EpiOut { static constexpr int PM = 1; const float* x; bf16_t* h1b; u64* ssq1;
    DEV void operator()(EPI_ARGS) const { const unsigned cb = (unsigned)(u.pn * 256 + wc * 32 + fq * 8);
        f32x4 xc_[2][2], xn_[2][2];
        { const unsigned bo = (ROWB(0, 0) + cb) * 4u; FOR_BJ { xc_[bj][0] = GLD(f32x4, x, bo + bj * 512); xc_[bj][1] = GLD(f32x4, x, bo + bj * 512 + 16); } }
#pragma unroll
        for (int k = 0; k < 8; ++k) { const int ai = k >> 2, m = k & 3;
            if (k < 7) { const unsigned bo = (ROWB((k + 1) >> 2, (k + 1) & 3) + cb) * 4u; FOR_BJ { xn_[bj][0] = GLD(f32x4, x, bo + bj * 512); xn_[bj][1] = GLD(f32x4, x, bo + bj * 512 + 16); } }
            FENCE;
            { const int row = ROW_OF(ai, m); float s = 0.f; const unsigned bo = (ROWB(ai, m) + cb) * 2u;
              FOR_BJ { const f32x4 v0 = xc_[bj][0] + acc[ai][bj][m][0] * (1.f / (MIX_SCALE * WIN_SCALE)), v1 = xc_[bj][1] + acc[ai][bj][m][1] * (1.f / (MIX_SCALE * WIN_SCALE));
                  s += sumsq4(v0) + sumsq4(v1); GST(u32x4, h1b, bo + bj * 256) = pk8(v0, v1); }
              row_atomic(ssq1, row, s, fq); }
            FENCE;
            FOR_BJ { xc_[bj][0] = xn_[bj][0]; xc_[bj][1] = xn_[bj][1]; } } } };
struct EpiPeerQ { static constexpr int PM = 0; const u64* ssq1; bf16_t* q;
    DEV void operator()(EPI_ARGS) const { FOR_AI_M { const int row = ROW_OF(ai, m); const float rs = rsqrtf(ssq_get(ssq1, row) * (1.f / DM) + EPS);
        FOR_BJ_N { *(u32x2*)(q + (size_t)row * DM + COL_OF(bj, n)) = pk4(acc[ai][bj][m][n] * rs); } } } };
struct EpiPlain { static constexpr int PM = 1; bf16_t* o;
    DEV void operator()(EPI_ARGS) const { FOR_AI_M { const int row = ROW_OF(ai, m); FOR_BJ { *(u32x4*)(o + (size_t)row * DM + COLP(bj)) = pk8(acc[ai][bj][m][0], acc[ai][bj][m][1]); } } } };
struct EpiScores { static constexpr int PM = 0; float* sc; const u64* ssq1;
    DEV void operator()(EPI_ARGS) const {
        float rs[2][4];
        FOR_AI_M rs[ai][m] = ssq_get(ssq1, ROW_OF(ai, m));
        FOR_AI_M rs[ai][m] = rsqrtf(rs[ai][m] * (1.f / DM) + EPS);
        FENCE;
        FOR_AI_M { const int row = ROW_OF(ai, m);
        const unsigned i0 = (unsigned)((((row >> 5) * 16 + u.pn * 2) * 128 + wc * 32 + fq * 4) * 32 + (row & 31));
#pragma unroll
        for (int bj = 0; bj < 2; ++bj)
#pragma unroll
            for (int n = 0; n < 2; ++n) { const f32x4 v = acc[ai][bj][m][n] * rs[ai][m]; const unsigned i1 = i0 + bj * 4096 + n * 512; sc[i1] = v[0]; sc[i1 + 32] = v[1]; sc[i1 + 64] = v[2]; sc[i1 + 96] = v[3]; }
        FENCE; } } };
struct EpiWf { static constexpr int PM = 1; bf16_t* o;
    DEV void operator()(EPI_ARGS) const { FOR_AI_M { const int row = u.b * 256 + ai * 128 + wr * 64 + m * 16 + fr; FOR_BJ { *(u32x4*)(o + (size_t)row * DM + COLP(bj)) = pk8(acc[ai][bj][m][0], acc[ai][bj][m][1]); } } } };
struct EpiPle { static constexpr int PM = 0; const bf16_t* pp; const bf16_t* h; float* hout; u64* ssq3; const float* ssq2;
    DEV void operator()(EPI_ARGS) const {
        const unsigned cb = (unsigned)(u.pn * 256 + wc * 32 + fq * 4);
        float rs2[2][4];
        FOR_AI_M rs2[ai][m] = ssq2[ROW_OF(ai, m)];
        FOR_AI_M rs2[ai][m] = rsqrtf(rs2[ai][m] * (1.f / DM) + EPS) * (1.f / (WIN_SCALE * X_SCALE));
        u32x2 pc_[2][2], hc_[2][2], pn_[2][2], hn_[2][2];
        { const unsigned bo = (ROWB(0, 0) + cb) * 2u; FOR_BJ_N { pc_[bj][n] = GLD(u32x2, pp, bo + bj * 256 + n * 32); hc_[bj][n] = GLD(u32x2, h, bo + bj * 256 + n * 32); } }
#pragma unroll
        for (int k = 0; k < 8; ++k) { const int ai = k >> 2, m = k & 3;
            if (k < 7) { const unsigned bo = (ROWB((k + 1) >> 2, (k + 1) & 3) + cb) * 2u; FOR_BJ_N { pn_[bj][n] = GLD(u32x2, pp, bo + bj * 256 + n * 32); hn_[bj][n] = GLD(u32x2, h, bo + bj * 256 + n * 32); } }
            FENCE;
            { const int row = ROW_OF(ai, m); float s = 0.f; const unsigned bo = (ROWB(ai, m) + cb) * 4u;
              FOR_BJ_N { const f32x4 a = acc[ai][bj][m][n] * rs2[ai][m], p4 = unpk4(pc_[bj][n]); f32x4 v = unpk4(hc_[bj][n]);
                  v[0] += sigmoidf_(a[0]) * p4[0]; v[1] += sigmoidf_(a[1]) * p4[1]; v[2] += sigmoidf_(a[2]) * p4[2]; v[3] += sigmoidf_(a[3]) * p4[3]; s += sumsq4(v);
                  GST(f32x4, hout, bo + bj * 512 + n * 64) = v; }
              row_atomic(ssq3, row, s, fq); }
            FENCE;
            FOR_BJ_N { pc_[bj][n] = pn_[bj][n]; hc_[bj][n] = hn_[bj][n]; } } } };
struct EpiPleFinal { static constexpr int PM = 0; const bf16_t* pp; const bf16_t* h; float* out; u64* ssq3; const float* ssq2; const float* fn; unsigned* pcnt;
    DEV void operator()(EPI_ARGS) const { ACM;
        const unsigned cb = (unsigned)(u.pn * 256 + wc * 32 + fq * 4);
        float rs2[2][4];
        FOR_AI_M rs2[ai][m] = ssq2[ROW_OF(ai, m)];
        FOR_AI_M rs2[ai][m] = rsqrtf(rs2[ai][m] * (1.f / DM) + EPS) * (1.f / (WIN_SCALE * X_SCALE));
        u32x2 pc_[2][2], hc_[2][2], pn_[2][2], hn_[2][2];
        { const unsigned bo = (ROWB(0, 0) + cb) * 2u; FOR_BJ_N { pc_[bj][n] = GLD(u32x2, pp, bo + bj * 256 + n * 32); hc_[bj][n] = GLD(u32x2, h, bo + bj * 256 + n * 32); } }
#pragma unroll
        for (int k = 0; k < 8; ++k) { const int ai = k >> 2, m = k & 3;
            if (k < 7) { const unsigned bo = (ROWB((k + 1) >> 2, (k + 1) & 3) + cb) * 2u; FOR_BJ_N { pn_[bj][n] = GLD(u32x2, pp, bo + bj * 256 + n * 32); hn_[bj][n] = GLD(u32x2, h, bo + bj * 256 + n * 32); } }
            FENCE;
            { const int row = ROW_OF(ai, m); float s = 0.f;
              FOR_BJ_N { const f32x4 a = acm[ai][bj][m][n] * rs2[ai][m], p4 = unpk4(pc_[bj][n]); f32x4 v = unpk4(hc_[bj][n]);
                  v[0] += sigmoidf_(a[0]) * p4[0]; v[1] += sigmoidf_(a[1]) * p4[1]; v[2] += sigmoidf_(a[2]) * p4[2]; v[3] += sigmoidf_(a[3]) * p4[3]; s += sumsq4(v);
                  acm[ai][bj][m][n] = v; }
              row_atomic(ssq3, row, s, fq); }
            FENCE;
            FOR_BJ_N { pc_[bj][n] = pn_[bj][n]; hc_[bj][n] = hn_[bj][n]; } }
        asm volatile("s_waitcnt vmcnt(0)" ::: "memory");
        __syncthreads();
        if (threadIdx.x == 0) {
            unsigned* c_ = pcnt + 64 * u.pm;
            __hip_atomic_fetch_add(c_, 1u, __ATOMIC_RELAXED, __HIP_MEMORY_SCOPE_AGENT);
            unsigned sp_ = 0;
            while (__hip_atomic_load(c_, __ATOMIC_RELAXED, __HIP_MEMORY_SCOPE_AGENT) < 8u) { __builtin_amdgcn_s_sleep(1); if (++sp_ > (1u << 20)) break; }
            __builtin_amdgcn_fence(__ATOMIC_ACQUIRE, "agent");
            asm volatile("s_waitcnt vmcnt(0)" ::: "memory");
        }
        __syncthreads();
        float rs[2][4]; f32x4 fnv[2][2];
        FOR_BJ_N fnv[bj][n] = *(const f32x4*)(fn + COL_OF(bj, n));
        FOR_AI_M rs[ai][m] = (float)__hip_atomic_load(ssq3 + ROW_OF(ai, m), __ATOMIC_RELAXED, __HIP_MEMORY_SCOPE_AGENT);
        FOR_AI_M rs[ai][m] = rsqrtf(rs[ai][m] * 2.3283064365386963e-10f * (1.f / DM) + EPS);
        FENCE;
        FOR_AI_M { const unsigned bo = (ROWB(ai, m) + cb) * 4u;
            FOR_BJ_N { GST(f32x4, out, bo + bj * 512 + n * 64) = acm[ai][bj][m][n] * rs[ai][m] * fnv[bj][n]; } FENCE; }
    }
};

DEV void attn_simple(float* lds, const bf16_t* qn, const bf16_t* qp, const bf16_t* kn, const bf16_t* kpe, const bf16_t* vv, bf16_t* o_out) {
    const int tid = threadIdx.x, sub = tid & 7, rloc = tid >> 3;
    float* Ks = lds;
    float* Vs = lds + 32 * 196;
    const int nunits = NH * (S / 64);
    for (int ui = blockIdx.x; ui < nunits; ui += gridDim.x) {
        const int h = ui & 15, qb = (S / 64 - 1) - (ui >> 4);
        const int t = qb * 64 + rloc;
        float q[24];
        { const u32x4 a = *(const u32x4*)(qn + (size_t)t * DM + h * 128 + sub * 16), b = *(const u32x4*)(qn + (size_t)t * DM + h * 128 + sub * 16 + 8);
          const u32x4 c = *(const u32x4*)(qp + (size_t)t * 1024 + h * 64 + sub * 8);
          q[0] = bflo(a.x); q[1] = bfhi(a.x); q[2] = bflo(a.y); q[3] = bfhi(a.y); q[4] = bflo(a.z); q[5] = bfhi(a.z); q[6] = bflo(a.w); q[7] = bfhi(a.w);
          q[8] = bflo(b.x); q[9] = bfhi(b.x); q[10] = bflo(b.y); q[11] = bfhi(b.y); q[12] = bflo(b.z); q[13] = bfhi(b.z); q[14] = bflo(b.w); q[15] = bfhi(b.w);
          q[16] = bflo(c.x); q[17] = bfhi(c.x); q[18] = bflo(c.y); q[19] = bfhi(c.y); q[20] = bflo(c.z); q[21] = bfhi(c.z); q[22] = bflo(c.w); q[23] = bfhi(c.w); }
        float o[16];
#pragma unroll
        for (int i = 0; i < 16; ++i) o[i] = 0.f;
        float mrun = -1e30f, l = 0.f;
        const int ntiles = 2 * qb + 2;
        for (int kt = 0; kt < ntiles; ++kt) {
            __syncthreads();
            {
                const int key = tid >> 4, c8 = (tid & 15) * 8; const size_t tk = (size_t)(kt * 32 + key);
                const u32x4 a = *(const u32x4*)(kn + tk * DM + h * 128 + c8), b = *(const u32x4*)(vv + tk * DM + h * 128 + c8);
                float* kd = Ks + key * 196 + c8; float* vd = Vs + key * 132 + c8;
                *(f32x4*)kd = (f32x4){bflo(a.x), bfhi(a.x), bflo(a.y), bfhi(a.y)}; *(f32x4*)(kd + 4) = (f32x4){bflo(a.z), bfhi(a.z), bflo(a.w), bfhi(a.w)};
                *(f32x4*)vd = (f32x4){bflo(b.x), bfhi(b.x), bflo(b.y), bfhi(b.y)}; *(f32x4*)(vd + 4) = (f32x4){bflo(b.z), bfhi(b.z), bflo(b.w), bfhi(b.w)};
                if (tid < 256) { const int key2 = tid >> 3, d8 = (tid & 7) * 8; const u32x4 c = *(const u32x4*)(kpe + (size_t)(kt * 32 + key2) * 64 + d8);
                    float* pd = Ks + key2 * 196 + 128 + d8;
                    *(f32x4*)pd = (f32x4){bflo(c.x), bfhi(c.x), bflo(c.y), bfhi(c.y)}; *(f32x4*)(pd + 4) = (f32x4){bflo(c.z), bfhi(c.z), bflo(c.w), bfhi(c.w)}; }
            }
            __syncthreads();
#pragma unroll 1
            for (int j0 = 0; j0 < 32; j0 += 8) {
                float sc[8]; float tmax = -1e30f;
#pragma unroll
                for (int jj = 0; jj < 8; ++jj) {
                    const float* kr = Ks + (j0 + jj) * 196;
                    float p = 0.f;
#pragma unroll
                    for (int d4 = 0; d4 < 4; ++d4) { const f32x4 kv = *(const f32x4*)(kr + sub * 16 + d4 * 4); p += (q[d4 * 4] * kv[0] + q[d4 * 4 + 1] * kv[1]) + (q[d4 * 4 + 2] * kv[2] + q[d4 * 4 + 3] * kv[3]); }
#pragma unroll
                    for (int d4 = 0; d4 < 2; ++d4) { const f32x4 kv = *(const f32x4*)(kr + 128 + sub * 8 + d4 * 4); p += (q[16 + d4 * 4] * kv[0] + q[17 + d4 * 4] * kv[1]) + (q[18 + d4 * 4] * kv[2] + q[19 + d4 * 4] * kv[3]); }
                    p += __shfl_xor(p, 1); p += __shfl_xor(p, 2); p += __shfl_xor(p, 4);
                    if (kt * 32 + j0 + jj > t) p = -__builtin_inff();
                    sc[jj] = p; tmax = fmaxf(tmax, p);
                }
                const float mn = fmaxf(mrun, tmax), alpha = exp2f(mrun - mn); mrun = mn;
                l *= alpha;
#pragma unroll
                for (int i = 0; i < 16; ++i) o[i] *= alpha;
#pragma unroll
                for (int jj = 0; jj < 8; ++jj) {
                    const float p = exp2f(sc[jj] - mn); l += p;
                    const float* vr = Vs + (j0 + jj) * 132 + sub * 16;
#pragma unroll
                    for (int d4 = 0; d4 < 4; ++d4) { const f32x4 v4 = *(const f32x4*)(vr + d4 * 4); o[d4 * 4] += p * v4[0]; o[d4 * 4 + 1] += p * v4[1]; o[d4 * 4 + 2] += p * v4[2]; o[d4 * 4 + 3] += p * v4[3]; }
                }
            }
        }
        const float il = 1.f / l;
        u32x4 w0, w1;
        w0.x = pk2(o[0] * il, o[1] * il); w0.y = pk2(o[2] * il, o[3] * il); w0.z = pk2(o[4] * il, o[5] * il); w0.w = pk2(o[6] * il, o[7] * il);
        w1.x = pk2(o[8] * il, o[9] * il); w1.y = pk2(o[10] * il, o[11] * il); w1.z = pk2(o[12] * il, o[13] * il); w1.w = pk2(o[14] * il, o[15] * il);
        *(u32x4*)(o_out + (size_t)t * DM + h * 128 + sub * 16) = w0; *(u32x4*)(o_out + (size_t)t * DM + h * 128 + sub * 16 + 8) = w1;
    }
}


typedef short s16x4 __attribute__((ext_vector_type(4)));
typedef float f32x16 __attribute__((ext_vector_type(16)));
constexpr int AT_SHM_V = 64 * 128 * 2, AT_SHM_K = 64 * 128 * 2, AT_SHM_P = 64 * 64 * 2;
constexpr int AT_V = 0, AT_K = 2 * AT_SHM_V, AT_P = AT_K + 2 * AT_SHM_K, AT_WS = AT_P + 2 * AT_SHM_P, AT_LDS = AT_WS + 8 * 64 * 4;
#define KSWZ(row, colB) ((row) * 256 + ((colB) ^ (((row) & 7) << 4)))
#define PSWZ(row, ch) ((row) * 128 + ((((ch) ^ (((row) >> 1) & 7))) << 4))
#define SBAR() __builtin_amdgcn_sched_barrier(0)
DEV int v_st(int k, int c) { const int kk = (k & ~0xC) | ((k & 4) << 1) | ((k & 8) >> 1); return ((kk >> 3) * 4 + (c >> 5)) * 512 + ((kk & 7) * 32 + (c & 31)) * 2; }
DEV int v_rd_base(int lane) { return ((lane & 3) << 3) | (((lane >> 2) & 3) << 6) | (((lane >> 4) & 1) << 5) | (((lane >> 5) & 1) << 8); }
constexpr int v_rd_off(int d0, int ks, int half) { return d0 * 512 + ks * 4096 + half * 2048; }
DEV int crow(int r, int hi) { return (r & 3) + 8 * (r >> 2) + 4 * hi; }
DEV unsigned cvtpk(float lo, float hi) { unsigned r; asm volatile("v_cvt_pk_bf16_f32 %0, %1, %2" : "=v"(r) : "v"(lo), "v"(hi)); return r; }
DEV void at_mask(f32x16& p0, f32x16& p1, int dq) {
    const float NEG = -__builtin_inff();
#pragma unroll
    for (int r = 0; r < 16; ++r) { const int c = (r & 3) + 8 * (r >> 2); if (dq - c < 0) p0[r] = NEG; if (dq - c - 32 < 0) p1[r] = NEG; }
}
constexpr float AT_THR = 11.5f;
DEV void at_partialSM(f32x16& p0, f32x16& p1, float& m_reg, float& alpha) {
    float pmax = p0[0];
#pragma unroll
    for (int r = 1; r < 16; ++r) pmax = fmaxf(pmax, p0[r]);
#pragma unroll
    for (int r = 0; r < 16; ++r) pmax = fmaxf(pmax, p1[r]);
    { auto rr = __builtin_amdgcn_permlane32_swap(__float_as_uint(pmax), __float_as_uint(pmax), false, false); pmax = fmaxf(__uint_as_float(rr[0]), __uint_as_float(rr[1])); }
    float mn;
    if (__builtin_expect(__all((pmax - m_reg) <= AT_THR), 1)) { mn = m_reg; alpha = 1.f; }
    else { mn = fmaxf(m_reg, pmax); alpha = __builtin_amdgcn_exp2f(m_reg - mn); m_reg = mn; }
#pragma unroll
    for (int r = 0; r < 16; ++r) { p0[r] = __builtin_amdgcn_exp2f(p0[r] - mn); p1[r] = __builtin_amdgcn_exp2f(p1[r] - mn); }
}
DEV void at_finishSM(const f32x16& p0, const f32x16& p1, float alpha, float& l_reg, bf16x8& pa0, bf16x8& pa1, bf16x8& pa2, bf16x8& pa3) {
    float ps = 0;
#pragma unroll
    for (int r = 0; r < 16; ++r) ps += p0[r];
#pragma unroll
    for (int r = 0; r < 16; ++r) ps += p1[r];
    { auto rr = __builtin_amdgcn_permlane32_swap(__float_as_uint(ps), __float_as_uint(ps), false, false); ps = __uint_as_float(rr[0]) + __uint_as_float(rr[1]); }
    l_reg = l_reg * alpha + ps;
#define PK4(P, B_, OUT) do { unsigned a0 = cvtpk(P[B_+0], P[B_+1]), a1 = cvtpk(P[B_+2], P[B_+3]); unsigned b0 = cvtpk(P[B_+4], P[B_+5]), b1 = cvtpk(P[B_+6], P[B_+7]); \
        auto r0 = __builtin_amdgcn_permlane32_swap(a0, b0, false, false); auto r1 = __builtin_amdgcn_permlane32_swap(a1, b1, false, false); \
        u32x4 w = {r0[0], r1[0], r0[1], r1[1]}; OUT = *reinterpret_cast<bf16x8*>(&w); } while (0)
    PK4(p0, 0, pa0); PK4(p0, 8, pa1); PK4(p1, 0, pa2); PK4(p1, 8, pa3);
#undef PK4
}
template <int KB>
DEV void at_qkt(f32x16& p0, f32x16& p1, const char* lds, int r32, int hi, const bf16x8* qr) {
    p0 = f32x16{}; p1 = f32x16{};
#pragma unroll
    for (int g = 0; g < 2; ++g) {
        bf16x8 b0[4], b1[4];
#pragma unroll
        for (int dd = 0; dd < 4; ++dd) { const char* a = lds + AT_K + KB * AT_SHM_K + KSWZ(r32, (dd * 16 + hi * 8) * 2) + g * 128;
            b0[dd] = *reinterpret_cast<const bf16x8*>(a); b1[dd] = *reinterpret_cast<const bf16x8*>(a + 32 * 256); }
#pragma unroll
        for (int dd = 0; dd < 4; ++dd) { p0 = __builtin_amdgcn_mfma_f32_32x32x16_bf16(b0[dd], qr[g * 4 + dd], p0, 0, 0, 0); p1 = __builtin_amdgcn_mfma_f32_32x32x16_bf16(b1[dd], qr[g * 4 + dd], p1, 0, 0, 0); }
        SBAR();
    }
    {
        bf16x8 b0[4], b1[4];
#pragma unroll
        for (int d0 = 0; d0 < 4; ++d0) { const char* a = lds + AT_P + KB * AT_SHM_P + PSWZ(r32, 2 * d0 + hi);
            b0[d0] = *reinterpret_cast<const bf16x8*>(a); b1[d0] = *reinterpret_cast<const bf16x8*>(a + 32 * 128); }
#pragma unroll
        for (int d0 = 0; d0 < 4; ++d0) { p0 = __builtin_amdgcn_mfma_f32_32x32x16_bf16(b0[d0], qr[8 + d0], p0, 0, 0, 0); p1 = __builtin_amdgcn_mfma_f32_32x32x16_bf16(b1[d0], qr[8 + d0], p1, 0, 0, 0); }
        SBAR();
    }
}
template <int VB>
DEV void at_pv(f32x16* o, int vb0, bf16x8 pa0, bf16x8 pa1, bf16x8 pa2, bf16x8 pa3) {
#define TRRD(dst, off) asm volatile("ds_read_b64_tr_b16 %0, %1 offset:%2" : "=&v"(dst) : "v"(vb0), "i"(off) : "memory")
#define PV_D0(d0) do { s16x4 l0, l1, l2, l3, h0, h1, h2, h3; constexpr int b_ = AT_V + VB * AT_SHM_V + v_rd_off(d0, 0, 0); \
        TRRD(l0, b_); TRRD(h0, b_ + 2048); TRRD(l1, b_ + 4096); TRRD(h1, b_ + 6144); TRRD(l2, b_ + 8192); TRRD(h2, b_ + 10240); TRRD(l3, b_ + 12288); TRRD(h3, b_ + 14336); \
        asm volatile("s_waitcnt lgkmcnt(0)" ::: "memory"); SBAR(); \
        o[d0] = __builtin_amdgcn_mfma_f32_32x32x16_bf16(pa0, (bf16x8){l0[0], l0[1], l0[2], l0[3], h0[0], h0[1], h0[2], h0[3]}, o[d0], 0, 0, 0); \
        o[d0] = __builtin_amdgcn_mfma_f32_32x32x16_bf16(pa1, (bf16x8){l1[0], l1[1], l1[2], l1[3], h1[0], h1[1], h1[2], h1[3]}, o[d0], 0, 0, 0); \
        o[d0] = __builtin_amdgcn_mfma_f32_32x32x16_bf16(pa2, (bf16x8){l2[0], l2[1], l2[2], l2[3], h2[0], h2[1], h2[2], h2[3]}, o[d0], 0, 0, 0); \
        o[d0] = __builtin_amdgcn_mfma_f32_32x32x16_bf16(pa3, (bf16x8){l3[0], l3[1], l3[2], l3[3], h3[0], h3[1], h3[2], h3[3]}, o[d0], 0, 0, 0); } while (0)
    PV_D0(0); PV_D0(1); PV_D0(2); PV_D0(3);
#undef PV_D0
#undef TRRD
}
DEV void attn_unit(char* lds, int h, int qb, const bf16_t* qn, const bf16_t* qp, const bf16_t* kn, const bf16_t* kpe, const bf16_t* vv, bf16_t* o_out) {
    const int tid = threadIdx.x, wid = __builtin_amdgcn_readfirstlane(tid >> 6), lane = tid & 63, r32 = lane & 31, hi = lane >> 5;
    const int q0 = qb * 256, qlo = q0 + wid * 32, NT = 4 * (qb + 1);
    float* ws = (float*)(lds + AT_WS) + wid * 64; float* li_l = ws; float* al_l = ws + 32;
    unsigned kof[2], vof[2], pof;
#pragma unroll
    for (int i = 0; i < 2; ++i) { const int off = (wid * 2 + i) * 1024 + lane * 16;
        { const int row = off >> 8, colB = (off & 255) ^ ((row & 7) << 4); kof[i] = (unsigned)(row * DM + h * 128 + (colB >> 1)); }
        { const int sub = off >> 9, within = off & 511, kk = (sub >> 2) * 8 + (within >> 6), c = (sub & 3) * 32 + ((within & 63) >> 1);
          const int k = (kk & ~0xC) | ((kk & 4) << 1) | ((kk & 8) >> 1); vof[i] = (unsigned)(k * DM + h * 128 + c); } }
    { const int off = wid * 1024 + lane * 16, row = off >> 7, ch = ((off >> 4) & 7) ^ ((row >> 1) & 7); pof = (unsigned)(row * 64 + ch * 8); }
    const int vb0 = (int)(uintptr_t)lds + v_rd_base(lane);
    LAS unsigned char* l3 = (LAS unsigned char*)(uintptr_t)lds;
#define AT_GLDS(gp, lo) __builtin_amdgcn_global_load_lds((const unsigned*)(gp), (LAS unsigned*)(l3 + (lo)), 16, 0, 0)
#define AT_STAGE(t, B) do { const bf16_t* kt_ = kn + (size_t)(t) * 64 * DM; const bf16_t* vt_ = vv + (size_t)(t) * 64 * DM; const bf16_t* pt_ = kpe + (size_t)(t) * 64 * 64; \
        AT_GLDS(kt_ + kof[0], AT_K + (B) * AT_SHM_K + (wid * 2 + 0) * 1024); AT_GLDS(kt_ + kof[1], AT_K + (B) * AT_SHM_K + (wid * 2 + 1) * 1024); \
        AT_GLDS(vt_ + vof[0], AT_V + (B) * AT_SHM_V + (wid * 2 + 0) * 1024); AT_GLDS(vt_ + vof[1], AT_V + (B) * AT_SHM_V + (wid * 2 + 1) * 1024); \
        AT_GLDS(pt_ + pof, AT_P + (B) * AT_SHM_P + wid * 1024); } while (0)
    AT_STAGE(0, 0);
    bf16x8 qr[12];
    { const bf16_t* qrow = qn + (size_t)(qlo + r32) * DM + h * 128 + hi * 8; const bf16_t* prow = qp + (size_t)(qlo + r32) * 1024 + h * 64 + hi * 8;
#pragma unroll
      for (int d0 = 0; d0 < 8; ++d0) qr[d0] = *(const bf16x8*)(qrow + d0 * 16);
#pragma unroll
      for (int d0 = 0; d0 < 4; ++d0) qr[8 + d0] = *(const bf16x8*)(prow + d0 * 16); }
    asm volatile("s_waitcnt vmcnt(0)" ::: "memory");
    __syncthreads();
    float m_reg = -1e30f, l_reg = 0.f; f32x16 o[4] = {};
    const int qm = qlo + r32 - 4 * hi;
#define AT_STEP(t, B) do { \
        if ((t) + 1 < NT) AT_STAGE((t) + 1, (B) ^ 1); \
        f32x16 p0, p1; at_qkt<B>(p0, p1, lds, r32, hi, qr); \
        if ((t) * 64 + 63 > qlo) at_mask(p0, p1, qm - (t) * 64); \
        SBAR(); float alpha; at_partialSM(p0, p1, m_reg, alpha); SBAR(); \
        if (__any(alpha < 1.f)) { if (hi == 0) al_l[r32] = alpha; asm volatile("s_waitcnt lgkmcnt(0)" ::: "memory"); \
            _Pragma("unroll") for (int r = 0; r < 16; ++r) { const float a_ = al_l[crow(r, hi)]; o[0][r] *= a_; o[1][r] *= a_; o[2][r] *= a_; o[3][r] *= a_; if ((r & 3) == 3) SBAR(); } } \
        SBAR(); bf16x8 pa0, pa1, pa2, pa3; at_finishSM(p0, p1, alpha, l_reg, pa0, pa1, pa2, pa3); SBAR(); \
        at_pv<B>(o, vb0, pa0, pa1, pa2, pa3); \
        asm volatile("s_waitcnt vmcnt(0)" ::: "memory"); \
        __syncthreads(); } while (0)
    for (int t = 0; t < NT; t += 2) { AT_STEP(t, 0); AT_STEP(t + 1, 1); }
    if (hi == 0) li_l[r32] = l_reg; asm volatile("s_waitcnt lgkmcnt(0)" ::: "memory");
    float rli[16];
#pragma unroll
    for (int r = 0; r < 16; ++r) rli[r] = __builtin_amdgcn_rcpf(li_l[crow(r, hi)]);
    unsigned char* Ow = (unsigned char*)o_out + (size_t)qlo * DM + h * 128;
#pragma unroll
    for (int r = 0; r < 16; ++r) { const int orow = crow(r, hi);
#pragma unroll
        for (int d0 = 0; d0 < 4; ++d0) { const float v = o[d0][r] * rli[r] * O_SCALE; const float vn = __shfl_xor(v, 1);
            const unsigned w16 = __builtin_amdgcn_cvt_pk_fp8_f32(v, vn, 0u, false) & 0xffffu; const unsigned w16n = (unsigned)__shfl_xor((int)w16, 2);
            if ((r32 & 3) == 0) *(unsigned*)(Ow + (size_t)orow * DM + d0 * 32 + r32) = w16 | (w16n << 16); } }
    __syncthreads();
#undef AT_GLDS
#undef AT_STAGE
#undef AT_STEP
}
DEV void attn_mfma(char* lds, const bf16_t* qn, const bf16_t* qp, const bf16_t* kn, const bf16_t* kpe, const bf16_t* vv, bf16_t* o_out) {
    for (int it = blockIdx.x; it < 256; it += gridDim.x) {
        const int vid = (gridDim.x == 256) ? ((it & 7) * 32 + (it >> 3)) : it;
        const int h = vid >> 4, j = vid & 15;
        attn_unit(lds, h, 31 - j, qn, qp, kn, kpe, vv, o_out);
        attn_unit(lds, h, j, qn, qp, kn, kpe, vv, o_out);
    }
}

DEV void wave_argmax(float& v, int& idx) {
#pragma unroll
    for (int o = 1; o < 64; o <<= 1) { const float ov = __shfl_xor(v, o); const int oi = __shfl_xor(idx, o);
        if (ov > v || (ov == v && oi < idx)) { v = ov; idx = oi; } }
}
DEV void peer_phase(float* lds, const float* sc, const float* h1, const bf16_t* h1b, const u64* ssq1, const bf16_t* tu, const bf16_t* tv, float* h2, bf16_t* xn3) {
    const int tid = threadIdx.x, lane = tid & 63, wid = tid >> 6;
    int* ex = (int*)(lds + wid * 256);
    float* gt = lds + wid * 256 + 128;
    const float NEG = -__builtin_inff();
    for (int t = blockIdx.x * 8 + wid; t < S; t += gridDim.x * 8) {
        for (int h = 0; h < PH; ++h) {
            const float* sp = sc + (size_t)t * DM + h * 256;
            float tvv[2]; int tii[2];
#pragma unroll
            for (int c = 0; c < 2; ++c) {
                float a = sp[c * 128 + lane], b = sp[c * 128 + 64 + lane];
                float keepv = NEG; int keepi = 0;
                for (int r = 0; r < TOPK; ++r) {
                    float v; int idx; if (b > a) { v = b; idx = lane + 64; } else { v = a; idx = lane; }
                    wave_argmax(v, idx);
                    if (idx == lane) a = NEG; if (idx == lane + 64) b = NEG;
                    if (lane == r) { keepv = v; keepi = idx; }
                }
                tvv[c] = keepv; tii[c] = keepi;
            }
            const float a1 = __shfl(tvv[0], lane >> 2);
            float cv[4];
#pragma unroll
            for (int j = 0; j < 4; ++j) cv[j] = a1 + __shfl(tvv[1], (lane & 3) * 4 + j);
            float bs = NEG; int bc = 0;
            for (int r = 0; r < TOPK; ++r) {
                float v = cv[0]; int idx = lane * 4;
#pragma unroll
                for (int j = 1; j < 4; ++j) if (cv[j] > v) { v = cv[j]; idx = lane * 4 + j; }
                wave_argmax(v, idx);
                if ((idx >> 2) == lane) {
#pragma unroll
                    for (int j = 0; j < 4; ++j) if ((idx & 3) == j) cv[j] = NEG;
                }
                if (lane == r) { bs = v; bc = idx; }
            }
            const int i1 = __shfl(tii[0], bc >> 4), i2 = __shfl(tii[1], bc & 15);
            const float mx = __shfl(bs, 0);
            float e = (lane < 16) ? __expf(bs - mx) : 0.f;
            float sum = e;
#pragma unroll
            for (int o = 1; o < 16; o <<= 1) sum += __shfl_xor(sum, o);
            if (lane < 16) { ex[h * 16 + lane] = i1 * NK + i2; gt[h * 16 + lane] = e / sum; }
        }
        asm volatile("s_waitcnt lgkmcnt(0)" ::: "memory");
        const float rs1 = rsqrtf(ssq_get(ssq1, t) * (1.f / DM) + EPS);
        float hv[32];
#pragma unroll
        for (int j = 0; j < 4; ++j) { const u32x4 w = *(const u32x4*)(h1b + (size_t)t * DM + j * 512 + lane * 8);
            hv[j * 8 + 0] = bflo(w.x); hv[j * 8 + 1] = bfhi(w.x); hv[j * 8 + 2] = bflo(w.y); hv[j * 8 + 3] = bfhi(w.y);
            hv[j * 8 + 4] = bflo(w.z); hv[j * 8 + 5] = bfhi(w.z); hv[j * 8 + 6] = bflo(w.w); hv[j * 8 + 7] = bfhi(w.w); }
        float ac[32];
#pragma unroll
        for (int i = 0; i < 32; ++i) ac[i] = 0.f;
        for (int k = 0; k < PH * TOPK * DBG_PEER; ++k) {
            const int e = ex[k]; const float g = gt[k];
            const bf16_t* ur = tu + (size_t)e * DM + lane * 8; const bf16_t* vr = tv + (size_t)e * DM + lane * 8;
            u32x4 uw[4], vw[4];
#pragma unroll
            for (int j = 0; j < 4; ++j) { uw[j] = *(const u32x4*)(ur + j * 512); vw[j] = *(const u32x4*)(vr + j * 512); }
            float d = 0.f;
#pragma unroll
            for (int j = 0; j < 4; ++j) { d += hv[j * 8 + 0] * bflo(uw[j].x) + hv[j * 8 + 1] * bfhi(uw[j].x) + hv[j * 8 + 2] * bflo(uw[j].y) + hv[j * 8 + 3] * bfhi(uw[j].y)
                                             + hv[j * 8 + 4] * bflo(uw[j].z) + hv[j * 8 + 5] * bfhi(uw[j].z) + hv[j * 8 + 6] * bflo(uw[j].w) + hv[j * 8 + 7] * bfhi(uw[j].w); }
            d = wave_sum(d);
            const float w = g * gelu_tanh(d * rs1);
#pragma unroll
            for (int j = 0; j < 4; ++j) { ac[j * 8 + 0] += w * bflo(vw[j].x); ac[j * 8 + 1] += w * bfhi(vw[j].x); ac[j * 8 + 2] += w * bflo(vw[j].y); ac[j * 8 + 3] += w * bfhi(vw[j].y);
                                          ac[j * 8 + 4] += w * bflo(vw[j].z); ac[j * 8 + 5] += w * bfhi(vw[j].z); ac[j * 8 + 6] += w * bflo(vw[j].w); ac[j * 8 + 7] += w * bfhi(vw[j].w); }
        }
        float ss = 0.f;
#pragma unroll
        for (int j = 0; j < 4; ++j) { const size_t o = (size_t)t * DM + j * 512 + lane * 8;
            const f32x4 x0 = *(const f32x4*)(h1 + o), x1 = *(const f32x4*)(h1 + o + 4);
#pragma unroll
            for (int i = 0; i < 4; ++i) { ac[j * 8 + i] += x0[i]; ac[j * 8 + 4 + i] += x1[i]; }
#pragma unroll
            for (int i = 0; i < 8; ++i) ss += ac[j * 8 + i] * ac[j * 8 + i]; }
        ss = wave_sum(ss);
        const float rs2 = rsqrtf(ss * (1.f / DM) + EPS);
#pragma unroll
        for (int j = 0; j < 4; ++j) { const size_t o = (size_t)t * DM + j * 512 + lane * 8;
            *(f32x4*)(h2 + o) = (f32x4){ac[j * 8], ac[j * 8 + 1], ac[j * 8 + 2], ac[j * 8 + 3]}; *(f32x4*)(h2 + o + 4) = (f32x4){ac[j * 8 + 4], ac[j * 8 + 5], ac[j * 8 + 6], ac[j * 8 + 7]};
            u32x4 w; w.x = pk2(ac[j * 8] * rs2, ac[j * 8 + 1] * rs2); w.y = pk2(ac[j * 8 + 2] * rs2, ac[j * 8 + 3] * rs2); w.z = pk2(ac[j * 8 + 4] * rs2, ac[j * 8 + 5] * rs2); w.w = pk2(ac[j * 8 + 6] * rs2, ac[j * 8 + 7] * rs2);
            *(u32x4*)(xn3 + o) = w; }
    }
}


#define BUBBLE16(v, x) _Pragma("unroll") for (int j_ = 0; j_ < 16; ++j_) { const float hi_ = fmaxf(v[j_], x); x = fminf(v[j_], x); v[j_] = hi_; }
constexpr int PL_KEYS = 0, PL_WL = 0, PL_WTS = 16384, PL_SX = 32768, PL_SG = 49152, PL_TOT = 65536, PL_MB = 65536, PL_OFF = 67584, PL_H8 = 69888, PL_EX = 69888, PL_GT = 86272, PL_CNT = 102656, H8_STRIDE = 2112;
DEV f32x2 fp8x2(unsigned w, bool hi) { return hi ? __builtin_amdgcn_cvt_pk_f32_fp8(w, true) : __builtin_amdgcn_cvt_pk_f32_fp8(w, false); }
DEV float dot16_fp8(const float* h, u32x4 r) {
    float d = 0.f;
#pragma unroll
    for (int q = 0; q < 4; ++q) { const f32x2 lo = __builtin_amdgcn_cvt_pk_f32_fp8(r[q], false), hi2 = __builtin_amdgcn_cvt_pk_f32_fp8(r[q], true);
        d = fmaf(h[q * 4 + 0], lo.x, d); d = fmaf(h[q * 4 + 1], lo.y, d); d = fmaf(h[q * 4 + 2], hi2.x, d); d = fmaf(h[q * 4 + 3], hi2.y, d); }
    return d;
}
DEV void axpy16_fp8(float* acc, float w, u32x4 r) {
#pragma unroll
    for (int q = 0; q < 4; ++q) { const f32x2 lo = __builtin_amdgcn_cvt_pk_f32_fp8(r[q], false), hi2 = __builtin_amdgcn_cvt_pk_f32_fp8(r[q], true);
        acc[q * 4 + 0] = fmaf(w, lo.x, acc[q * 4 + 0]); acc[q * 4 + 1] = fmaf(w, lo.y, acc[q * 4 + 1]); acc[q * 4 + 2] = fmaf(w, hi2.x, acc[q * 4 + 2]); acc[q * 4 + 3] = fmaf(w, hi2.y, acc[q * 4 + 3]); }
}
#define PE_FENCE0 do { asm volatile("" ::: "memory"); __builtin_amdgcn_sched_barrier(0); } while (0)
#ifdef STAMP_SEL
#define PSTAMP(k) do { if (blockIdx.x == STAMP_BLK && threadIdx.x == 0) { ((unsigned long long*)stampp)[32 + (k)] = __builtin_amdgcn_s_memrealtime(); } } while (0)
#else
#define PSTAMP(k) do {} while (0)
#endif
DEV void peer_phase2(void* stampp, char* lds, const float* scT, const bf16_t* h1, const u64* ssq1, const unsigned char* tu8, const unsigned char* tv8, bf16_t* h2, bf16_t* xn3, float* ssq2) {
    const int tid = threadIdx.x, lane = tid & 63, wid = __builtin_amdgcn_readfirstlane(tid >> 6);
    unsigned* keys1 = (unsigned*)(lds + PL_KEYS); int* ex = (int*)(lds + PL_EX); float* gt = (float*)(lds + PL_GT); float* wts = (float*)(lds + PL_WTS) + wid * 512; int* wl = (int*)(lds + PL_WL) + wid * 512; unsigned* wpk = (unsigned*)(lds + PL_EX) + wid * 512; int* mbase = (int*)(lds + PL_MB) + wid * 64;
    int* sx = (int*)(lds + PL_SX); float* sg = (float*)(lds + PL_SG); int* cnth = (int*)(lds + PL_CNT); int* tot = (int*)(lds + PL_TOT); int* offs = (int*)(lds + PL_OFF);
    const float NEGINF = -__builtin_inff();
    for (int grp = blockIdx.x; grp < S / 32; grp += gridDim.x) {
        __syncthreads();
        PSTAMP(0);
        {
            const int tl = tid & 31, hc = tid >> 5;
            const float* sp = scT + ((size_t)(grp * 16 + hc) * 128) * 32 + tl;
            float v[16];
#pragma unroll
            for (int j = 0; j < 16; ++j) v[j] = NEGINF;
#pragma unroll 1
            for (int n0 = 0; n0 < 128; n0 += 8) {
                float sv[8];
#pragma unroll
                for (int q = 0; q < 8; ++q) sv[q] = sp[(n0 + q) * 32];
#pragma unroll
                for (int q = 0; q < 8; ++q) { float x = __uint_as_float((__float_as_uint(sv[q]) & 0xFFFFFF80u) | (unsigned)(127 - (n0 + q))); BUBBLE16(v, x); }
            }
#pragma unroll
            for (int j = 0; j < 16; ++j) keys1[(tl * 16 + hc) * 16 + j] = __float_as_uint(v[j]);
        }
        __syncthreads();
        PSTAMP(1);
        if (tid < 256) {
            const int tl = tid & 31, h = tid >> 5;
            const unsigned* ka = keys1 + (tl * 16 + 2 * h) * 16; const unsigned* kb = ka + 16;
            float a[16], b[16];
#pragma unroll
            for (int j = 0; j < 16; ++j) { a[j] = __uint_as_float(ka[j] & 0xFFFFFF80u); b[j] = __uint_as_float(kb[j] & 0xFFFFFF80u); }
            float w[16];
#pragma unroll
            for (int j = 0; j < 16; ++j) w[j] = NEGINF;
            {
                int cid = 0;
#pragma unroll
                for (int i = 0; i < 16; ++i)
#pragma unroll
                    for (int j = 0; j < 16; ++j) if ((i + 1) * (j + 1) <= 16) { float x = __uint_as_float((__float_as_uint(a[i] + b[j]) & 0xFFFFFFC0u) | (unsigned)(63 - cid)); BUBBLE16(w, x); ++cid; }
            }
            const float mx = __uint_as_float(__float_as_uint(w[0]) & 0xFFFFFFC0u);
            float e[16], sum = 0.f;
#pragma unroll
            for (int k = 0; k < 16; ++k) { e[k] = __expf(__uint_as_float(__float_as_uint(w[k]) & 0xFFFFFFC0u) - mx); sum += e[k]; }
            const float inv = 1.f / sum;
#pragma unroll
            for (int k = 0; k < 16; ++k) {
                const int cid = 63 - (int)(__float_as_uint(w[k]) & 63u);
                int i, j;
                if (cid >= 42) { i = 8 + (cid - 42); j = 0; }
                else { i = (cid >= 16) + (cid >= 24) + (cid >= 29) + (cid >= 33) + (cid >= 36) + (cid >= 38) + (cid >= 40);
                       const int st = i == 0 ? 0 : i == 1 ? 16 : i == 2 ? 24 : i == 3 ? 29 : i == 4 ? 33 : i == 5 ? 36 : i == 6 ? 38 : 40; j = cid - st; }
                const int i1 = 127 - (int)(ka[i] & 127u), i2 = 127 - (int)(kb[j] & 127u);
                ex[tl * 128 + h * 16 + k] = i1 * NK + i2; gt[tl * 128 + h * 16 + k] = e[k] * inv;
            }
            int* crow_ = cnth + (tl * 8 + h) * 16;
#pragma unroll
            for (int r = 0; r < 16; ++r) crow_[r] = 0;
            for (int k = 0; k < 16; ++k) { const int r = ex[tl * 128 + h * 16 + k] >> 10; crow_[r] = crow_[r] + 1; }
        }
        __syncthreads();
        {
            const int tl = tid & 31, r = tid >> 5;
            int t_ = 0;
#pragma unroll
            for (int h = 0; h < 8; ++h) t_ += cnth[(tl * 8 + h) * 16 + r];
            tot[tl * 16 + r] = t_;
        }
        __syncthreads();
        {
            const int tl = tid & 31, r = tid >> 5;
            int b_ = 0;
            for (int r2 = 0; r2 < r; ++r2) b_ += tot[tl * 16 + r2];
            offs[tl * 17 + r] = b_; if (r == 15) offs[tl * 17 + 16] = 128;
#pragma unroll
            for (int h = 0; h < 8; ++h) { const int c_ = cnth[(tl * 8 + h) * 16 + r]; cnth[(tl * 8 + h) * 16 + r] = b_; b_ += c_; }
        }
        __syncthreads();
        if (tid < 256) {
            const int tl = tid & 31, h = tid >> 5; int* crow_ = cnth + (tl * 8 + h) * 16;
            for (int k = 0; k < 16; ++k) { const int e_ = ex[tl * 128 + h * 16 + k]; const int r = e_ >> 10; const int p_ = crow_[r]; crow_[r] = p_ + 1; sx[tl * 128 + p_] = e_; sg[tl * 128 + p_] = gt[tl * 128 + h * 16 + k]; }
        }
        __syncthreads();
#define PE_FENCE do { asm volatile("" ::: "memory"); __builtin_amdgcn_sched_barrier(0); } while (0)
#define PE_TIE16(A, o) asm volatile("" : "+v"(A[o + 0]), "+v"(A[o + 1]), "+v"(A[o + 2]), "+v"(A[o + 3]), "+v"(A[o + 4]), "+v"(A[o + 5]), "+v"(A[o + 6]), "+v"(A[o + 7]), "+v"(A[o + 8]), "+v"(A[o + 9]), \
            "+v"(A[o + 10]), "+v"(A[o + 11]), "+v"(A[o + 12]), "+v"(A[o + 13]), "+v"(A[o + 14]), "+v"(A[o + 15]))
        PSTAMP(2);
#define PE_FENCE do { asm volatile("" ::: "memory"); __builtin_amdgcn_sched_barrier(0); } while (0)
        {
            const int tl0 = wid * 4, t0 = grp * 32 + tl0;
            {
                const int q = lane >> 4, r = lane & 15; int b_ = 0;
#pragma unroll
                for (int q2 = 0; q2 < 4; ++q2) { const int o0 = offs[(tl0 + q2) * 17 + r], o1 = offs[(tl0 + q2) * 17 + r + 1]; b_ += o0; if (q2 < q) b_ += o1 - o0; }
                mbase[lane] = b_;
            }
            asm volatile("s_waitcnt lgkmcnt(0)" ::: "memory");
#pragma unroll
            for (int q = 0; q < 4; ++q)
#pragma unroll
                for (int kk = 0; kk < 2; ++kk) { const int k = lane + 64 * kk; const int e_ = sx[(tl0 + q) * 128 + k]; const int r = e_ >> 10;
                    wl[(k - offs[(tl0 + q) * 17 + r]) + mbase[q * 16 + r]] = e_ | (k << 16) | (q << 23); }
            asm volatile("s_waitcnt lgkmcnt(0)" ::: "memory");
            float rsq[4];
#pragma unroll
            for (int q = 0; q < 4; ++q) rsq[q] = rsqrtf(ssq_get(ssq1, t0 + q) * (1.f / DM) + EPS) * (1.f / (TU_SCALE * H_SCALE));
            {
                int hq[4][8];
#pragma unroll
                for (int q = 0; q < 4; ++q)
#pragma unroll
                    for (int c = 0; c < 8; ++c) hq[q][c] = (int)q8pack(unpk4(*(const u32x2*)(h1 + (size_t)(t0 + q) * DM + (c >> 2) * 1024 + lane * 16 + (c & 3) * 4)) * H_SCALE);
                u32x4 rr[16][2]; int ent[16];
#define PE_LOAD1(j, i) do { ent[j] = __builtin_amdgcn_readfirstlane(wl[(i)]); const unsigned char* p_ = tu8 + (size_t)(ent[j] & 0x3FFF) * DM + lane * 16; \
                    rr[j][0] = *(const u32x4*)p_; rr[j][1] = *(const u32x4*)(p_ + 1024); } while (0)
#define PE_DOT(j, dj) do { int s_[4] = {0, 0, 0, 0}; _Pragma("unroll") for (int hf_ = 0; hf_ < 2; ++hf_) _Pragma("unroll") for (int w_ = 0; w_ < 4; ++w_) { const int x_ = (int)rr[j][hf_][w_]; \
                    s_[0] = __builtin_amdgcn_sdot4(x_, hq[0][hf_ * 4 + w_], s_[0], false); s_[1] = __builtin_amdgcn_sdot4(x_, hq[1][hf_ * 4 + w_], s_[1], false); \
                    s_[2] = __builtin_amdgcn_sdot4(x_, hq[2][hf_ * 4 + w_], s_[2], false); s_[3] = __builtin_amdgcn_sdot4(x_, hq[3][hf_ * 4 + w_], s_[3], false); } \
                    const int q_ = (ent[j] >> 23) & 3; d_[dj] = (float)(q_ == 0 ? s_[0] : q_ == 1 ? s_[1] : q_ == 2 ? s_[2] : s_[3]); } while (0)
#define PE_UREDUCE(i0) do { \
                    float r4_[4]; _Pragma("unroll") for (int i_ = 0; i_ < 4; ++i_) { const bool up_ = (lane & 32) != 0; const float keep_ = up_ ? d_[i_ + 4] : d_[i_], send_ = up_ ? d_[i_] : d_[i_ + 4]; r4_[i_] = keep_ + __shfl_xor(send_, 32); } \
                    float r2_[2]; _Pragma("unroll") for (int i_ = 0; i_ < 2; ++i_) { const bool up_ = (lane & 16) != 0; const float keep_ = up_ ? r4_[i_ + 2] : r4_[i_], send_ = up_ ? r4_[i_] : r4_[i_ + 2]; r2_[i_] = keep_ + __shfl_xor(send_, 16); } \
                    float r1_; { const bool up_ = (lane & 8) != 0; const float keep_ = up_ ? r2_[1] : r2_[0], send_ = up_ ? r2_[0] : r2_[1]; r1_ = keep_ + __shfl_xor(send_, 8); } \
                    r1_ += __shfl_xor(r1_, 4); r1_ += __shfl_xor(r1_, 2); r1_ += __shfl_xor(r1_, 1); \
                    const int en_ = wl[(i0) + (lane >> 3)]; const int q_ = (en_ >> 23) & 3, k_ = (en_ >> 16) & 127; \
                    const float rs_ = q_ == 0 ? rsq[0] : q_ == 1 ? rsq[1] : q_ == 2 ? rsq[2] : rsq[3]; \
                    const float wv_ = sg[(tl0 + q_) * 128 + k_] * gelu_tanh(r1_ * rs_); if ((lane & 7) == 0) wts[q_ * 128 + k_] = wv_; } while (0)
#pragma unroll
                for (int j = 0; j < 16; ++j) PE_LOAD1(j, j);
                PE_FENCE;
#pragma unroll 1
                for (int b = 0; b < 31; ++b) {
                    { float d_[8];
#pragma unroll
                      for (int j = 0; j < 8; ++j) { PE_DOT(j, j); PE_FENCE; PE_LOAD1(j, (b + 1) * 16 + j); PE_FENCE; }
                      PE_UREDUCE(b * 16); }
                    { float d_[8];
#pragma unroll
                      for (int j = 8; j < 16; ++j) { PE_DOT(j, j - 8); PE_FENCE; PE_LOAD1(j, (b + 1) * 16 + j); PE_FENCE; }
                      PE_UREDUCE(b * 16 + 8); }
                }
                { float d_[8];
#pragma unroll
                  for (int j = 0; j < 8; ++j) { PE_DOT(j, j); PE_FENCE; }
                  PE_UREDUCE(31 * 16); }
                { float d_[8];
#pragma unroll
                  for (int j = 8; j < 16; ++j) { PE_DOT(j, j - 8); PE_FENCE; }
                  PE_UREDUCE(31 * 16 + 8); }
#undef PE_LOAD1
#undef PE_DOT
#undef PE_UREDUCE
            }
            asm volatile("s_waitcnt lgkmcnt(0)" ::: "memory");
            PSTAMP(3);
            float swq[4];
            {
#pragma unroll
                for (int q = 0; q < 4; ++q) { float m_ = fmaxf(fabsf(wts[q * 128 + lane]), fabsf(wts[q * 128 + 64 + lane]));
#pragma unroll
                    for (int o = 1; o < 64; o <<= 1) m_ = fmaxf(m_, __shfl_xor(m_, o));
                    swq[q] = 127.f / fmaxf(m_, 1e-20f); }
#pragma unroll
                for (int gg = 0; gg < 2; ++gg) { const int gi = lane + 64 * gg; unsigned pk_[4] = {0u, 0u, 0u, 0u};
#pragma unroll
                    for (int j = 0; j < 4; ++j) { const int en_ = wl[gi * 4 + j]; const int q_ = (en_ >> 23) & 3, k_ = (en_ >> 16) & 127; const float w_ = wts[q_ * 128 + k_];
                        const float sw_ = q_ == 0 ? swq[0] : q_ == 1 ? swq[1] : q_ == 2 ? swq[2] : swq[3]; const unsigned qv_ = q8(w_ * sw_) << (8 * j);
                        pk_[0] |= q_ == 0 ? qv_ : 0u; pk_[1] |= q_ == 1 ? qv_ : 0u; pk_[2] |= q_ == 2 ? qv_ : 0u; pk_[3] |= q_ == 3 ? qv_ : 0u; }
                    wpk[gi] = pk_[0]; wpk[128 + gi] = pk_[1]; wpk[256 + gi] = pk_[2]; wpk[384 + gi] = pk_[3]; }
            }
            asm volatile("s_waitcnt lgkmcnt(0)" ::: "memory");
            float ssq[4] = {0.f, 0.f, 0.f, 0.f};
#pragma unroll 1
            for (int hf = 0; hf < 2; ++hf) {
                int ac[4][16];
#pragma unroll
                for (int q = 0; q < 4; ++q)
#pragma unroll
                    for (int i = 0; i < 16; ++i) ac[q][i] = 0;
                u32x4 rv[16];
#define PE_VLOAD(j, i) do { const int e_ = __builtin_amdgcn_readfirstlane(wl[(i)]) & 0x3FFF; rv[j] = *(const u32x4*)(tv8 + (size_t)e_ * DM + hf * 1024 + lane * 16); } while (0)
#define PE_TIEI(A) asm volatile("" : "+v"(A[0]), "+v"(A[1]), "+v"(A[2]), "+v"(A[3]), "+v"(A[4]), "+v"(A[5]), "+v"(A[6]), "+v"(A[7]), "+v"(A[8]), "+v"(A[9]), "+v"(A[10]), "+v"(A[11]), "+v"(A[12]), "+v"(A[13]), "+v"(A[14]), "+v"(A[15]))
#define PE_GROUP4(j0, gi) do { const int w0_ = (int)wpk[(gi)], w1_ = (int)wpk[128 + (gi)], w2_ = (int)wpk[256 + (gi)], w3_ = (int)wpk[384 + (gi)]; \
                    _Pragma("unroll") for (int w_ = 0; w_ < 4; ++w_) { \
                        const unsigned r0_ = rv[j0][w_], r1_ = rv[j0 + 1][w_], r2_ = rv[j0 + 2][w_], r3_ = rv[j0 + 3][w_]; \
                        const unsigned lo01_ = __builtin_amdgcn_perm(r1_, r0_, 0x05010400u), hi01_ = __builtin_amdgcn_perm(r1_, r0_, 0x07030602u); \
                        const unsigned lo23_ = __builtin_amdgcn_perm(r3_, r2_, 0x05010400u), hi23_ = __builtin_amdgcn_perm(r3_, r2_, 0x07030602u); \
                        const int t_[4] = {(int)__builtin_amdgcn_perm(lo23_, lo01_, 0x05040100u), (int)__builtin_amdgcn_perm(lo23_, lo01_, 0x07060302u), \
                                           (int)__builtin_amdgcn_perm(hi23_, hi01_, 0x05040100u), (int)__builtin_amdgcn_perm(hi23_, hi01_, 0x07060302u)}; \
                        _Pragma("unroll") for (int c_ = 0; c_ < 4; ++c_) { const int o_ = w_ * 4 + c_; \
                            ac[0][o_] = __builtin_amdgcn_sdot4(t_[c_], w0_, ac[0][o_], false); ac[1][o_] = __builtin_amdgcn_sdot4(t_[c_], w1_, ac[1][o_], false); \
                            ac[2][o_] = __builtin_amdgcn_sdot4(t_[c_], w2_, ac[2][o_], false); ac[3][o_] = __builtin_amdgcn_sdot4(t_[c_], w3_, ac[3][o_], false); } } \
                    PE_TIEI(ac[0]); PE_TIEI(ac[1]); PE_TIEI(ac[2]); PE_TIEI(ac[3]); } while (0)
#pragma unroll
                for (int j = 0; j < 16; ++j) PE_VLOAD(j, j);
                PE_FENCE;
#pragma unroll 1
                for (int b = 0; b < 31; ++b) {
#pragma unroll
                    for (int g4 = 0; g4 < 4; ++g4) { PE_GROUP4(g4 * 4, b * 4 + g4); PE_FENCE;
#pragma unroll
                        for (int j = g4 * 4; j < g4 * 4 + 4; ++j) PE_VLOAD(j, (b + 1) * 16 + j);
                        PE_FENCE; }
                }
#pragma unroll
                for (int g4 = 0; g4 < 4; ++g4) { PE_GROUP4(g4 * 4, 31 * 4 + g4); PE_FENCE; }
#undef PE_VLOAD
#undef PE_TIEI
#undef PE_GROUP4
#pragma unroll
                for (int q = 0; q < 4; ++q) { const size_t o = (size_t)(t0 + q) * DM + hf * 1024 + lane * 16; const float f_ = 1.f / (swq[q] * TV_SCALE);
#pragma unroll
                    for (int c2 = 0; c2 < 2; ++c2) { const u32x4 xr_ = *(const u32x4*)(h1 + o + c2 * 8); f32x4 y4[2]; unsigned w8_[2];
#pragma unroll
                        for (int e = 0; e < 2; ++e) { const int c = c2 * 2 + e; const f32x4 x4 = e == 0 ? unpk4lo(xr_) : unpk4hi(xr_);
                            y4[e][0] = (float)ac[q][c * 4] * f_ + x4[0]; y4[e][1] = (float)ac[q][c * 4 + 1] * f_ + x4[1]; y4[e][2] = (float)ac[q][c * 4 + 2] * f_ + x4[2]; y4[e][3] = (float)ac[q][c * 4 + 3] * f_ + x4[3];
                            ssq[q] += sumsq4(y4[e]); w8_[e] = f8pack(y4[e] * X_SCALE); }
                        *(u32x4*)(h2 + o + c2 * 8) = pk8(y4[0], y4[1]); *(u32x2*)((unsigned char*)xn3 + o + c2 * 8) = (u32x2){w8_[0], w8_[1]}; } }
            }
#pragma unroll
            for (int q = 0; q < 4; ++q) { const float s_ = wave_sum(ssq[q]); if (lane == 0) ssq2[t0 + q] = s_; }
            PSTAMP(5);
        }
#undef PE_FENCE
#undef PE_TIE16
    }
}

#define XB_TMO      128
#define XB_XCNT(j)  (256  + 64 * (j))
#define XB_XSUB(j)  (1280 + 64 * (j))
#define XB_XGEN(j)  (2304 + 64 * (j))
#define XB_TOP      3328
#define XB_TOPGEN   3392
#define XCD_BAR_WORDS 3456
#define XB_SPIN_CAP (1u << 18)

__device__ __forceinline__ unsigned xb_ld(unsigned* p)              { return __hip_atomic_load(p, __ATOMIC_RELAXED, __HIP_MEMORY_SCOPE_AGENT); }
__device__ __forceinline__ unsigned xb_add(unsigned* p, unsigned v) { return __hip_atomic_fetch_add(p, v, __ATOMIC_RELAXED, __HIP_MEMORY_SCOPE_AGENT); }
__device__ __forceinline__ unsigned xb_xcc_id() { return (unsigned)__builtin_amdgcn_s_getreg((3 << 11) | 20) & 0xFu; }
#define XB_SPIN(cond, bar) do { unsigned _sp = 0; while (cond) { __builtin_amdgcn_s_sleep(1); \
    if ((++_sp & 255u) == 0u) { if (xb_ld(&(bar)[XB_TMO])) break; if (_sp > XB_SPIN_CAP) { atomicAdd(&(bar)[XB_TMO], 1u); break; } } } } while (0)

struct XcdBarrier {
    unsigned* bar; unsigned x;
    volatile __attribute__((address_space(3))) unsigned* st;
};

__device__ __forceinline__ XcdBarrier xcd_barrier_post(unsigned* bar, volatile __attribute__((address_space(3))) unsigned* st) {
    XcdBarrier b; b.bar = bar; b.x = xb_xcc_id(); b.st = st;
    if (threadIdx.x == 0) (void)xb_add(&bar[XB_XCNT(b.x)], 1u);
    return b;
}
__device__ __forceinline__ void xcd_barrier_complete(unsigned* bar, unsigned x, unsigned& nloc, unsigned& nx) {
    const unsigned G = gridDim.x * gridDim.y * gridDim.z;
    unsigned sum, cnt, mine, sp = 0u;
    for (;;) {
        sum = 0u; cnt = 0u; mine = 0u;
#pragma unroll
        for (unsigned j = 0; j < 16; ++j) { const unsigned c = xb_ld(&bar[XB_XCNT(j)]); sum += c; cnt += (c > 0u) ? 1u : 0u; mine = (j == x) ? c : mine; }
        if (sum == G) break;
        __builtin_amdgcn_s_sleep(1);
        if ((++sp & 255u) == 0u) { if (xb_ld(&bar[XB_TMO])) break; if (sp > XB_SPIN_CAP) { atomicAdd(&bar[XB_TMO], 1u); break; } }
    }
    nloc = mine > 0u ? mine : 1u; nx = cnt > 0u ? cnt : 1u;
}

__device__ __forceinline__ void xcd_barrier(const XcdBarrier& b) {
    asm volatile("s_waitcnt vmcnt(0)" ::: "memory");
    __syncthreads();
    if (threadIdx.x == 0) {
        unsigned* bar = b.bar;
        __builtin_amdgcn_s_waitcnt(0);
        unsigned nloc = b.st[0], nx = b.st[1];
        if (nloc == 0u) { xcd_barrier_complete(bar, b.x, nloc, nx); b.st[0] = nloc; b.st[1] = nx; }
        const unsigned old = xb_add(&bar[XB_XSUB(b.x)], 1u);
        const unsigned gen = old / nloc;
        if (old + 1u == (gen + 1u) * nloc) {
            __builtin_amdgcn_fence(__ATOMIC_RELEASE, "agent");
            asm volatile("s_waitcnt vmcnt(0)" ::: "memory");
            const unsigned og = xb_add(&bar[XB_TOP], 1u);
            const unsigned tg = og / nx;
            if (og + 1u == (tg + 1u) * nx) xb_add(&bar[XB_TOPGEN], 1u);
            else XB_SPIN(xb_ld(&bar[XB_TOPGEN]) == tg, bar);
            __builtin_amdgcn_fence(__ATOMIC_ACQUIRE, "agent");
            xb_add(&bar[XB_XGEN(b.x)], 1u);
            asm volatile("s_waitcnt vmcnt(0)" ::: "memory");
        } else {
            XB_SPIN(xb_ld(&bar[XB_XGEN(b.x)]) == gen, bar);
            __builtin_amdgcn_fence(__ATOMIC_ACQUIRE, "agent");
            asm volatile("s_waitcnt vmcnt(0)" ::: "memory");
        }
    }
    __syncthreads();
}


__global__ void __launch_bounds__(NTHREADS, 2) fwd_kernel(Params P) {
    extern __shared__ __attribute__((aligned(16))) unsigned char lds_raw[];
    float* lds = (float*)lds_raw;
    cg::grid_group grid = cg::this_grid();
    const int G = gridDim.x, bx = blockIdx.x;
    const int gthreads = G * NTHREADS, gwaves = G * 8;
#define PHASE_IDS() int tid = threadIdx.x; asm volatile("" : "+v"(tid)); const int lane = tid & 63, wid = tid >> 6, gtid = bx * NTHREADS + tid, gwave = bx * 8 + wid; (void)lane; (void)wid; (void)gtid; (void)gwave
typedef const float* const __attribute__((address_space(4)))* KARG;
#define PH_PTRS() \
    KARG INP = (KARG)__builtin_amdgcn_kernarg_segment_ptr(); asm volatile("" : "+s"(INP)); \
    unsigned char* ws = (unsigned char*)INP[29]; float* outp = (float*)INP[28]; \
    float* small = (float*)(ws + WS_SMALL); \
    float* rope = (float*)(ws + WS_ROPE); \
    bf16_t* wt_in = (bf16_t*)(ws + WS_WIN); bf16_t* wt_uq = (bf16_t*)(ws + WS_WUQ); bf16_t* wt_ukv = (bf16_t*)(ws + WS_WUKV); \
    bf16_t* wt_ao = (bf16_t*)(ws + WS_WAO); bf16_t* wt_ro = (bf16_t*)(ws + WS_WRO); bf16_t* wt_out = (bf16_t*)(ws + WS_WOUT); \
    bf16_t* wt_pq = (bf16_t*)(ws + WS_WPQ); bf16_t* wt_pg = (bf16_t*)(ws + WS_WPG); bf16_t* wt_pp = (bf16_t*)(ws + WS_WPP); \
    bf16_t* wt_g = (bf16_t*)(ws + WS_WG); bf16_t* wt_sk = (bf16_t*)(ws + WS_WSK); bf16_t* pb = (bf16_t*)(ws + WS_PB); \
    bf16_t* tu = (bf16_t*)(ws + WS_TU); bf16_t* tvt = (bf16_t*)(ws + WS_TV); \
    bf16_t* xb = (bf16_t*)(ws + WS_A0); bf16_t* xc = (bf16_t*)(ws + WS_A0); float* agg = (float*)(ws + WS_A0); bf16_t* h1b = (bf16_t*)(ws + WS_A0); \
    bf16_t* Yb = (bf16_t*)(ws + WS_A2); bf16_t* wq_plain = (bf16_t*)(ws + WS_A2); bf16_t* h2b = (bf16_t*)(ws + WS_A2); \
    bf16_t* gy = (bf16_t*)(ws + WS_A3); float* scores = (float*)(ws + WS_A3); \
    unsigned char* o8 = ws + WS_TV + 32 * MiB; bf16_t* gat = (bf16_t*)(ws + WS_A4); bf16_t* grn = (bf16_t*)(ws + WS_A5); bf16_t* ppb = (bf16_t*)(ws + WS_TU + 32 * MiB); \
    bf16_t* qn = (bf16_t*)(ws + WS_A6); bf16_t* kn = (bf16_t*)(ws + WS_A7); bf16_t* mixa = (bf16_t*)(ws + WS_A7); bf16_t* xn3 = (bf16_t*)(ws + WS_A7); \
    bf16_t* vv = (bf16_t*)(ws + WS_A8); bf16_t* mix = (bf16_t*)(ws + WS_A8); \
    bf16_t* qp = (bf16_t*)(ws + WS_A9); bf16_t* kpe = (bf16_t*)(ws + WS_KPE); \
    bf16_t* cq = (bf16_t*)outp; bf16_t* ckv = (bf16_t*)((unsigned char*)outp + 12 * MiB); bf16_t* xr = (bf16_t*)((unsigned char*)outp + 20 * MiB); \
    bf16_t* la = (bf16_t*)outp; bf16_t* gx = (bf16_t*)((unsigned char*)outp + 32 * MiB); \
    float* hres = outp;
#define INP_WS_STAMP (((unsigned char* const __attribute__((address_space(4)))*)__builtin_amdgcn_kernarg_segment_ptr())[29] + WS_SMALL + 400 * 1024)
    const int lo = P.ph_lo, hi = P.ph_hi;
    volatile __attribute__((address_space(3))) unsigned* misc_ = (volatile __attribute__((address_space(3))) unsigned*)((__attribute__((address_space(3))) unsigned char*)lds_raw + MISC_OFF);
    if (threadIdx.x < 2) misc_[threadIdx.x] = 0u;
    __syncthreads();
    XcdBarrier xbar; xbar.bar = nullptr; xbar.x = 0; xbar.st = nullptr;
    if (hi - lo > 1) xbar = xcd_barrier_post((unsigned*)(P.ws + WS_BAR), misc_);
#ifndef PHMASK
#define PHMASK 0xFFFF
#endif
#define IN(k) (((PHMASK >> (k)) & 1) && lo <= (k) && (k) < hi)
#define SYNC_AFTER(k) do { STAMP(2 * (k)); if (IN(k) && IN((k) + 1)) xcd_barrier(xbar); STAMP(2 * (k) + 1); } while (0)

#ifndef STAMP_DIV
#define STAMP_DIV 100.f
#endif
#ifndef SIMPLE_ATTN
#define SIMPLE_ATTN 0
#endif
#ifndef SIMPLE_GEMM
#define SIMPLE_GEMM 0
#endif
#define GEMM8(g, E) gemm_mfma8<decltype(E), true, true>((LAS unsigned char*)lds_raw, g, E)
#define GEMM(g, E) do { if (SIMPLE_GEMM) gemm_simple(lds, g, E); else gemm_mfma<decltype(E), true, true>((LAS unsigned char*)lds_raw, g, E); } while (0)
#ifdef STAMP_SEL
    if (blockIdx.x == STAMP_BLK && threadIdx.x == 0) { unsigned long long* st_ = (unsigned long long*)(INP_WS_STAMP); st_[0] = __builtin_amdgcn_s_memrealtime(); }
#define STAMP(k) do { if (blockIdx.x == STAMP_BLK && threadIdx.x == 0) { unsigned long long* st_ = (unsigned long long*)(INP_WS_STAMP); st_[(k) + 1] = __builtin_amdgcn_s_memrealtime(); } } while (0)
#else
#define STAMP(k) do {} while (0)
#endif
    if (IN(0)) { PH_PTRS();
        PHASE_IDS();
        int ib = 0;
        transpose_items<MapWin, true>(lds, INP[I_W_IN], DM, 9536, NIN_PAD, wt_in, INP[I_ATTN_NORM], WIN_SCALE, MapWin(), ib, gwave, gwaves);
        transpose_items(lds, INP[I_W_UQ], QL, 3072, 3072, wt_uq, INP[I_Q_NORM], QSCALE, MapWuq(), ib, gwave, gwaves);
        transpose_items(lds, INP[I_W_UKV], KVL, 4096, 4096, wt_ukv, INP[I_KV_NORM], 1.f, MapIdent(), ib, gwave, gwaves);
        transpose_items<MapIdent, true>(lds, INP[I_W_ATTN_O], DM, DM, DM, wt_ao, nullptr, WIN_SCALE, MapIdent(), ib, gwave, gwaves);
        transpose_items<MapIdent, true>(lds, INP[I_W_RNN_O], DM, DM, DM, wt_ro, nullptr, WIN_SCALE, MapIdent(), ib, gwave, gwaves);
        transpose_items<MapIdent, true>(lds, INP[I_W_OUT], DM, DM, DM, wt_out, nullptr, WIN_SCALE, MapIdent(), ib, gwave, gwaves);
        { const float* wq = INP[I_W_PEER_Q]; const float* gn = INP[I_FFN_NORM];
          for (int i = gtid; i < DM * DM / 8; i += gthreads) { const size_t o = (size_t)i * 8; const float g = gn[o / DM];
              const f32x4 a = *(const f32x4*)(wq + o) * g, b4 = *(const f32x4*)(wq + o + 4) * g; u32x4 w; w.x = pk2(a[0], a[1]); w.y = pk2(a[2], a[3]); w.z = pk2(b4[0], b4[1]); w.w = pk2(b4[2], b4[3]);
              *(u32x4*)(wq_plain + o) = w; } }
        transpose_items<MapIdent, true>(lds, INP[I_W_PLE_GATE], DM, DM, DM, wt_pg, INP[I_PLE_NORM], WIN_SCALE, MapIdent(), ib, gwave, gwaves);
        transpose_items(lds, INP[I_W_PLE_PROJ], PLE, DM, DM, wt_pp, nullptr, 1.f, MapIdent(), ib, gwave, gwaves);
        for (int b = 0; b < NBLK; ++b) {
            transpose_items(lds, INP[I_W_RG_A] + (size_t)b * BD * BD, BD, BD, BD, wt_g + (size_t)b * 256 * BD, nullptr, 1.f, MapIdent(), ib, gwave, gwaves);
            transpose_items(lds, INP[I_W_RG_X] + (size_t)b * BD * BD, BD, BD, BD, wt_g + (size_t)b * 256 * BD + 128 * BD, nullptr, 1.f, MapIdent(), ib, gwave, gwaves);
        }
        for (int i = gtid; i < PH * 256 * 256; i += gthreads) { const int h = i >> 16, n = (i >> 8) & 255, k = i & 255, c = n >> 7;
            float v = 0.f; if ((k >> 7) == c) v = INP[I_SUBKEYS][(((size_t)h * 2 + c) * NK + (n & 127)) * 128 + (k & 127)];
            wt_sk[i] = (bf16_t)f2bf(v); }
        { const float* pu = INP[I_PEER_U]; const float* pv = INP[I_PEER_V]; const float* gn = INP[I_FFN_NORM]; unsigned char* tu8 = (unsigned char*)tu; unsigned char* tv8 = (unsigned char*)tvt;
          const size_t n16 = (size_t)NK * NK * DM / 16;
          for (size_t i = gtid; i < n16; i += gthreads) { const size_t o = i * 16; const int d = (int)(o & (DM - 1));
              u32x4 wu, wv;
#pragma unroll
              for (int q = 0; q < 4; ++q) { const f32x4 a = *(const f32x4*)(pu + o + q * 4) * *(const f32x4*)(gn + d + q * 4) * TU_SCALE, bq = *(const f32x4*)(pv + o + q * 4) * TV_SCALE;
                  wu[q] = q8pack(a); wv[q] = q8pack(bq); }
              *(u32x4*)(tu8 + o) = wu; *(u32x4*)(tv8 + o) = wv; } }
        for (int i = gtid; i < S * PLE / 4; i += gthreads) { const f32x4 v = *(const f32x4*)(INP[I_P] + (size_t)i * 4); *(u32x2*)(pb + (size_t)i * 4) = pk4(v); }
        for (int t = gwave; t < S; t += gwaves) { const float* xrw = INP[I_X] + (size_t)t * DM; float s = 0.f;
#pragma unroll
            for (int j = 0; j < 8; ++j) { const f32x4 v = *(const f32x4*)(xrw + j * 256 + lane * 4); s += sumsq4(v); unsigned w1 = 0;
                w1 = __builtin_amdgcn_cvt_pk_fp8_f32(v[0] * X_SCALE, v[1] * X_SCALE, w1, false); w1 = __builtin_amdgcn_cvt_pk_fp8_f32(v[2] * X_SCALE, v[3] * X_SCALE, w1, true);
                *(unsigned*)((unsigned char*)xb + (size_t)t * DM + j * 256 + lane * 4) = w1; }
            s = wave_sum(s); if (lane == 0) small[SM_SSQ0 + t] = s; }
        for (int i = gtid; i < S * 32; i += gthreads) { const int t = i >> 5, j = i & 31; const float inv = exp2f(-(float)j * 0.41524101186092029f); const float ang = (float)t * inv;
            float rev = ang * 0.15915494309189535f; rev -= rintf(rev);
            rope[2 * i] = __builtin_amdgcn_cosf(rev); rope[2 * i + 1] = __builtin_amdgcn_sinf(rev); }
        for (int i = gtid; i < 4 * 2 * S; i += gthreads) small[SM_SSQQ + i] = 0.f;
        for (int i = gtid; i < DM; i += gthreads) { const float lam = INP[I_LAMBDA][i]; small[SM_N8SP + i] = -8.f * log1pf(__expf(-lam)); }
    }
    SYNC_AFTER(0);
    if (IN(1)) { PH_PTRS();
        GemmDesc g{xb, DM, 0, wt_in, DM, 0, S / 256, NIN_PAD / 256, 1, DM};
        static_assert(WS_A4 - WS_A3 == 32 * MiB && WS_A5 - WS_A4 == 32 * MiB && SM_SSQKV - SM_SSQQ == 16384, "EpiIn layout");
        EpiIn E{small + SM_SSQ0, rope, INP[I_B_GATE], cq, kpe, xr, gy, (u64*)(small + SM_SSQQ), 1.f / (WIN_SCALE * X_SCALE)};
        gemm_mfma8<decltype(E), true, true>((LAS unsigned char*)lds_raw, g, E);
        if (G == 256 && bx >= 192) { GemmDesc g2{wt_sk, 256, 256 * 256, wq_plain, DM, 256, 1, 8, PH, 256, 64, bx - 192}; EpiWf E2{wt_pq}; GEMM(g2, E2); }
    }
    SYNC_AFTER(1);
    if (IN(2)) { PH_PTRS();
        PHASE_IDS();
        { GemmDesc g{cq, QL, 0, wt_uq, QL, 0, S / 256, 12, 1, QL}; EpiQ E{(const u64*)(small + SM_SSQQ), rope, qn, qp}; GEMM(g, E); }
        if (G == 256 && bx >= 128) { GemmDesc g{pb, PLE, 0, wt_pp, PLE, 0, S / 256, 8, 1, PLE, 128, bx - 128}; EpiPlain E{ppb}; GEMM(g, E); }
        { GemmDesc g{ckv, KVL, 0, wt_ukv, KVL, 0, S / 256, 16, 1, KVL}; EpiKV E{(const u64*)(small + SM_SSQKV), kn, vv}; GEMM(g, E); }
        if (G != 256) { GemmDesc g{wt_sk, 256, 256 * 256, wq_plain, DM, 256, 1, 8, PH, 256}; EpiWf E{wt_pq}; GEMM(g, E); }
        const float* cw = INP[I_CONV_W]; const float* cb = INP[I_CONV_B];
        for (int i = gtid; i < (S / 32) * (DM / 8); i += gthreads) { const int run = i / (DM / 8), c = (i % (DM / 8)) * 8, t0 = run * 32;
            float w_[4][8], b_[8];
#pragma unroll
            for (int k = 0; k < 4; ++k) { const f32x4 a = *(const f32x4*)(cw + k * DM + c), d = *(const f32x4*)(cw + k * DM + c + 4); w_[k][0] = a[0]; w_[k][1] = a[1]; w_[k][2] = a[2]; w_[k][3] = a[3]; w_[k][4] = d[0]; w_[k][5] = d[1]; w_[k][6] = d[2]; w_[k][7] = d[3]; }
            { const f32x4 a = *(const f32x4*)(cb + c), d = *(const f32x4*)(cb + c + 4); b_[0] = a[0]; b_[1] = a[1]; b_[2] = a[2]; b_[3] = a[3]; b_[4] = d[0]; b_[5] = d[1]; b_[6] = d[2]; b_[7] = d[3]; }
            float x0[8], x1[8], x2[8];
#pragma unroll
            for (int j = 0; j < 8; ++j) { x0[j] = 0.f; x1[j] = 0.f; x2[j] = 0.f; }
            if (t0 > 0) { const u32x4 r0 = *(const u32x4*)(xr + (size_t)(t0 - 3) * DM + c), r1 = *(const u32x4*)(xr + (size_t)(t0 - 2) * DM + c), r2 = *(const u32x4*)(xr + (size_t)(t0 - 1) * DM + c);
#pragma unroll
                for (int j = 0; j < 4; ++j) { x0[2 * j] = bflo(r0[j]); x0[2 * j + 1] = bfhi(r0[j]); x1[2 * j] = bflo(r1[j]); x1[2 * j + 1] = bfhi(r1[j]); x2[2 * j] = bflo(r2[j]); x2[2 * j + 1] = bfhi(r2[j]); } }
#pragma unroll 1
            for (int tt = 0; tt < 32; tt += 8) { u32x4 rw[8];
#pragma unroll
                for (int q = 0; q < 8; ++q) rw[q] = *(const u32x4*)(xr + (size_t)(t0 + tt + q) * DM + c);
#pragma unroll
                for (int q = 0; q < 8; ++q) { float x3[8]; u32x4 o;
#pragma unroll
                    for (int j = 0; j < 4; ++j) { x3[2 * j] = bflo(rw[q][j]); x3[2 * j + 1] = bfhi(rw[q][j]); }
#pragma unroll
                    for (int j = 0; j < 4; ++j) { const float y0 = b_[2 * j] + w_[0][2 * j] * x0[2 * j] + w_[1][2 * j] * x1[2 * j] + w_[2][2 * j] * x2[2 * j] + w_[3][2 * j] * x3[2 * j];
                        const float y1 = b_[2 * j + 1] + w_[0][2 * j + 1] * x0[2 * j + 1] + w_[1][2 * j + 1] * x1[2 * j + 1] + w_[2][2 * j + 1] * x2[2 * j + 1] + w_[3][2 * j + 1] * x3[2 * j + 1]; o[j] = pk2(y0, y1); }
                    *(u32x4*)(xc + (size_t)(t0 + tt + q) * DM + c) = o;
#pragma unroll
                    for (int j = 0; j < 8; ++j) { x0[j] = x1[j]; x1[j] = x2[j]; x2[j] = x3[j]; } } } }
    }
    SYNC_AFTER(2);
    if (IN(3)) { PH_PTRS();
        if (SIMPLE_ATTN) attn_simple(lds, qn, qp, kn, kpe, vv, qn); else attn_mfma((char*)lds_raw, qn, qp, kn, kpe, vv, (bf16_t*)o8);
#ifndef SKIP_GATES
        GemmDesc g{xc, DM, BD, wt_g, BD, 256 * BD, S / 256, 1, NBLK, BD};
        EpiGates E{INP[I_B_RG_A], INP[I_B_RG_X], small + SM_N8SP, xc, la, gx};
        GEMM(g, E);
#endif
    }
    SYNC_AFTER(3);
    if (IN(4)) { PH_PTRS();
        PHASE_IDS();
        for (int i = gtid; i < 64 * (DM / 2); i += gthreads) { const int ch = i / (DM / 2), c = (i % (DM / 2)) * 2;
            float A0 = 1.f, B0 = 0.f, A1 = 1.f, B1 = 0.f;
#pragma unroll 1
            for (int t16 = 0; t16 < 128; t16 += 16) { unsigned lw[16], gw[16];
#pragma unroll
                for (int q = 0; q < 16; ++q) { const size_t o = (size_t)(ch * 128 + t16 + q) * DM + c; lw[q] = *(const unsigned*)(la + o); gw[q] = *(const unsigned*)(gx + o); }
#pragma unroll
                for (int q = 0; q < 16; ++q) { const float a0 = __builtin_amdgcn_exp2f(bflo(lw[q])), a1 = __builtin_amdgcn_exp2f(bfhi(lw[q]));
                    A0 *= a0; B0 = a0 * B0 + bflo(gw[q]); A1 *= a1; B1 = a1 * B1 + bfhi(gw[q]); } }
            *(f32x4*)(agg + ((size_t)ch * DM + c) * 2) = (f32x4){A0, B0, A1, B1}; }
    }
    SYNC_AFTER(4);
    if (IN(5)) { PH_PTRS();
        PHASE_IDS();
        for (int i = gtid; i < 64 * (DM / 2); i += gthreads) { const int ch = i / (DM / 2), c = (i % (DM / 2)) * 2;
            float h0 = 0.f, h1v = 0.f;
#pragma unroll 1
            for (int c16 = 0; c16 < ch; c16 += 16) { f32x4 ab[16];
#pragma unroll
                for (int q = 0; q < 16; ++q) ab[q] = (c16 + q < ch) ? *(const f32x4*)(agg + ((size_t)(c16 + q) * DM + c) * 2) : (f32x4){1.f, 0.f, 1.f, 0.f};
#pragma unroll
                for (int q = 0; q < 16; ++q) { h0 = ab[q][0] * h0 + ab[q][1]; h1v = ab[q][2] * h1v + ab[q][3]; } }
#pragma unroll 1
            for (int t16 = 0; t16 < 128; t16 += 16) { unsigned lw[16], gw[16], yw[16];
#pragma unroll
                for (int q = 0; q < 16; ++q) { const size_t o = (size_t)(ch * 128 + t16 + q) * DM + c; lw[q] = *(const unsigned*)(la + o); gw[q] = *(const unsigned*)(gx + o); yw[q] = *(const unsigned*)(gy + o); }
#pragma unroll
                for (int q = 0; q < 16; ++q) { const float a0 = __builtin_amdgcn_exp2f(bflo(lw[q])), a1 = __builtin_amdgcn_exp2f(bfhi(lw[q]));
                    h0 = a0 * h0 + bflo(gw[q]); h1v = a1 * h1v + bfhi(gw[q]);
                    *(unsigned short*)((unsigned char*)Yb + (size_t)(ch * 128 + t16 + q) * DM + c) = (unsigned short)(__builtin_amdgcn_cvt_pk_fp8_f32(h0 * bflo(yw[q]) * Y_SCALE, h1v * bfhi(yw[q]) * Y_SCALE, 0u, false) & 0xffffu); } } }
    }
    SYNC_AFTER(5);
    if (IN(6)) { PH_PTRS();
        { GemmDesc g{(const bf16_t*)o8, DM, 0, wt_ao, DM, 0, S / 256, 8, 1, DM}; EpiMixA E{gat, mixa}; GEMM8(g, E); }
        asm volatile("s_waitcnt vmcnt(0)" ::: "memory"); __syncthreads();
        { GemmDesc g{Yb, DM, 0, wt_ro, DM, 0, S / 256, 8, 1, DM}; EpiMix E{grn, mixa, (unsigned char*)mix}; GEMM8(g, E); }
    }
    SYNC_AFTER(6);
    if (IN(7)) { PH_PTRS();
        { GemmDesc g{mix, DM, 0, wt_out, DM, 0, S / 256, 8, 1, DM}; EpiOut E{INP[I_X], h1b, (u64*)(small + SM_SSQ1)}; GEMM8(g, E); }
        if (G != 256) { GemmDesc g{pb, PLE, 0, wt_pp, PLE, 0, S / 256, 8, 1, PLE}; EpiPlain E{ppb}; GEMM(g, E); }
    }
    SYNC_AFTER(7);
    if (IN(8)) { PH_PTRS(); GemmDesc g{h1b, DM, 0, wt_pq, DM, 0, S / 256, 8, 1, DM}; EpiScores E{scores, (const u64*)(small + SM_SSQ1)}; GEMM(g, E); }
    SYNC_AFTER(8);

    if (IN(10)) { PH_PTRS(); peer_phase2((void*)(INP_WS_STAMP), (char*)lds_raw, scores, h1b, (const u64*)(small + SM_SSQ1), (const unsigned char*)tu, (const unsigned char*)tvt, h2b, xn3, small + SM_SSQ2); }
    SYNC_AFTER(10);
#ifdef STAMP_SEL
    const bool fuse_final = false;
#else
    const bool fuse_final = (G == 256);
#endif
    if (IN(11)) { PH_PTRS(); GemmDesc g{xn3, DM, 0, wt_pg, DM, 0, S / 256, 8, 1, DM};
        if (fuse_final) { EpiPleFinal E{ppb, h2b, hres, (u64*)(small + SM_SSQ3), small + SM_SSQ2, INP[I_FINAL_NORM], (unsigned*)(ws + WS_BAR) + XCD_BAR_WORDS}; gemm_mfma8<decltype(E), true, true>((LAS unsigned char*)lds_raw, g, E); }
        else { EpiPle E{ppb, h2b, hres, (u64*)(small + SM_SSQ3), small + SM_SSQ2}; gemm_mfma8<decltype(E), true, true>((LAS unsigned char*)lds_raw, g, E); } }
    if (!fuse_final) { SYNC_AFTER(11); }
    if (IN(12) && !fuse_final) { PH_PTRS();
        PHASE_IDS();
        const float* fn = INP[I_FINAL_NORM];
        for (int i = gtid; i < S * DM / 4; i += gthreads) { const int t = i / (DM / 4), c = (i % (DM / 4)) * 4;
            const float rs = rsqrtf(ssq_get((const u64*)(small + SM_SSQ3), t) * (1.f / DM) + EPS);
            const f32x4 v = *(const f32x4*)(hres + (size_t)i * 4), g4 = *(const f32x4*)(fn + c);
            f32x4 ov = v * rs * g4;
#ifdef STAMP_SEL
            if (i == STAMP_BLK * NTHREADS) { const unsigned long long* st_ = (const unsigned long long*)(INP_WS_STAMP); { const float tus_ = (float)(st_[STAMP_B] - st_[STAMP_A]) * 0.01f; ov[0] += exp2f(rintf(STAMP_Q * log2f(fmaxf(tus_, 1.f))) * (1.f / STAMP_Q)) * (1.f / STAMP_DIV); } }
#endif
            *(f32x4*)(hres + (size_t)i * 4) = ov; }
    }
}

constexpr int NPHASES = 13;
#ifndef MK_N_LAUNCHES
#define MK_N_LAUNCHES 1
#endif

extern "C" void kernel_launch(void* const* d_in, const int* in_sizes, int n_in, void* d_out, int out_size, void* d_ws, size_t ws_size, hipStream_t stream) {
    static int grid = 0;
    if (grid == 0) {
        if (n_in != 28 || out_size != S * DM || ws_size < WS_END) { fprintf(stderr, "kernel_launch: unexpected shapes (n_in %d out %d ws %zu)\n", n_in, out_size, ws_size); grid = -1; return; }
        int dev = 0, cus = 0, per_cu = 0;
        (void)hipGetDevice(&dev);
        (void)hipDeviceGetAttribute(&cus, hipDeviceAttributeMultiprocessorCount, dev);
        if (hipFuncSetAttribute((const void*)fwd_kernel, hipFuncAttributeMaxDynamicSharedMemorySize, LDS_BYTES) != hipSuccess) { fprintf(stderr, "kernel_launch: hipFuncSetAttribute failed\n"); grid = -1; return; }
        if (hipOccupancyMaxActiveBlocksPerMultiprocessor(&per_cu, (const void*)fwd_kernel, NTHREADS, LDS_BYTES) != hipSuccess || per_cu < 1) { fprintf(stderr, "kernel_launch: occupancy query failed (%d)\n", per_cu); (void)hipGetLastError(); per_cu = 1; }
        if (per_cu > 1) per_cu = 1;
        grid = cus * per_cu;
        if (grid <= 0) grid = 256;
    }
    if (grid < 0) return;
    if (hipMemsetAsync((char*)d_ws + WS_BAR, 0, XCD_BAR_WORDS * 4 + 32 * 256, stream) != hipSuccess) { fprintf(stderr, "kernel_launch: hipMemsetAsync failed\n"); return; }
    Params p{};
    for (int i = 0; i < 28; ++i) p.in[i] = (const float*)d_in[i];
    p.out = (float*)d_out; p.ws = (unsigned char*)d_ws;
    if (MK_N_LAUNCHES == 1) {
        p.ph_lo = 0; p.ph_hi = NPHASES;
        void* args[] = {&p};
        hipError_t e = hipLaunchCooperativeKernel((const void*)fwd_kernel, dim3(grid), dim3(NTHREADS), args, LDS_BYTES, stream);
        if (e != hipSuccess) fprintf(stderr, "cooperative launch failed: %s (grid %d)\n", hipGetErrorString(e), grid);
    } else {
        for (int k = 0; k < NPHASES; ++k) { p.ph_lo = k; p.ph_hi = k + 1; hipLaunchKernelGGL(fwd_kernel, dim3(grid), dim3(NTHREADS), LDS_BYTES, stream, p); }
    }
}
```
